# Optimizing an MI355X kernel written in HIP

```python
import math
import jax, jax.numpy as jnp
from jax import lax
import numpy as np

D_MODEL = 1024
BATCH = 1
SEQ = 16384
DEPTH = 2

GRID_W = 64
CTX_LEN = 256
HEAD_DIM = 64
NORM_EPS = 1e-6
A_Q_HEADS = 8
A_KV_HEADS = 2
A_WIDTH = A_Q_HEADS * HEAD_DIM
A_KV_WIDTH = A_KV_HEADS * HEAD_DIM
ROPE_THETA = 10000.0
Q_BLOCK = 128
B_HEADS = 4
B_WIDTH = B_HEADS * HEAD_DIM
B_CONV = 3
B_CHUNK = 64
C_WIDTH = 256
C_GROUP = 16
C_GROUPS = C_WIDTH // C_GROUP
C_STATE = 64
MIX_WIDTH = A_WIDTH + B_WIDTH + C_WIDTH
DEEPNORM_ALPHA = (2 * DEPTH) ** 0.25
DEEPNORM_BETA = (8 * DEPTH) ** -0.25
_SPLIT_WIDTHS = (A_WIDTH, A_KV_WIDTH, A_KV_WIDTH, A_WIDTH,
                 B_WIDTH, B_WIDTH, B_WIDTH, B_WIDTH, 2 * B_HEADS, 2 * B_HEADS,
                 C_WIDTH, C_WIDTH)
IN_WIDTH = sum(_SPLIT_WIDTHS)
SPLIT_POINTS = tuple(int(v) for v in np.cumsum(_SPLIT_WIDTHS)[:-1])

kernel_name = "hybrid_gqa_gdn_s5_prefix_ctx"

F32 = jnp.float32


def layer_norm(x):
    xf = x.astype(F32)
    mu = xf.mean(-1, keepdims=True)
    var = jnp.mean(jnp.square(xf - mu), -1, keepdims=True)
    return ((xf - mu) * lax.rsqrt(var + NORM_EPS)).astype(x.dtype)


def rms_norm(x, g):
    xf = x.astype(F32)
    y = xf * lax.rsqrt(jnp.mean(xf * xf, -1, keepdims=True) + NORM_EPS)
    return (y * g.astype(F32)).astype(x.dtype)


def l2norm(x):
    xf = x.astype(F32)
    return xf * lax.rsqrt(jnp.sum(xf * xf, -1, keepdims=True) + NORM_EPS)


def split_heads(z, n_heads):
    return z.reshape(*z.shape[:-1], n_heads, HEAD_DIM)


def flip_if(z, rev):
    return jnp.flip(z, 1) if rev else z


def axial_rope(n_tok):
    rows = n_tok // GRID_W
    row = jnp.repeat(jnp.arange(rows, dtype=F32), GRID_W)
    col = jnp.tile(jnp.arange(GRID_W, dtype=F32), rows)
    axis_dim = HEAD_DIM // 2
    inv = ROPE_THETA ** (-jnp.arange(0, axis_dim, 2, dtype=F32) / axis_dim)
    ar = row[:, None] * inv
    ac = col[:, None] * inv
    ang = jnp.concatenate([ar, ar, ac, ac], -1)
    return jnp.cos(ang), jnp.sin(ang)


def rotate_half(z):
    z1, z2 = jnp.split(z, 2, -1)
    return jnp.concatenate([-z2, z1], -1)


def apply_axial_rope(z, cos, sin):
    zf = z.astype(F32)
    zr, zc = jnp.split(zf, 2, -1)
    rot = jnp.concatenate([rotate_half(zr), rotate_half(zc)], -1)
    return (zf * cos[None, :, None, :] + rot * sin[None, :, None, :]).astype(z.dtype)


def attend(q, k, v):
    s = jnp.einsum('bqhgd,bkhd->bhgqk', q, k).astype(F32) * (HEAD_DIM ** -0.5)
    p = jax.nn.softmax(s, axis=-1).astype(v.dtype)
    return jnp.einsum('bhgqk,bkhd->bqhgd', p, v)


def attention_branch(lat, ctx, q_gain, k_gain, cos, sin, with_ctx_out):
    q_l_raw, k_l_raw, v_l_raw, gate_l = lat
    q_c_raw, k_c_raw, v_c_raw, gate_c = ctx
    groups = A_Q_HEADS // A_KV_HEADS
    k_l = apply_axial_rope(rms_norm(split_heads(k_l_raw, A_KV_HEADS), k_gain), cos, sin)
    q_l = apply_axial_rope(rms_norm(split_heads(q_l_raw, A_Q_HEADS), q_gain), cos, sin)
    k_c = rms_norm(split_heads(k_c_raw, A_KV_HEADS), k_gain)
    v_l = split_heads(v_l_raw, A_KV_HEADS)
    v_c = split_heads(v_c_raw, A_KV_HEADS)
    k_all = jnp.concatenate([k_l, k_c], 1)
    v_all = jnp.concatenate([v_l, v_c], 1)
    B, L = q_l.shape[:2]
    qb = q_l.reshape(B, L // Q_BLOCK, Q_BLOCK, A_KV_HEADS, groups, HEAD_DIM).swapaxes(0, 1)
    o_l = lax.map(lambda blk: attend(blk, k_all, v_all), qb)
    o_l = o_l.swapaxes(0, 1).reshape(B, L, A_WIDTH) * jax.nn.silu(gate_l)
    o_c = None
    if with_ctx_out:
        q_c = rms_norm(split_heads(q_c_raw, A_Q_HEADS), q_gain)
        Lc = q_c.shape[1]
        o_c = attend(q_c.reshape(B, Lc, A_KV_HEADS, groups, HEAD_DIM), k_c, v_c)
        o_c = o_c.reshape(B, Lc, A_WIDTH) * jax.nn.silu(gate_c)
    return o_l, o_c


def short_conv(z, w):
    K = w.shape[0]
    pad = K // 2
    L = z.shape[1]
    zp = jnp.pad(z, ((0, 0), (pad, pad), (0, 0)))
    return sum(zp[:, i:i + L] * w[i] for i in range(K))


def gated_delta_chunked(q, k, v, beta, g, s0):
    B, L, H, dk = k.shape
    dv = v.shape[-1]
    C = B_CHUNK
    n = L // C
    to_c = lambda z: z.reshape(B, n, C, H, z.shape[-1]).transpose(1, 0, 3, 2, 4)
    to_cs = lambda z: z.reshape(B, n, C, H).transpose(1, 0, 3, 2)
    qc, kc, vc = to_c(q), to_c(k), to_c(v)
    bc, gcum = to_cs(beta), jnp.cumsum(to_cs(g), -1)
    tri_incl = jnp.tril(jnp.ones((C, C), bool))
    tri_strict = jnp.tril(jnp.ones((C, C), bool), -1)
    decay = jnp.exp(jnp.where(tri_incl, gcum[..., :, None] - gcum[..., None, :], -jnp.inf))
    kb = kc * bc[..., None]
    lower = jnp.where(tri_strict, jnp.einsum('nbhid,nbhjd->nbhij', kb, kc) * decay, 0.0)
    eye = jnp.eye(C, dtype=F32)
    rhs = jnp.concatenate([vc * bc[..., None], kb * jnp.exp(gcum)[..., None]], -1)
    sol = lax.linalg.triangular_solve(lower + eye, rhs, left_side=True, lower=True,
                                      unit_diagonal=True)
    w_val, k_cum = sol[..., :dv], sol[..., dv:]
    attn = jnp.einsum('nbhid,nbhjd->nbhij', qc, kc) * decay
    q_dec = qc * jnp.exp(gcum)[..., None]
    k_dec = kc * jnp.exp(gcum[..., -1:] - gcum)[..., None]
    g_last = jnp.exp(gcum[..., -1])

    def step(S, xs):
        w_c, kcum_c, attn_c, qd_c, kd_c, gl_c = xs
        u = w_c - jnp.einsum('bhcd,bhde->bhce', kcum_c, S)
        o = jnp.einsum('bhcd,bhde->bhce', qd_c, S) + jnp.einsum('bhij,bhje->bhie', attn_c, u)
        S = S * gl_c[..., None, None] + jnp.einsum('bhcd,bhce->bhde', kd_c, u)
        return S, o

    S, o = lax.scan(step, s0, (w_val, k_cum, attn, q_dec, k_dec, g_last))
    o = o.transpose(1, 0, 3, 2, 4).reshape(B, L, H, dv)
    return o, S


def deltanet_prep(q, k, v, beta_raw, a_raw, conv_w, A_log, dt_bias):
    B, L = q.shape[:2]
    qkv = jax.nn.silu(short_conv(jnp.concatenate([q, k, v], -1), conv_w))
    q, k, v = jnp.split(qkv, 3, -1)
    q = l2norm(split_heads(q, B_HEADS)) * (HEAD_DIM ** -0.5)
    k = l2norm(split_heads(k, B_HEADS))
    v = split_heads(v, B_HEADS).astype(F32)
    beta = jax.nn.sigmoid(beta_raw.astype(F32)).reshape(B, L, 2, B_HEADS)
    g = -jnp.exp(A_log.astype(F32)) * jax.nn.softplus(
        a_raw.astype(F32).reshape(B, L, 2, B_HEADS) + dt_bias.astype(F32))
    return q, k, v, beta, g


def deltanet_branch(lat, ctx, conv_w, A_log, dt_bias, out_gain, with_ctx_out):
    ql, kl, vl, bl, gl = deltanet_prep(lat[0], lat[1], lat[2], lat[4], lat[5], conv_w, A_log, dt_bias)
    qc, kc, vc, bc, gc = deltanet_prep(ctx[0], ctx[1], ctx[2], ctx[4], ctx[5], conv_w, A_log, dt_bias)
    B, L = ql.shape[:2]
    s0 = jnp.zeros((B, B_HEADS, HEAD_DIM, HEAD_DIM), F32)
    o_l = jnp.zeros_like(vl)
    o_c = jnp.zeros_like(vc)
    for d, rev in ((0, False), (1, True)):
        oc_d, s_ctx = gated_delta_chunked(flip_if(qc, rev), flip_if(kc, rev), flip_if(vc, rev),
                                          flip_if(bc[:, :, d], rev), flip_if(gc[:, :, d], rev), s0)
        ol_d, _ = gated_delta_chunked(flip_if(ql, rev), flip_if(kl, rev), flip_if(vl, rev),
                                      flip_if(bl[:, :, d], rev), flip_if(gl[:, :, d], rev), s_ctx)
        o_l = o_l + flip_if(ol_d, rev)
        if with_ctx_out:
            o_c = o_c + flip_if(oc_d, rev)
    gate_l, gate_c = lat[3], ctx[3]
    out_l = rms_norm(o_l, out_gain).reshape(B, L, B_WIDTH).astype(gate_l.dtype) * jax.nn.silu(gate_l)
    out_c = None
    if with_ctx_out:
        out_c = rms_norm(o_c, out_gain).reshape(B, -1, B_WIDTH).astype(gate_c.dtype) * jax.nn.silu(gate_c)
    return out_l, out_c


def s5_discretise(A_re, A_im, log_dt, B_re, B_im):
    lam = lax.complex(A_re.astype(F32), A_im.astype(F32))
    dt = jnp.exp(log_dt.astype(F32))[:, None]
    a_bar = jnp.exp(lam * dt)
    b_bar = ((a_bar - 1.0) / lam)[..., None] * lax.complex(B_re.astype(F32), B_im.astype(F32))
    return a_bar, b_bar


def s5_states(u, a_bar, b_bar, h0):
    bu = jnp.einsum('blgc,gpc->blgp', u.astype(jnp.complex64), b_bar)
    bu = bu.at[:, 0].add(a_bar * h0)
    a = jnp.broadcast_to(a_bar, bu.shape)

    def combine(e1, e2):
        a1, b1 = e1
        a2, b2 = e2
        return a1 * a2, a2 * b1 + b2

    _, h = lax.associative_scan(combine, (a, bu), axis=1)
    return h


def s5_readout(h, c_mat):
    return jnp.einsum('blgp,gcp->blgc', h, c_mat).real


def s5_glu(y, glu_w, glu_b):
    z = jax.nn.gelu(y)
    return z * jax.nn.sigmoid(z @ glu_w.astype(F32) + glu_b.astype(F32))


def s5_branch(u_l_raw, gate_l, u_c_raw, gate_c, A_re, A_im, log_dt, B_re, B_im, C_re, C_im,
              D, glu_w, glu_b, with_ctx_out):
    B, L = u_l_raw.shape[:2]
    Lc = u_c_raw.shape[1]
    ul = u_l_raw.astype(F32).reshape(B, L, C_GROUPS, C_GROUP)
    uc = u_c_raw.astype(F32).reshape(B, Lc, C_GROUPS, C_GROUP)
    d_skip = D.astype(F32).reshape(C_GROUPS, C_GROUP)
    y_l = ul * d_skip
    y_c = uc * d_skip
    h0 = jnp.zeros((B, C_GROUPS, C_STATE), jnp.complex64)
    for d, rev in ((0, False), (1, True)):
        a_bar, b_bar = s5_discretise(A_re[d], A_im[d], log_dt[d], B_re[d], B_im[d])
        c_mat = lax.complex(C_re[d].astype(F32), C_im[d].astype(F32))
        h_c = s5_states(flip_if(uc, rev), a_bar, b_bar, h0)
        h_l = s5_states(flip_if(ul, rev), a_bar, b_bar, h_c[:, -1])
        y_l = y_l + flip_if(s5_readout(h_l, c_mat), rev)
        if with_ctx_out:
            y_c = y_c + flip_if(s5_readout(h_c, c_mat), rev)
    out_l = s5_glu(y_l.reshape(B, L, C_WIDTH), glu_w, glu_b).astype(gate_l.dtype) * jax.nn.silu(gate_l)
    out_c = None
    if with_ctx_out:
        out_c = s5_glu(y_c.reshape(B, Lc, C_WIDTH), glu_w, glu_b).astype(gate_c.dtype) * jax.nn.silu(gate_c)
    return out_l, out_c


def setup_inputs(seed: int = 0) -> dict:
    key = jax.random.key(seed)
    ks = jax.random.split(key, 32)
    nrm = lambda k, shape, s: jax.random.normal(k, shape, F32) * s
    dt_lo, dt_hi = math.log(1e-3), math.log(1e-1)
    x = nrm(ks[0], (BATCH, SEQ, D_MODEL), 1.0)
    c = nrm(ks[1], (BATCH, D_MODEL), 1.0)
    ctx = nrm(ks[2], (BATCH, CTX_LEN, D_MODEL), 1.0)
    c_ctx = nrm(ks[3], (D_MODEL,), 1.0)
    w_mod = nrm(ks[4], (DEPTH, D_MODEL, 3 * D_MODEL), D_MODEL ** -0.5)
    b_mod = nrm(ks[5], (DEPTH, 3 * D_MODEL), 0.02)
    w_in = nrm(ks[6], (DEPTH, D_MODEL, IN_WIDTH), D_MODEL ** -0.5)
    attn_q_gain = 1.0 + nrm(ks[7], (DEPTH, HEAD_DIM), 0.02)
    attn_k_gain = 1.0 + nrm(ks[8], (DEPTH, HEAD_DIM), 0.02)
    dn_conv_w = nrm(ks[9], (DEPTH, B_CONV, 3 * B_WIDTH), B_CONV ** -0.5)
    dn_A_log = jnp.log(jax.random.uniform(ks[10], (DEPTH, 2, B_HEADS), F32, 1.0, 16.0))
    dn_dt = jnp.exp(jax.random.uniform(ks[11], (DEPTH, 2, B_HEADS), F32, dt_lo, dt_hi))
    dn_dt_bias = dn_dt + jnp.log(-jnp.expm1(-dn_dt))
    dn_out_gain = 1.0 + nrm(ks[12], (DEPTH, HEAD_DIM), 0.02)
    n_idx = jnp.arange(C_STATE, dtype=F32)
    s5_A_re = -0.5 + nrm(ks[13], (DEPTH, 2, C_GROUPS, C_STATE), 0.01)
    s5_A_im = math.pi * n_idx + nrm(ks[14], (DEPTH, 2, C_GROUPS, C_STATE), 0.01)
    s5_log_dt = jax.random.uniform(ks[15], (DEPTH, 2, C_GROUPS), F32, dt_lo, dt_hi)
    s5_B_re = nrm(ks[16], (DEPTH, 2, C_GROUPS, C_STATE, C_GROUP), (2 * C_GROUP) ** -0.5)
    s5_B_im = nrm(ks[17], (DEPTH, 2, C_GROUPS, C_STATE, C_GROUP), (2 * C_GROUP) ** -0.5)
    s5_C_re = nrm(ks[18], (DEPTH, 2, C_GROUPS, C_GROUP, C_STATE), (2 * C_STATE) ** -0.5)
    s5_C_im = nrm(ks[19], (DEPTH, 2, C_GROUPS, C_GROUP, C_STATE), (2 * C_STATE) ** -0.5)
    s5_D = nrm(ks[20], (DEPTH, C_WIDTH), 1.0)
    glu_w = nrm(ks[21], (DEPTH, C_WIDTH, C_WIDTH), C_WIDTH ** -0.5)
    glu_b = nrm(ks[22], (DEPTH, C_WIDTH), 0.02)
    w_out = nrm(ks[23], (DEPTH, MIX_WIDTH, D_MODEL), MIX_WIDTH ** -0.5 * DEEPNORM_BETA)
    ln_g = 1.0 + nrm(ks[24], (DEPTH, D_MODEL), 0.02)
    ln_b = nrm(ks[25], (DEPTH, D_MODEL), 0.02)
    return {"x": x, "c": c, "ctx": ctx, "c_ctx": c_ctx, "w_mod": w_mod, "b_mod": b_mod,
            "w_in": w_in, "attn_q_gain": attn_q_gain, "attn_k_gain": attn_k_gain,
            "dn_conv_w": dn_conv_w, "dn_A_log": dn_A_log, "dn_dt_bias": dn_dt_bias,
            "dn_out_gain": dn_out_gain, "s5_A_re": s5_A_re, "s5_A_im": s5_A_im,
            "s5_log_dt": s5_log_dt, "s5_B_re": s5_B_re, "s5_B_im": s5_B_im,
            "s5_C_re": s5_C_re, "s5_C_im": s5_C_im, "s5_D": s5_D, "glu_w": glu_w,
            "glu_b": glu_b, "w_out": w_out, "ln_g": ln_g, "ln_b": ln_b}


def reference(x, c, ctx, c_ctx, w_mod, b_mod, w_in, attn_q_gain, attn_k_gain, dn_conv_w,
              dn_A_log, dn_dt_bias, dn_out_gain, s5_A_re, s5_A_im, s5_log_dt, s5_B_re, s5_B_im,
              s5_C_re, s5_C_im, s5_D, glu_w, glu_b, w_out, ln_g, ln_b):
    cos, sin = axial_rope(x.shape[1])
    for l in range(DEPTH):
        with_ctx_out = l < DEPTH - 1
        mod = jax.nn.silu(c) @ w_mod[l] + b_mod[l]
        shift, scale, gate = jnp.split(mod[:, None, :], 3, -1)
        mod_c = jax.nn.silu(c_ctx) @ w_mod[l] + b_mod[l]
        shift_c, scale_c, gate_c = jnp.split(mod_c, 3, -1)
        h = layer_norm(x) * (1 + scale) + shift
        hc = layer_norm(ctx) * (1 + scale_c) + shift_c
        zl = jnp.split(h @ w_in[l], SPLIT_POINTS, -1)
        zc = jnp.split(hc @ w_in[l], SPLIT_POINTS, -1)
        a_l, a_c = attention_branch(zl[0:4], zc[0:4], attn_q_gain[l], attn_k_gain[l],
                                    cos, sin, with_ctx_out)
        d_l, d_c = deltanet_branch(zl[4:10], zc[4:10], dn_conv_w[l], dn_A_log[l], dn_dt_bias[l],
                                   dn_out_gain[l], with_ctx_out)
        s_l, s_c = s5_branch(zl[10], zl[11], zc[10], zc[11], s5_A_re[l], s5_A_im[l], s5_log_dt[l],
                             s5_B_re[l], s5_B_im[l], s5_C_re[l], s5_C_im[l], s5_D[l],
                             glu_w[l], glu_b[l], with_ctx_out)
        mix_l = jnp.concatenate([a_l.astype(x.dtype), d_l.astype(x.dtype), s_l.astype(x.dtype)], -1)
        x_new = layer_norm(DEEPNORM_ALPHA * x + gate * (mix_l @ w_out[l])) * ln_g[l] + ln_b[l]
        if with_ctx_out:
            mix_c = jnp.concatenate([a_c.astype(ctx.dtype), d_c.astype(ctx.dtype),
                                     s_c.astype(ctx.dtype)], -1)
            ctx = layer_norm(DEEPNORM_ALPHA * ctx + gate_c * (mix_c @ w_out[l])) * ln_g[l] + ln_b[l]
        x = x_new
    return x
```

```cpp
#include <hip/hip_runtime.h>
#include <hip/hip_cooperative_groups.h>
#include <cstdio>
namespace cg = cooperative_groups;

#define DI __device__ __forceinline__
typedef unsigned short u16;
using bf16x8 = __attribute__((ext_vector_type(8))) short;
using f32x16 = __attribute__((ext_vector_type(16))) float;
using f32x4 = __attribute__((ext_vector_type(4))) float;
typedef __bf16 bf2_t __attribute__((ext_vector_type(2)));
typedef float f2_t __attribute__((ext_vector_type(2)));

#define MFMA32(a, b, c) __builtin_amdgcn_mfma_f32_32x32x16_bf16((a), (b), (c), 0, 0, 0)
#define MFMA16(a, b, c) __builtin_amdgcn_mfma_f32_16x16x32_bf16((a), (b), (c), 0, 0, 0)

constexpr int T = 16640;
constexpr int NCTX = 256;
constexpr int DM = 1024;
constexpr int NIN = 2832;
constexpr int NINP = 2944;
constexpr int NCH = 260;
constexpr float EPS = 1e-6f;
constexpr float DN_ALPHA = 1.4142135623730951f;

constexpr size_t al256(size_t x) { return (x + 255) & ~(size_t)255; }
constexpr size_t OFF_WINT = 0;
constexpr size_t OFF_WOUTT = OFF_WINT + al256((size_t)2 * NINP * 1024 * 2);
constexpr size_t OFF_GLUWT = OFF_WOUTT + al256((size_t)2 * 1024 * 1024 * 2);
constexpr size_t OFF_MODV = OFF_GLUWT + al256((size_t)2 * 256 * 256 * 2);
constexpr size_t OFF_ROPE = OFF_MODV + al256((size_t)2 * 2 * 3072 * 4);
constexpr size_t OFF_H = OFF_ROPE + al256((size_t)256 * 16 * 2 * 4);
constexpr size_t OFF_QB = OFF_H + al256((size_t)T * 1024 * 2);
constexpr size_t OFF_KB = OFF_QB + al256((size_t)8 * T * 64 * 2);
constexpr size_t OFF_VT = OFF_KB + al256((size_t)2 * T * 64 * 2);
constexpr size_t OFF_GATES = OFF_VT + al256((size_t)2 * T * 64 * 2);
constexpr size_t OFF_QKVB = OFF_GATES + al256((size_t)T * 1024 * 2);
constexpr size_t OFF_UC = OFF_QKVB + al256((size_t)T * 768 * 2);
constexpr size_t OFF_BD = OFF_UC + al256((size_t)T * 256 * 4);
constexpr size_t OFF_DN = OFF_BD + al256((size_t)T * 16 * 4);
constexpr size_t OFF_GLAST = OFF_DN + al256((size_t)1040 * 2 * 5 * 4096 * 2);
constexpr size_t OFF_S5E = OFF_GLAST + al256((size_t)1040 * 2 * 4);
constexpr size_t OFF_S5H = OFF_S5E + al256((size_t)NCH * 2 * 16 * 64 * 2 * 4);
constexpr size_t OFF_CTX1 = OFF_S5H + al256((size_t)NCH * 2 * 16 * 64 * 2 * 4);
constexpr size_t OFF_BAR = OFF_CTX1 + al256((size_t)256 * 1024 * 4);
constexpr size_t WS_TOTAL = OFF_BAR + 16384;
static_assert(WS_TOTAL <= (size_t)256 * 1024 * 1024, "workspace too large");
static_assert((size_t)T * 1024 * 4 <= (size_t)1040 * 2 * 5 * 4096 * 2, "y alias");

struct Params {
  const float *x, *c, *ctx, *c_ctx, *w_mod, *b_mod, *w_in, *qg, *kg, *conv_w, *A_log, *dt_bias, *out_gain,
      *A_re, *A_im, *log_dt, *B_re, *B_im, *C_re, *C_im, *Dskip, *glu_w, *glu_b, *w_out, *ln_g, *ln_b;
  float* out;
  char* ws;
};

constexpr int SMEM_BYTES = 75 * 1024;

DI float bf2f(u16 v) { return __uint_as_float(((unsigned)v) << 16); }
DI unsigned pk2(float a, float b) {
  f2_t v = {a, b};
  bf2_t r = __builtin_convertvector(v, bf2_t);
  return __builtin_bit_cast(unsigned, r);
}
DI u16 f2bf(float a) { return (u16)(pk2(a, 0.f) & 0xffffu); }
DI float silu_f(float x) { return x / (1.f + __expf(-x)); }
DI float sigmoid_f(float x) { return 1.f / (1.f + __expf(-x)); }
DI float wave_sum(float v) {
#pragma unroll
  for (int o = 32; o > 0; o >>= 1) v += __shfl_xor(v, o);
  return v;
}
DI int otid() { int t = threadIdx.x; asm volatile("" : "+v"(t)); return t; }
DI float gelu_tanh(float x) {
  float u = 0.7978845608028654f * (x + 0.044715f * x * x * x);
  float t = 1.f - 2.f / (1.f + __expf(2.f * u));
  return 0.5f * x * (1.f + t);
}
DI bf16x8 mk8(uint2 lo, uint2 hi) {
  uint4 v = {lo.x, lo.y, hi.x, hi.y};
  return __builtin_bit_cast(bf16x8, v);
}
DI bf16x8 mk8u(unsigned a, unsigned b, unsigned c, unsigned d) {
  uint4 v = {a, b, c, d};
  return __builtin_bit_cast(bf16x8, v);
}


#define XB_TMO      128
#define XB_XCNT(j)  (256  + 64 * (j))
#define XB_XSUB(j)  (1280 + 64 * (j))
#define XB_XGEN(j)  (2304 + 64 * (j))
#define XB_TOP      3328
#define XB_TOPGEN   3392
#define XCD_BAR_WORDS 3456
#define XB_SPIN_CAP (1u << 18)
#define LAS __attribute__((address_space(3)))
DI unsigned xb_ld(unsigned* p) { return __hip_atomic_load(p, __ATOMIC_RELAXED, __HIP_MEMORY_SCOPE_AGENT); }
DI unsigned xb_add(unsigned* p, unsigned v) { return __hip_atomic_fetch_add(p, v, __ATOMIC_RELAXED, __HIP_MEMORY_SCOPE_AGENT); }
DI unsigned xb_xcc_id() { return (unsigned)__builtin_amdgcn_s_getreg((3 << 11) | 20) & 0xFu; }
#define XB_SPIN(cond, bar) do { unsigned _sp = 0; while (cond) { __builtin_amdgcn_s_sleep(1); \
    if ((++_sp & 255u) == 0u) { if (xb_ld(&(bar)[XB_TMO])) break; if (_sp > XB_SPIN_CAP) { atomicAdd(&(bar)[XB_TMO], 1u); break; } } } } while (0)
struct XcdBarrier { unsigned* bar; unsigned x; volatile LAS unsigned* st; };
DI XcdBarrier xcd_barrier_post(unsigned* bar, volatile LAS unsigned* st) {
  XcdBarrier b; b.bar = bar; b.x = xb_xcc_id(); b.st = st;
  if (threadIdx.x == 0) (void)xb_add(&bar[XB_XCNT(b.x)], 1u);
  return b;
}
DI void xcd_barrier_complete(unsigned* bar, unsigned x, unsigned& nloc, unsigned& nx) {
  const unsigned G = gridDim.x * gridDim.y * gridDim.z;
  unsigned sum, cnt, mine, sp = 0u;
  for (;;) {
    sum = 0u; cnt = 0u; mine = 0u;
#pragma unroll
    for (unsigned j = 0; j < 16; ++j) { const unsigned c = xb_ld(&bar[XB_XCNT(j)]); sum += c; cnt += (c > 0u) ? 1u : 0u; mine = (j == x) ? c : mine; }
    if (sum == G) break;
    __builtin_amdgcn_s_sleep(1);
    if ((++sp & 255u) == 0u) { if (xb_ld(&bar[XB_TMO])) break; if (sp > XB_SPIN_CAP) { atomicAdd(&bar[XB_TMO], 1u); break; } }
  }
  nloc = mine > 0u ? mine : 1u; nx = cnt > 0u ? cnt : 1u;
}
DI void xcd_barrier(const XcdBarrier& b) {
  asm volatile("s_waitcnt vmcnt(0)" ::: "memory");
  __syncthreads();
  if (threadIdx.x == 0) {
    unsigned* bar = b.bar;
    __builtin_amdgcn_s_waitcnt(0);
    unsigned nloc = b.st[0], nx = b.st[1];
    if (nloc == 0u) { xcd_barrier_complete(bar, b.x, nloc, nx); b.st[0] = nloc; b.st[1] = nx; }
    const unsigned old = xb_add(&bar[XB_XSUB(b.x)], 1u);
    const unsigned gen = old / nloc;
    if (old + 1u == (gen + 1u) * nloc) {
      __builtin_amdgcn_fence(__ATOMIC_RELEASE, "agent");
      asm volatile("s_waitcnt vmcnt(0)" ::: "memory");
      const unsigned og = xb_add(&bar[XB_TOP], 1u);
      const unsigned tg = og / nx;
      if (og + 1u == (tg + 1u) * nx) xb_add(&bar[XB_TOPGEN], 1u);
      else XB_SPIN(xb_ld(&bar[XB_TOPGEN]) == tg, bar);
      __builtin_amdgcn_fence(__ATOMIC_ACQUIRE, "agent");
      xb_add(&bar[XB_XGEN(b.x)], 1u);
      asm volatile("s_waitcnt vmcnt(0)" ::: "memory");
    } else {
      XB_SPIN(xb_ld(&bar[XB_XGEN(b.x)]) == gen, bar);
      __builtin_amdgcn_fence(__ATOMIC_ACQUIRE, "agent");
      asm volatile("s_waitcnt vmcnt(0)" ::: "memory");
    }
  }
  __syncthreads();
}

DI void transpose_item(const float* __restrict__ src, int src_ld, u16* __restrict__ dst, int dst_ld, int k0, int n0,
                       bool permute_in, char* smem) {
  float* tile = (float*)smem;
  const int tid = otid();
#pragma unroll
  for (int i = 0; i < 16; ++i) {
    int k = i * 4 + (tid >> 6), n = tid & 63;
    int nd = n0 + n, ns = nd;
    if (permute_in) {
      if (nd < 2304) ns = nd;
      else if (nd < 2816) ns = nd + 16;
      else if (nd < 2832) ns = nd - 512;
      else ns = -1;
    }
    float v = (ns >= 0) ? src[(size_t)(k0 + k) * src_ld + ns] : 0.f;
    tile[k * 65 + n] = v;
  }
  __syncthreads();
#pragma unroll 4
  for (int i = 0; i < 16; ++i) {
    int n = i * 4 + (tid >> 6), k = tid & 63;
    dst[(size_t)(n0 + n) * dst_ld + k0 + k] = f2bf(tile[k * 65 + n]);
  }
  __syncthreads();
}

DI void mod_item(const Params& p, int item, char* smem) {
  const int l = item / 96, grp = item % 96;
  float* ssc = (float*)smem;
  float* red = ssc + 2048;
  const int tid = otid();
  for (int i = tid; i < 1024; i += 256) {
    ssc[i] = silu_f(p.c[i]);
    ssc[1024 + i] = silu_f(p.c_ctx[i]);
  }
  __syncthreads();
  const int kq = tid >> 5, n = tid & 31, col = grp * 32 + n;
  const float* w = p.w_mod + (size_t)l * 1024 * 3072 + col;
  float a0 = 0.f, a1 = 0.f;
#pragma unroll 16
  for (int k = kq * 128; k < kq * 128 + 128; ++k) {
    float wv = w[(size_t)k * 3072];
    a0 += ssc[k] * wv;
    a1 += ssc[1024 + k] * wv;
  }
  red[(0 * 8 + kq) * 32 + n] = a0;
  red[(1 * 8 + kq) * 32 + n] = a1;
  __syncthreads();
  if (tid < 64) {
    int v = tid >> 5, nn = tid & 31;
    float s = 0.f;
    for (int q = 0; q < 8; ++q) s += red[(v * 8 + q) * 32 + nn];
    int cc = grp * 32 + nn;
    float* modv = (float*)(p.ws + OFF_MODV);
    modv[(l * 2 + v) * 3072 + cc] = s + p.b_mod[l * 3072 + cc];
  }
  __syncthreads();
}

DI void setup_phase(const Params& p, char* smem) {
  constexpr int N_A = 2 * 16 * 46, N_B = 2 * 16 * 16, N_C = 2 * 4 * 4, N_D = 192, N_E = 1;
  constexpr int NTOT = N_A + N_B + N_C + N_D + N_E;
  for (int item = blockIdx.x; item < NTOT; item += gridDim.x) {
    int it = item;
    if (it < N_A) {
      int l = it / (16 * 46), r = it % (16 * 46);
      int kt = r / 46, nt = r % 46;
      transpose_item(p.w_in + (size_t)l * 1024 * NIN, NIN, (u16*)(p.ws + OFF_WINT) + (size_t)l * NINP * 1024, 1024,
                     kt * 64, nt * 64, true, smem);
      continue;
    }
    it -= N_A;
    if (it < N_B) {
      int l = it / 256, r = it % 256;
      int kt = r / 16, nt = r % 16;
      transpose_item(p.w_out + (size_t)l * 1024 * 1024, 1024, (u16*)(p.ws + OFF_WOUTT) + (size_t)l * 1024 * 1024, 1024,
                     kt * 64, nt * 64, false, smem);
      continue;
    }
    it -= N_B;
    if (it < N_C) {
      int l = it / 16, r = it % 16;
      int kt = r / 4, nt = r % 4;
      transpose_item(p.glu_w + (size_t)l * 256 * 256, 256, (u16*)(p.ws + OFF_GLUWT) + (size_t)l * 256 * 256, 256,
                     kt * 64, nt * 64, false, smem);
      continue;
    }
    it -= N_C;
    if (it < N_D) { mod_item(p, it, smem); continue; }
    float* rope = (float*)(p.ws + OFF_ROPE);
    for (int e = otid(); e < 4096; e += 256) {
      int row = e >> 4, j = e & 15;
      float inv = powf(10000.f, -(float)j / 16.f);
      float ang = (float)row * inv;
      rope[e * 2] = cosf(ang);
      rope[e * 2 + 1] = sinf(ang);
    }
  }
}

DI void ln_mod_phase(const Params& p, const float* ctx_src, const float* lat_src, int l) {
  const int lane = otid() & 63, wave = otid() >> 6;
  const int nw = gridDim.x * 4;
  u16* h = (u16*)(p.ws + OFF_H);
  const float* modv = (const float*)(p.ws + OFF_MODV);
  for (int r = blockIdx.x * 4 + wave; r < T; r += nw) {
    const float* src = (r < NCTX) ? ctx_src + (size_t)r * DM : lat_src + (size_t)(r - NCTX) * DM;
    const float* mod = modv + (l * 2 + (r < NCTX ? 1 : 0)) * 3072;
    float4 v[4];
    float s = 0.f;
#pragma unroll
    for (int i = 0; i < 4; ++i) {
      v[i] = *(const float4*)(src + (i * 64 + lane) * 4);
      s += v[i].x + v[i].y + v[i].z + v[i].w;
    }
    float mu = wave_sum(s) * (1.f / DM);
    float q = 0.f;
#pragma unroll
    for (int i = 0; i < 4; ++i) {
      v[i].x -= mu; v[i].y -= mu; v[i].z -= mu; v[i].w -= mu;
      q += v[i].x * v[i].x + v[i].y * v[i].y + v[i].z * v[i].z + v[i].w * v[i].w;
    }
    float rstd = rsqrtf(wave_sum(q) * (1.f / DM) + EPS);
#pragma unroll
    for (int i = 0; i < 4; ++i) {
      int c0 = (i * 64 + lane) * 4;
      float4 sh = *(const float4*)(mod + c0);
      float4 sc = *(const float4*)(mod + 1024 + c0);
      float o0 = v[i].x * rstd * (1.f + sc.x) + sh.x;
      float o1 = v[i].y * rstd * (1.f + sc.y) + sh.y;
      float o2 = v[i].z * rstd * (1.f + sc.z) + sh.z;
      float o3 = v[i].w * rstd * (1.f + sc.w) + sh.w;
      uint2 pk = {pk2(o0, o1), pk2(o2, o3)};
      *(uint2*)(h + (size_t)r * DM + c0) = pk;
    }
  }
}

constexpr int G_LDA = 72;
DI void gemm_tile_compute(const u16* __restrict__ A, int lda, const u16* __restrict__ Bt, int ldb, int K, int m0, int n0,
                          char* smem) {
  u16* As = (u16*)smem;
  u16* Bs = As + 2 * 128 * G_LDA;
  const int tid = otid(), lane = tid & 63, wave = tid >> 6;
  const int wm = wave >> 1, wn = wave & 1;
  const int lr = lane & 31, lh = lane >> 5;
  f32x16 acc[2][2];
#pragma unroll
  for (int a = 0; a < 2; ++a)
#pragma unroll
    for (int b = 0; b < 2; ++b)
#pragma unroll
      for (int i = 0; i < 16; ++i) acc[a][b][i] = 0.f;

  const int KT = K / 64;
  uint4 ra0, ra1, ra2, ra3, rb0, rb1, rb2, rb3;
  const int srow = tid >> 3, sch = tid & 7;
  const u16* Ag = A + (size_t)(m0 + srow) * lda + sch * 8;
  const u16* Bg = Bt + (size_t)(n0 + srow) * ldb + sch * 8;
  const size_t a32 = (size_t)32 * lda, b32 = (size_t)32 * ldb;
#define G_LOAD(KT_)                                                                       \
  {                                                                                       \
    const u16* ag_ = Ag + (KT_) * 64;                                                     \
    const u16* bg_ = Bg + (KT_) * 64;                                                     \
    ra0 = *(const uint4*)(ag_);            rb0 = *(const uint4*)(bg_);                    \
    ra1 = *(const uint4*)(ag_ + a32);      rb1 = *(const uint4*)(bg_ + b32);              \
    ra2 = *(const uint4*)(ag_ + 2 * a32);  rb2 = *(const uint4*)(bg_ + 2 * b32);          \
    ra3 = *(const uint4*)(ag_ + 3 * a32);  rb3 = *(const uint4*)(bg_ + 3 * b32);          \
  }
#define G_STORE(BUF_)                                                                     \
  {                                                                                       \
    u16* as_ = As + ((BUF_) * 128 + srow) * G_LDA + sch * 8;                              \
    u16* bs_ = Bs + ((BUF_) * 128 + srow) * G_LDA + sch * 8;                              \
    *(uint4*)(as_) = ra0;                    *(uint4*)(bs_) = rb0;                        \
    *(uint4*)(as_ + 32 * G_LDA) = ra1;       *(uint4*)(bs_ + 32 * G_LDA) = rb1;           \
    *(uint4*)(as_ + 64 * G_LDA) = ra2;       *(uint4*)(bs_ + 64 * G_LDA) = rb2;           \
    *(uint4*)(as_ + 96 * G_LDA) = ra3;       *(uint4*)(bs_ + 96 * G_LDA) = rb3;           \
  }
  G_LOAD(0)
  G_STORE(0)
  __syncthreads();
  for (int kt = 0; kt < KT; ++kt) {
    const int buf = kt & 1;
    const int ktn = kt + 1 < KT ? kt + 1 : kt;
    G_LOAD(ktn)
    __builtin_amdgcn_sched_barrier(0);
    const u16* Ab = As + (buf * 128 + wm * 64 + lr) * G_LDA + lh * 8;
    const u16* Bb = Bs + (buf * 128 + wn * 64 + lr) * G_LDA + lh * 8;
    bf16x8 fa0[4], fa1[4], fb0[4], fb1[4];
#pragma unroll
    for (int ks = 0; ks < 4; ++ks) {
      fa0[ks] = *(const bf16x8*)(Ab + ks * 16);
      fa1[ks] = *(const bf16x8*)(Ab + 32 * G_LDA + ks * 16);
      fb0[ks] = *(const bf16x8*)(Bb + ks * 16);
      fb1[ks] = *(const bf16x8*)(Bb + 32 * G_LDA + ks * 16);
    }
    __builtin_amdgcn_sched_barrier(0);
#pragma unroll
    for (int ks = 0; ks < 4; ++ks) {
      acc[0][0] = MFMA32(fa0[ks], fb0[ks], acc[0][0]);
      acc[0][1] = MFMA32(fa0[ks], fb1[ks], acc[0][1]);
      acc[1][0] = MFMA32(fa1[ks], fb0[ks], acc[1][0]);
      acc[1][1] = MFMA32(fa1[ks], fb1[ks], acc[1][1]);
    }
    __builtin_amdgcn_sched_barrier(0);
    G_STORE(buf ^ 1)
    __syncthreads();
  }
  float* Cs = (float*)smem;
#pragma unroll
  for (int mi = 0; mi < 2; ++mi)
#pragma unroll
    for (int ni = 0; ni < 2; ++ni)
#pragma unroll
      for (int i = 0; i < 16; ++i) {
        int row = wm * 64 + mi * 32 + (i & 3) + 8 * (i >> 2) + 4 * lh;
        int col = wn * 64 + ni * 32 + lr;
        Cs[row * 132 + col] = acc[mi][ni][i];
      }
  __syncthreads();
}

template <bool OUT_BF16, bool SILU>
DI void epi_store(const float* Cs, void* dst, int ld, int m0, int coff, int ncols) {
  const int tid = otid();
  const int cpr = ncols >> 2;
  for (int idx = tid; idx < 128 * cpr; idx += 256) {
    int row = idx / cpr, c4 = idx % cpr;
    float4 v = *(const float4*)(Cs + row * 132 + 4 * c4);
    if (SILU) { v.x = silu_f(v.x); v.y = silu_f(v.y); v.z = silu_f(v.z); v.w = silu_f(v.w); }
    size_t o = (size_t)(m0 + row) * ld + coff + 4 * c4;
    if (OUT_BF16) *(uint2*)((u16*)dst + o) = make_uint2(pk2(v.x, v.y), pk2(v.z, v.w));
    else *(float4*)((float*)dst + o) = v;
  }
}

DI void epi_qk(const Params& p, const float* Cs, int l, int m0, int nt) {
  const int tid = otid();
  const int row = tid & 127, hh = tid >> 7;
  const int gr = m0 + row;
  const bool isk = (nt == 4);
  const float* gain = (isk ? p.kg : p.qg) + l * 64;
  float v[64];
  float ss = 0.f;
#pragma unroll
  for (int d4 = 0; d4 < 16; ++d4) {
    float4 t4 = *(const float4*)(Cs + row * 132 + hh * 64 + d4 * 4);
    v[4 * d4] = t4.x; v[4 * d4 + 1] = t4.y; v[4 * d4 + 2] = t4.z; v[4 * d4 + 3] = t4.w;
    ss += t4.x * t4.x + t4.y * t4.y + t4.z * t4.z + t4.w * t4.w;
  }
  float rinv = rsqrtf(ss * (1.f / 64.f) + EPS);
#pragma unroll
  for (int d = 0; d < 64; ++d) v[d] = v[d] * rinv * gain[d];
  if (gr >= NCTX) {
    const int t = gr - NCTX;
    const float* rope = (const float*)(p.ws + OFF_ROPE);
    const float* rr = rope + (t >> 6) * 32;
    const float* rc = rope + (t & 63) * 32;
#pragma unroll
    for (int j = 0; j < 16; ++j) {
      float c1 = rr[2 * j], s1 = rr[2 * j + 1];
      float a = v[j], b = v[j + 16];
      v[j] = a * c1 - b * s1;
      v[j + 16] = b * c1 + a * s1;
      float c2 = rc[2 * j], s2 = rc[2 * j + 1];
      float a2 = v[32 + j], b2 = v[48 + j];
      v[32 + j] = a2 * c2 - b2 * s2;
      v[48 + j] = b2 * c2 + a2 * s2;
    }
  }
  if (!isk) {
    constexpr float QS = 0.125f * 1.4426950408889634f;
#pragma unroll
    for (int d = 0; d < 64; ++d) v[d] *= QS;
  }
  u16* dst;
  if (isk) dst = (u16*)(p.ws + OFF_KB) + ((size_t)hh * T + gr) * 64;
  else dst = (u16*)(p.ws + OFF_QB) + ((size_t)(2 * nt + hh) * T + gr) * 64;
#pragma unroll
  for (int c = 0; c < 8; ++c) {
    uint4 o = {pk2(v[8 * c], v[8 * c + 1]), pk2(v[8 * c + 2], v[8 * c + 3]), pk2(v[8 * c + 4], v[8 * c + 5]),
               pk2(v[8 * c + 6], v[8 * c + 7])};
    *(uint4*)(dst + 8 * c) = o;
  }
}

DI void epi_v(const Params& p, const float* Cs, int m0) {
  const int tid = otid();
  const int c = tid & 127, half = tid >> 7;
  const int kvh = c >> 6, d = c & 63;
  u16* dst = (u16*)(p.ws + OFF_VT) + ((size_t)kvh * 64 + d) * T + m0 + half * 64;
#pragma unroll
  for (int g = 0; g < 8; ++g) {
    float v[8];
#pragma unroll
    for (int e = 0; e < 8; ++e) v[e] = Cs[(half * 64 + g * 8 + e) * 132 + c];
    uint4 o = {pk2(v[0], v[1]), pk2(v[2], v[3]), pk2(v[4], v[5]), pk2(v[6], v[7])};
    *(uint4*)(dst + g * 8) = o;
  }
}

DI void gemm_in_phase(const Params& p, int l, char* smem) {
  const u16* A = (const u16*)(p.ws + OFF_H);
  const u16* Bt = (const u16*)(p.ws + OFF_WINT) + (size_t)l * NINP * 1024;
  constexpr int MT = T / 128, NT = NINP / 128;
  const float* Cs = (const float*)smem;
  constexpr int MG = (MT + 7) / 8;
  for (int item = blockIdx.x; item < MG * 8 * NT; item += gridDim.x) {
    const int xcd = item & 7, r = item >> 3;
    const int mt = (r / NT) * 8 + xcd, nt = r % NT;
    if (mt >= MT) continue;
    const int m0 = mt * 128;
    gemm_tile_compute(A, 1024, Bt, 1024, 1024, m0, nt * 128, smem);
    if (nt <= 4) epi_qk(p, Cs, l, m0, nt);
    else if (nt == 5) epi_v(p, Cs, m0);
    else if (nt <= 9) epi_store<true, true>(Cs, p.ws + OFF_GATES, 1024, m0, (nt - 6) * 128, 128);
    else if (nt <= 15) epi_store<true, false>(Cs, p.ws + OFF_QKVB, 768, m0, (nt - 10) * 128, 128);
    else if (nt <= 17) epi_store<true, true>(Cs, p.ws + OFF_GATES, 1024, m0, 512 + (nt - 16) * 128, 128);
    else if (nt <= 19) epi_store<false, false>(Cs, p.ws + OFF_UC, 256, m0, (nt - 18) * 128, 128);
    else if (nt <= 21) epi_store<true, true>(Cs, p.ws + OFF_GATES, 1024, m0, 768 + (nt - 20) * 128, 128);
    else epi_store<false, false>(Cs, p.ws + OFF_BD, 16, m0, 0, 16);
    __syncthreads();
  }
}

DI void gemm_glu_phase(const Params& p, int l, char* smem) {
  const u16* A = (const u16*)(p.ws + OFF_QB);
  const u16* Bt = (const u16*)(p.ws + OFF_GLUWT) + (size_t)l * 256 * 256;
  const u16* gates = (const u16*)(p.ws + OFF_GATES);
  u16* mix = (u16*)(p.ws + OFF_H);
  const float* Cs = (const float*)smem;
  constexpr int MT = T / 128;
  for (int item = blockIdx.x; item < MT * 2; item += gridDim.x) {
    const int mt = item >> 1, nt = item & 1;
    const int m0 = mt * 128, n0 = nt * 128;
    gemm_tile_compute(A, 256, Bt, 256, 256, m0, n0, smem);
    for (int idx = otid(); idx < 128 * 64; idx += 256) {
      int row = idx >> 6, cp = idx & 63;
      int col = n0 + 2 * cp;
      size_t r = (size_t)(m0 + row);
      float a0 = Cs[row * 132 + 2 * cp] + p.glu_b[l * 256 + col];
      float a1 = Cs[row * 132 + 2 * cp + 1] + p.glu_b[l * 256 + col + 1];
      unsigned zz = *(const unsigned*)(A + r * 256 + col);
      unsigned gg = *(const unsigned*)(gates + r * 1024 + 768 + col);
      float z0 = bf2f((u16)(zz & 0xffff)), z1 = bf2f((u16)(zz >> 16));
      float g0 = bf2f((u16)(gg & 0xffff)), g1 = bf2f((u16)(gg >> 16));
      float o0 = z0 * sigmoid_f(a0) * g0, o1 = z1 * sigmoid_f(a1) * g1;
      *(unsigned*)(mix + r * 1024 + 768 + col) = pk2(o0, o1);
    }
    __syncthreads();
  }
}

DI void gemm_out_phase(const Params& p, int l, char* smem) {
  const u16* A = (const u16*)(p.ws + OFF_H);
  const u16* Bt = (const u16*)(p.ws + OFF_WOUTT) + (size_t)l * 1024 * 1024;
  const float* Cs = (const float*)smem;
  constexpr int MT = T / 128, NT = 8;
  const int mstart = (l == 1) ? 2 : 0;
  constexpr int MG = (MT + 7) / 8;
  for (int item = blockIdx.x; item < MG * 8 * NT; item += gridDim.x) {
    const int xcd = item & 7, r = item >> 3;
    const int mt = (r / NT) * 8 + xcd, nt = r % NT;
    if (mt >= MT || mt < mstart) continue;
    gemm_tile_compute(A, 1024, Bt, 1024, 1024, mt * 128, nt * 128, smem);
    epi_store<false, false>(Cs, p.ws + OFF_DN, 1024, mt * 128, nt * 128, 128);
    __syncthreads();
  }
}

DI void dn_solve(const float* Lr, const float* sb, const float* gc, bool isv, const char* src, int stride_bytes, float* x) {
  int off = 0;
  const int hioff = isv ? 0 : 2;
  const unsigned lomask = isv ? 0u : 0xffffu;
  const float gsel = isv ? 0.f : 1.f;
#pragma unroll
  for (int li = 0; li < 64; ++li) {
    const unsigned hi = *(const u16*)(src + off + hioff);
    const unsigned lo = *(const u16*)(src + off);
    const float gcl = gc[li];
    float r = __uint_as_float((hi << 16) | (lo & lomask)) * __expf(gcl * gsel);
    off += stride_bytes;
    asm volatile("" : "+v"(off));
    float acc = r * sb[li];
#pragma unroll
    for (int lj4 = 0; lj4 < (li + 3) / 4; ++lj4) {
      float4 Lq = *(const float4*)(Lr + li * 64 + lj4 * 4);
      if (lj4 * 4 + 0 < li) acc -= Lq.x * x[lj4 * 4 + 0];
      if (lj4 * 4 + 1 < li) acc -= Lq.y * x[lj4 * 4 + 1];
      if (lj4 * 4 + 2 < li) acc -= Lq.z * x[lj4 * 4 + 2];
      if (lj4 * 4 + 3 < li) acc -= Lq.w * x[lj4 * 4 + 3];
    }
    x[li] = acc;
    if (li & 1) __builtin_amdgcn_sched_barrier(0);
  }
}

DI void dn_prep_item(const Params& p, int l, int unit, char* smem) {
  const int cid = unit >> 2, head = unit & 3;
  const int tt0 = cid * 64;
  const int seg_lo = cid < 4 ? 0 : NCTX, seg_hi = cid < 4 ? NCTX : T;
  float* sq = (float*)smem;
  float* sk = sq + 64 * 65;
  float* sL = sk + 64 * 65;
  float* sbeta = sL + 2 * 4096;
  float* sgc = sbeta + 128;
  float* sg = sgc + 128;
  u16* sv = (u16*)(sg + 128);
  const u16* z = (const u16*)(p.ws + OFF_QKVB);
  const float* bd = (const float*)(p.ws + OFF_BD);
  const float* cw = p.conv_w + l * 3 * 768;
  u16* dn = (u16*)(p.ws + OFF_DN) + (size_t)unit * 2 * 5 * 4096;
  u16* tmp = (u16*)(p.ws + OFF_H) + (size_t)blockIdx.x * 32768;
  float* glast = (float*)(p.ws + OFF_GLAST);
  const int tid = otid(), lane = tid & 63, wave = tid >> 6;

  {
    const int cq = head * 64 + lane, ck = 256 + head * 64 + lane;
    const float wq0 = cw[cq], wq1 = cw[768 + cq], wq2 = cw[1536 + cq];
    const float wk0 = cw[ck], wk1 = cw[768 + ck], wk2 = cw[1536 + ck];
#pragma unroll 8
    for (int i = wave; i < 64; i += 4) {
      const int tt = tt0 + i;
      float zq0 = 0.f, zq2 = 0.f, zk0 = 0.f, zk2 = 0.f;
      if (tt - 1 >= seg_lo) { zq0 = bf2f(z[(size_t)(tt - 1) * 768 + cq]); zk0 = bf2f(z[(size_t)(tt - 1) * 768 + ck]); }
      if (tt + 1 < seg_hi) { zq2 = bf2f(z[(size_t)(tt + 1) * 768 + cq]); zk2 = bf2f(z[(size_t)(tt + 1) * 768 + ck]); }
      float zq1 = bf2f(z[(size_t)tt * 768 + cq]), zk1 = bf2f(z[(size_t)tt * 768 + ck]);
      float vq = silu_f(wq0 * zq0 + wq1 * zq1 + wq2 * zq2);
      float vk = silu_f(wk0 * zk0 + wk1 * zk1 + wk2 * zk2);
      float s1 = wave_sum(vq * vq), s2 = wave_sum(vk * vk);
      sq[i * 65 + lane] = vq * rsqrtf(s1 + EPS) * 0.125f;
      sk[i * 65 + lane] = vk * rsqrtf(s2 + EPS);
    }
  }
  if (tid < 128) {
    const int dir = tid >> 6, i = tid & 63;
    const int tt = tt0 + i;
    const int li = dir ? 63 - i : i;
    float br = bd[(size_t)tt * 16 + dir * 4 + head];
    float ar = bd[(size_t)tt * 16 + 8 + dir * 4 + head];
    sbeta[dir * 64 + li] = 1.f / (1.f + expf(-br));
    float xx = ar + p.dt_bias[l * 8 + dir * 4 + head];
    float sp = fmaxf(xx, 0.f) + log1pf(expf(-fabsf(xx)));
    sg[dir * 64 + li] = -expf(p.A_log[l * 8 + dir * 4 + head]) * sp;
  }
  __syncthreads();
  if (tid == 0 || tid == 64) {
    const int dir = tid >> 6;
    float a = 0.f;
    for (int li = 0; li < 64; ++li) { a += sg[dir * 64 + li]; sgc[dir * 64 + li] = a; }
  }
  __syncthreads();

  {
    const int it = wave >> 1, jt = wave & 1;
    const int lr = lane & 31, lh = lane >> 5;
    f32x16 kk, qk;
#pragma unroll
    for (int r = 0; r < 16; ++r) { kk[r] = 0.f; qk[r] = 0.f; }
    const float* ki = sk + (32 * it + lr) * 65 + 8 * lh;
    const float* qi = sq + (32 * it + lr) * 65 + 8 * lh;
    const float* kj = sk + (32 * jt + lr) * 65 + 8 * lh;
#pragma unroll
    for (int ks = 0; ks < 4; ++ks) {
      bf16x8 fa = mk8u(pk2(ki[16 * ks], ki[16 * ks + 1]), pk2(ki[16 * ks + 2], ki[16 * ks + 3]), pk2(ki[16 * ks + 4], ki[16 * ks + 5]),
                       pk2(ki[16 * ks + 6], ki[16 * ks + 7]));
      bf16x8 fq = mk8u(pk2(qi[16 * ks], qi[16 * ks + 1]), pk2(qi[16 * ks + 2], qi[16 * ks + 3]), pk2(qi[16 * ks + 4], qi[16 * ks + 5]),
                       pk2(qi[16 * ks + 6], qi[16 * ks + 7]));
      bf16x8 fb = mk8u(pk2(kj[16 * ks], kj[16 * ks + 1]), pk2(kj[16 * ks + 2], kj[16 * ks + 3]), pk2(kj[16 * ks + 4], kj[16 * ks + 5]),
                       pk2(kj[16 * ks + 6], kj[16 * ks + 7]));
      kk = MFMA32(fa, fb, kk);
      qk = MFMA32(fq, fb, qk);
    }
    const int j = 32 * jt + lr;
#pragma unroll
    for (int dir = 0; dir < 2; ++dir) {
      u16* attn = tmp + dir * 16384;
      const int lj = dir ? 63 - j : j;
      const float gcj = sgc[dir * 64 + lj];
#pragma unroll
      for (int r = 0; r < 16; ++r) {
        const int i = 32 * it + (r & 3) + 8 * (r >> 2) + 4 * lh;
        const int li = dir ? 63 - i : i;
        const float dec = __expf(fminf(sgc[dir * 64 + li] - gcj, 0.f));
        const float Lv = (lj < li) ? sbeta[dir * 64 + li] * kk[r] * dec : 0.f;
        const float Av = (lj <= li) ? qk[r] * dec : 0.f;
        sL[dir * 4096 + li * 64 + lj] = Lv;
        attn[li * 64 + lj] = f2bf(Av);
      }
    }
  }
#pragma unroll
  for (int dir = 0; dir < 2; ++dir) {
    u16* kdT = tmp + dir * 16384 + 4096;
    {
      const int d = tid >> 2, lq = tid & 3;
      const float gl = sgc[dir * 64 + 63];
      unsigned o[8];
#pragma unroll
      for (int e = 0; e < 8; ++e) {
        const int li0 = lq * 16 + 2 * e, li1 = li0 + 1;
        const int i0 = dir ? 63 - li0 : li0, i1 = dir ? 63 - li1 : li1;
        float v0 = sk[i0 * 65 + d] * __expf(gl - sgc[dir * 64 + li0]);
        float v1 = sk[i1 * 65 + d] * __expf(gl - sgc[dir * 64 + li1]);
        o[e] = pk2(v0, v1);
      }
      *(uint4*)(kdT + d * 64 + lq * 16) = make_uint4(o[0], o[1], o[2], o[3]);
      *(uint4*)(kdT + d * 64 + lq * 16 + 8) = make_uint4(o[4], o[5], o[6], o[7]);
    }
    if (tid == 0) glast[unit * 2 + dir] = __expf(sgc[dir * 64 + 63]);
  }
  {
    const int cv = 512 + head * 64 + lane;
    const float w0 = cw[cv], w1 = cw[768 + cv], w2 = cw[1536 + cv];
#pragma unroll 8
    for (int i = wave; i < 64; i += 4) {
      const int tt = tt0 + i;
      float z0 = 0.f, z2 = 0.f;
      if (tt - 1 >= seg_lo) z0 = bf2f(z[(size_t)(tt - 1) * 768 + cv]);
      if (tt + 1 < seg_hi) z2 = bf2f(z[(size_t)(tt + 1) * 768 + cv]);
      float z1 = bf2f(z[(size_t)tt * 768 + cv]);
      sv[i * 72 + lane] = f2bf(silu_f(w0 * z0 + w1 * z1 + w2 * z2));
    }
  }
  __syncthreads();
  {
    const int dir = tid >> 7, col = tid & 127;
    const bool isv = col < 64;
    const int c6 = col & 63;
    float x[64];
    const char* src = isv ? (const char*)(sv + (dir ? 63 * 72 : 0) + c6) : (const char*)(sk + (dir ? 63 * 65 : 0) + c6);
    const int strideb = (isv ? 144 : 260) * (dir ? -1 : 1);
    dn_solve(sL + dir * 4096, sbeta + dir * 64, sgc + dir * 64, isv, src, strideb, x);
    u16* XT = tmp + dir * 16384 + 8192 + col * 64;
#pragma unroll
    for (int c = 0; c < 8; ++c)
      *(uint4*)(XT + 8 * c) = make_uint4(pk2(x[8 * c], x[8 * c + 1]), pk2(x[8 * c + 2], x[8 * c + 3]),
                                         pk2(x[8 * c + 4], x[8 * c + 5]), pk2(x[8 * c + 6], x[8 * c + 7]));
  }
  __threadfence_block();
  __syncthreads();
  {
    const int dir = wave >> 1, prod = wave & 1;
    const int lr = lane & 31, lh = lane >> 5;
    const u16* Aop = tmp + dir * 16384 + (prod ? 0 : 4096);
    const u16* XT = tmp + dir * 16384 + 8192;
    u16* dnd = dn + (size_t)dir * 5 * 4096;
    bf16x8 af[2][4];
#pragma unroll
    for (int mt = 0; mt < 2; ++mt)
#pragma unroll
      for (int ks = 0; ks < 4; ++ks) af[mt][ks] = *(const bf16x8*)(Aop + (mt * 32 + lr) * 64 + ks * 16 + lh * 8);
    {
      f32x16 acc[2][2];
#pragma unroll
      for (int a = 0; a < 2; ++a)
#pragma unroll
        for (int b = 0; b < 2; ++b)
#pragma unroll
          for (int i = 0; i < 16; ++i) acc[a][b][i] = 0.f;
#pragma unroll
      for (int nt = 0; nt < 2; ++nt)
#pragma unroll
        for (int ks = 0; ks < 4; ++ks) {
          bf16x8 b = *(const bf16x8*)(XT + (nt * 32 + lr) * 64 + ks * 16 + lh * 8);
          acc[0][nt] = MFMA32(af[0][ks], b, acc[0][nt]);
          acc[1][nt] = MFMA32(af[1][ks], b, acc[1][nt]);
        }
      u16* dst = dnd + (prod ? 3 : 1) * 4096;
#pragma unroll
      for (int mt = 0; mt < 2; ++mt)
#pragma unroll
        for (int nt = 0; nt < 2; ++nt)
#pragma unroll
          for (int g4 = 0; g4 < 4; ++g4) {
            uint2 o = {pk2(acc[mt][nt][4 * g4], acc[mt][nt][4 * g4 + 1]), pk2(acc[mt][nt][4 * g4 + 2], acc[mt][nt][4 * g4 + 3])};
            if (prod) {
              *(uint2*)(dst + (nt * 32 + lr) * 64 + mt * 32 + 8 * g4 + 4 * lh) = o;
            } else {
              const int dvv = nt * 32 + lr;
              const int mm = 2 * mt + (g4 >> 1), qq = 2 * (g4 & 1) + lh;
              *(uint2*)(dst + (((dvv >> 4) * 64 + qq * 16 + (dvv & 15)) * 4 + mm) * 4) = o;
            }
          }
    }
    {
      f32x16 acc[2][2];
#pragma unroll
      for (int a = 0; a < 2; ++a)
#pragma unroll
        for (int b = 0; b < 2; ++b)
#pragma unroll
          for (int i = 0; i < 16; ++i) acc[a][b][i] = 0.f;
#pragma unroll
      for (int mt = 0; mt < 2; ++mt)
#pragma unroll
        for (int ks = 0; ks < 4; ++ks) {
          bf16x8 a = *(const bf16x8*)(XT + (64 + mt * 32 + lr) * 64 + ks * 16 + lh * 8);
          acc[mt][0] = MFMA32(a, af[0][ks], acc[mt][0]);
          acc[mt][1] = MFMA32(a, af[1][ks], acc[mt][1]);
        }
      u16* dst = dnd + (prod ? 2 : 0) * 4096;
#pragma unroll
      for (int nt = 0; nt < 2; ++nt) {
        const int n = nt * 32 + lr;
        const int i = dir ? 63 - n : n;
        const float eg = __expf(sgc[dir * 64 + n]);
#pragma unroll
        for (int mt = 0; mt < 2; ++mt)
#pragma unroll
          for (int g4 = 0; g4 < 4; ++g4) {
            const int d0 = mt * 32 + 8 * g4 + 4 * lh;
            float v0 = acc[mt][nt][4 * g4], v1 = acc[mt][nt][4 * g4 + 1], v2 = acc[mt][nt][4 * g4 + 2], v3 = acc[mt][nt][4 * g4 + 3];
            if (prod) {
              v0 = sq[i * 65 + d0] * eg - v0;
              v1 = sq[i * 65 + d0 + 1] * eg - v1;
              v2 = sq[i * 65 + d0 + 2] * eg - v2;
              v3 = sq[i * 65 + d0 + 3] * eg - v3;
            }
            uint2 o = {pk2(v0, v1), pk2(v2, v3)};
            if (prod) {
              *(uint2*)(dst + n * 64 + d0) = o;
            } else {
              const int mm = n >> 4, cnn = n & 15, ss = mt, hif = g4 >> 1, qq = 2 * (g4 & 1) + lh;
              *(uint2*)(dst + ((mm * 2 + ss) * 64 + qq * 16 + cnn) * 8 + 4 * hif) = o;
            }
          }
      }
    }
  }
  __syncthreads();
}

DI void s5_coeffs(const Params& p, int l, int dir, int g, int pp, float& a_re, float& a_im, float* b_re, float* b_im) {
  const int gi = (l * 2 + dir) * 16 + g;
  const int idx = gi * 64 + pp;
  const float lr = p.A_re[idx], lim = p.A_im[idx];
  const float dt = expf(p.log_dt[gi]);
  const float mag = expf(lr * dt);
  const float ang = lim * dt;
  float sn, cs;
  sincosf(ang, &sn, &cs);
  a_re = mag * cs;
  a_im = mag * sn;
  const float nr = a_re - 1.f, ni = a_im;
  const float den = 1.f / (lr * lr + lim * lim);
  const float c_re = (nr * lr + ni * lim) * den;
  const float c_im = (ni * lr - nr * lim) * den;
  const float* Br = p.B_re + (size_t)idx * 16;
  const float* Bi = p.B_im + (size_t)idx * 16;
#pragma unroll
  for (int c = 0; c < 16; ++c) {
    float br = Br[c], bi = Bi[c];
    b_re[c] = c_re * br - c_im * bi;
    b_im[c] = c_re * bi + c_im * br;
  }
}


constexpr int S5_WAVE_LDS = 12800;
DI void s5_wave_sync() { asm volatile("s_waitcnt lgkmcnt(0)" ::: "memory"); }
DI void s5_bfrags(u16* sbw, const float* b_re, const float* b_im, int lane, bf16x8* bfrag) {
  *(uint4*)(sbw + lane * 32) = make_uint4(pk2(b_re[0], b_re[1]), pk2(b_re[2], b_re[3]), pk2(b_re[4], b_re[5]), pk2(b_re[6], b_re[7]));
  *(uint4*)(sbw + lane * 32 + 8) = make_uint4(pk2(b_re[8], b_re[9]), pk2(b_re[10], b_re[11]), pk2(b_re[12], b_re[13]), pk2(b_re[14], b_re[15]));
  *(uint4*)(sbw + lane * 32 + 16) = make_uint4(pk2(b_im[0], b_im[1]), pk2(b_im[2], b_im[3]), pk2(b_im[4], b_im[5]), pk2(b_im[6], b_im[7]));
  *(uint4*)(sbw + lane * 32 + 24) = make_uint4(pk2(b_im[8], b_im[9]), pk2(b_im[10], b_im[11]), pk2(b_im[12], b_im[13]), pk2(b_im[14], b_im[15]));
  s5_wave_sync();
  const int n = lane & 15, q4 = lane >> 4;
  const unsigned keep = (q4 < 2) ? 0xffffffffu : 0u;
#pragma unroll
  for (int nt = 0; nt < 8; ++nt) {
    const int state = 16 * (nt & 3) + n, part = nt >> 2;
    uint4 v = *(const uint4*)(sbw + state * 32 + part * 16 + 8 * (q4 & 1));
    bfrag[nt] = mk8u(v.x & keep, v.y & keep, v.z & keep, v.w & keep);
  }
}
DI void s5_bu_slab(const float* su, int wave, int dir, int s, int lane, const bf16x8* bfrag, u16* busw) {
  const int n = lane & 15, q4 = lane >> 4;
  const int li = 16 * s + n;
  const int i = dir ? 63 - li : li;
  const float* ur = su + i * 64 + wave * 16 + 8 * (q4 & 1);
  const float4 u0 = *(const float4*)ur, u1 = *(const float4*)(ur + 4);
  const unsigned keep = (q4 < 2) ? 0xffffffffu : 0u;
  const bf16x8 a = mk8u(pk2(u0.x, u0.y) & keep, pk2(u0.z, u0.w) & keep, pk2(u1.x, u1.y) & keep, pk2(u1.z, u1.w) & keep);
#pragma unroll
  for (int nt = 0; nt < 8; ++nt) {
    f32x4 acc = {0.f, 0.f, 0.f, 0.f};
    acc = MFMA16(a, bfrag[nt], acc);
    const int col = (nt >> 2) * 64 + 16 * (nt & 3) + n;
#pragma unroll
    for (int j = 0; j < 4; ++j) busw[(4 * q4 + j) * 136 + col] = f2bf(acc[j]);
  }
  s5_wave_sync();
}

DI void s5_a_item(const Params& p, int l, int item, char* smem) {
  const int quarter = item & 3, dir = (item >> 2) & 1, cid = item >> 3;
  const int tid = otid(), lane = tid & 63, wave = tid >> 6;
  const int g = quarter * 4 + wave;
  float* su = (float*)smem;
  const float* uC = (const float*)(p.ws + OFF_UC);
  for (int e = tid; e < 64 * 16; e += 256) {
    int i = e >> 4, c4 = e & 15;
    *(float4*)(su + i * 64 + c4 * 4) = *(const float4*)(uC + (size_t)(cid * 64 + i) * 256 + quarter * 64 + c4 * 4);
  }
  float a_re, a_im, b_re[16], b_im[16];
  s5_coeffs(p, l, dir, g, lane, a_re, a_im, b_re, b_im);
  u16* wl = (u16*)(smem + 16384 + wave * S5_WAVE_LDS);
  u16* busw = wl + 2176;
  u16* sbw = wl + 4352;
  bf16x8 bfrag[8];
  s5_bfrags(sbw, b_re, b_im, lane, bfrag);
  __syncthreads();
  float h_re = 0.f, h_im = 0.f;
  for (int s4 = 0; s4 < 4; ++s4) {
    s5_bu_slab(su, wave, dir, s4, lane, bfrag, busw);
#pragma unroll
    for (int r = 0; r < 16; ++r) {
      const float bu_re = bf2f(busw[r * 136 + lane]), bu_im = bf2f(busw[r * 136 + 64 + lane]);
      float nr = a_re * h_re - a_im * h_im + bu_re;
      float ni = a_re * h_im + a_im * h_re + bu_im;
      h_re = nr; h_im = ni;
    }
    s5_wave_sync();
  }
  float2* E = (float2*)(p.ws + OFF_S5E);
  E[((size_t)(cid * 2 + dir) * 16 + g) * 64 + lane] = make_float2(h_re, h_im);
  __syncthreads();
}

DI int chain_cid(int dir, int pos) { return dir == 0 ? pos : (pos < 4 ? 3 - pos : 263 - pos); }

DI void s5_carry(const Params& p, int l, int sblk) {
  const int id = sblk * 256 + otid();
  const int dir = id >> 10, g = (id >> 6) & 15, pp = id & 63;
  const int gi = (l * 2 + dir) * 16 + g;
  const float lr = p.A_re[gi * 64 + pp], lim = p.A_im[gi * 64 + pp];
  const float dt = expf(p.log_dt[gi]);
  const float mag = expf(lr * dt);
  float sn, cs;
  sincosf(lim * dt, &sn, &cs);
  float ar = mag * cs, ai = mag * sn;
#pragma unroll
  for (int i = 0; i < 6; ++i) { float nr = ar * ar - ai * ai, ni = 2.f * ar * ai; ar = nr; ai = ni; }
  const float2* E = (const float2*)(p.ws + OFF_S5E);
  float2* H = (float2*)(p.ws + OFF_S5H);
  float hr = 0.f, hi = 0.f;
  asm volatile("" : "+v"(hr), "+v"(hi));
  for (int pos0 = 0; pos0 < NCH; pos0 += 20) {
    float2 e[20];
    size_t o[20];
#pragma unroll
    for (int u = 0; u < 20; ++u) {
      int cid = chain_cid(dir, pos0 + u);
      o[u] = ((size_t)(cid * 2 + dir) * 16 + g) * 64 + pp;
      e[u] = E[o[u]];
    }
#pragma unroll
    for (int u = 0; u < 20; ++u) {
      H[o[u]] = make_float2(hr, hi);
      float nr = ar * hr - ai * hi + e[u].x;
      float ni = ar * hi + ai * hr + e[u].y;
      hr = nr; hi = ni;
    }
  }
}

DI void s5_c_item(const Params& p, int l, int item, char* smem) {
  const int quarter = item & 3, cid = item >> 2;
  const int tid = otid(), lane = tid & 63, wave = tid >> 6;
  const int g = quarter * 4 + wave;
  float* su = (float*)smem;
  u16* hs = (u16*)(smem + 16384 + wave * S5_WAVE_LDS);
  u16* busw = hs + 2176;
  u16* sbw = hs + 4352;
  const float* uC = (const float*)(p.ws + OFF_UC);
  const float2* Hin = (const float2*)(p.ws + OFF_S5H);
  u16* zg = (u16*)(p.ws + OFF_QB);
  for (int e = tid; e < 64 * 16; e += 256) {
    int i = e >> 4, c4 = e & 15;
    *(float4*)(su + i * 64 + c4 * 4) = *(const float4*)(uC + (size_t)(cid * 64 + i) * 256 + quarter * 64 + c4 * 4);
  }
  __syncthreads();
  const int cc = lane & 15, q4 = lane >> 4;
  f32x4 yacc[4];
#pragma unroll
  for (int t = 0; t < 4; ++t) yacc[t] = (f32x4){0.f, 0.f, 0.f, 0.f};
#pragma unroll
  for (int dir = 0; dir < 2; ++dir) {
    float a_re, a_im, b_re[16], b_im[16];
    s5_coeffs(p, l, dir, g, lane, a_re, a_im, b_re, b_im);
    bf16x8 cf[4];
    {
      const size_t cb = ((size_t)((l * 2 + dir) * 16 + g) * 16 + cc) * 64;
#pragma unroll
      for (int s = 0; s < 4; ++s) {
        const float* src = (s < 2 ? p.C_re : p.C_im) + cb + 32 * (s & 1) + 8 * q4;
        const float sgn = (s < 2) ? 1.f : -1.f;
        float4 v0 = *(const float4*)src, v1 = *(const float4*)(src + 4);
        cf[s] = mk8u(pk2(sgn * v0.x, sgn * v0.y), pk2(sgn * v0.z, sgn * v0.w), pk2(sgn * v1.x, sgn * v1.y),
                     pk2(sgn * v1.z, sgn * v1.w));
      }
    }
    bf16x8 bfrag[8];
    s5_bfrags(sbw, b_re, b_im, lane, bfrag);
    float2 h0 = Hin[((size_t)(cid * 2 + dir) * 16 + g) * 64 + lane];
    float h_re = h0.x, h_im = h0.y;
#pragma unroll
    for (int s = 0; s < 4; ++s) {
      s5_bu_slab(su, wave, dir, s, lane, bfrag, busw);
#pragma unroll
      for (int r = 0; r < 16; ++r) {
        const float bu_re = bf2f(busw[r * 136 + lane]), bu_im = bf2f(busw[r * 136 + 64 + lane]);
        float nr = a_re * h_re - a_im * h_im + bu_re;
        float ni = a_re * h_im + a_im * h_re + bu_im;
        h_re = nr; h_im = ni;
        const int rr = dir ? 15 - r : r;
        hs[rr * 136 + lane] = f2bf(h_re);
        hs[rr * 136 + 64 + lane] = f2bf(h_im);
      }
      asm volatile("s_waitcnt lgkmcnt(0)" ::: "memory");
      const int tile = dir ? 3 - s : s;
#pragma unroll
      for (int ks = 0; ks < 4; ++ks) {
        bf16x8 a = *(const bf16x8*)(hs + cc * 136 + 32 * ks + 8 * q4);
        yacc[tile] = MFMA16(a, cf[ks], yacc[tile]);
      }
      asm volatile("s_waitcnt lgkmcnt(0)" ::: "memory");
    }
  }
  const int ch = g * 16 + cc;
  const float dsk = p.Dskip[l * 256 + ch];
#pragma unroll
  for (int tile = 0; tile < 4; ++tile)
#pragma unroll
    for (int j = 0; j < 4; ++j) {
      const int t = 16 * tile + 4 * q4 + j;
      float y = yacc[tile][j] + su[t * 64 + wave * 16 + cc] * dsk;
      zg[(size_t)(cid * 64 + t) * 256 + ch] = f2bf(gelu_tanh(y));
    }
  __syncthreads();
}

DI void dn_out_item(const Params& p, int l, int unit, char* smem) {
  const int cid = unit >> 2, head = unit & 3;
  const int tid = otid(), lane = tid & 63, wave = tid >> 6;
  const int lr = lane & 31, lh = lane >> 5;
  float* so = (float*)smem;
  const u16* gates = (const u16*)(p.ws + OFF_GATES);
  u16* mix = (u16*)(p.ws + OFF_H);
  const int dir = wave >> 1, mt = wave & 1;
  const u16* dnd = (const u16*)(p.ws + OFF_DN) + ((size_t)unit * 2 + dir) * 5 * 4096;
  const u16* Pm = dnd + 2 * 4096, *RT = dnd + 3 * 4096, *ST = dnd + 4 * 4096;
  f32x16 acc[2];
#pragma unroll
  for (int nt = 0; nt < 2; ++nt)
#pragma unroll
    for (int i = 0; i < 16; ++i) acc[nt][i] = 0.f;
#pragma unroll
  for (int ks = 0; ks < 4; ++ks) {
    bf16x8 a = *(const bf16x8*)(Pm + (mt * 32 + lr) * 64 + ks * 16 + lh * 8);
#pragma unroll
    for (int nt = 0; nt < 2; ++nt) {
      bf16x8 b = *(const bf16x8*)(ST + (nt * 32 + lr) * 64 + ks * 16 + lh * 8);
      acc[nt] = MFMA32(a, b, acc[nt]);
    }
  }
#pragma unroll
  for (int nt = 0; nt < 2; ++nt)
#pragma unroll
    for (int g4 = 0; g4 < 4; ++g4) {
      uint2 rr = *(const uint2*)(RT + (nt * 32 + lr) * 64 + mt * 32 + 8 * g4 + 4 * lh);
      acc[nt][4 * g4 + 0] += bf2f((u16)(rr.x & 0xffff));
      acc[nt][4 * g4 + 1] += bf2f((u16)(rr.x >> 16));
      acc[nt][4 * g4 + 2] += bf2f((u16)(rr.y & 0xffff));
      acc[nt][4 * g4 + 3] += bf2f((u16)(rr.y >> 16));
    }
  if (dir == 0) {
#pragma unroll
    for (int nt = 0; nt < 2; ++nt)
#pragma unroll
      for (int i = 0; i < 16; ++i) {
        const int li = mt * 32 + (i & 3) + 8 * (i >> 2) + 4 * lh;
        so[li * 65 + nt * 32 + lr] = acc[nt][i];
      }
  }
  __syncthreads();
  if (dir == 1) {
#pragma unroll
    for (int nt = 0; nt < 2; ++nt)
#pragma unroll
      for (int i = 0; i < 16; ++i) {
        const int li = mt * 32 + (i & 3) + 8 * (i >> 2) + 4 * lh;
        so[(63 - li) * 65 + nt * 32 + lr] += acc[nt][i];
      }
  }
  __syncthreads();
  const float gain = p.out_gain[l * 64 + lane];
#pragma unroll
  for (int i0 = 0; i0 < 16; ++i0) {
    const int i = wave + 4 * i0;
    const size_t tt = (size_t)cid * 64 + i;
    const int c = head * 64 + lane;
    float o = so[i * 65 + lane];
    float ms = wave_sum(o * o) * (1.f / 64.f);
    float v = o * rsqrtf(ms + EPS) * gain * bf2f(gates[tt * 1024 + 512 + c]);
    mix[tt * 1024 + 512 + c] = f2bf(v);
  }
  __syncthreads();
}

#define SCAN_LOAD(U, POS)                                                                      \
  {                                                                                            \
    const int cid_ = chain_cid(dir, (POS));                                                    \
    const u16* base_ = dnb + ((size_t)(cid_ * 4 + head) * 2 + dir) * 5 * 4096;                 \
    _Pragma("unroll") for (int m = 0; m < 4; ++m) {                                            \
      _Pragma("unroll") for (int s2 = 0; s2 < 2; ++s2) {                                       \
        const uint4 t_ = *(const uint4*)(base_ + ((m * 2 + s2) * 64 + lane) * 8);              \
        mlo##U[m][s2] = make_uint2(t_.x, t_.y);                                                \
        mhi##U[m][s2] = make_uint2(t_.z, t_.w);                                                \
      }                                                                                        \
    }                                                                                          \
    {                                                                                          \
      const uint4 t0_ = *(const uint4*)(base_ + 4096 + (cgp * 64 + lane) * 16);                \
      const uint4 t1_ = *(const uint4*)(base_ + 4096 + (cgp * 64 + lane) * 16 + 8);            \
      ntv##U[0] = make_uint2(t0_.x, t0_.y); ntv##U[1] = make_uint2(t0_.z, t0_.w);              \
      ntv##U[2] = make_uint2(t1_.x, t1_.y); ntv##U[3] = make_uint2(t1_.z, t1_.w);              \
    }                                                                                          \
    gl##U = glast[(cid_ * 4 + head) * 2 + dir];                                                \
  }
#define SCAN_COMPUTE(U, POS)                                                                   \
  {                                                                                            \
    const int cid_ = chain_cid(dir, (POS));                                                    \
    u16* STp_ = dnb + (((size_t)(cid_ * 4 + head) * 2 + dir) * 5 + 4) * 4096 + dv * 64 + 4 * q4; \
    unsigned pk_[4][2];                                                                        \
    _Pragma("unroll") for (int m = 0; m < 4; ++m) {                                            \
      pk_[m][0] = pk2(S[m][0], S[m][1]);                                                       \
      pk_[m][1] = pk2(S[m][2], S[m][3]);                                                       \
      *(uint2*)(STp_ + 16 * m) = make_uint2(pk_[m][0], pk_[m][1]);                             \
    }                                                                                          \
    bf16x8 sb0_ = mk8u(pk_[0][0], pk_[0][1], pk_[1][0], pk_[1][1]);                            \
    bf16x8 sb1_ = mk8u(pk_[2][0], pk_[2][1], pk_[3][0], pk_[3][1]);                            \
    _Pragma("unroll") for (int m = 0; m < 4; ++m) {                                            \
      f32x4 acc_ = {0.f, 0.f, 0.f, 0.f};                                                       \
      acc_ = MFMA16(mk8(mlo##U[m][0], mhi##U[m][0]), sb0_, acc_);                              \
      acc_ = MFMA16(mk8(mlo##U[m][1], mhi##U[m][1]), sb1_, acc_);                              \
      S[m][0] = gl##U * S[m][0] - acc_[0] + bf2f((u16)(ntv##U[m].x & 0xffff));                 \
      S[m][1] = gl##U * S[m][1] - acc_[1] + bf2f((u16)(ntv##U[m].x >> 16));                    \
      S[m][2] = gl##U * S[m][2] - acc_[2] + bf2f((u16)(ntv##U[m].y & 0xffff));                 \
      S[m][3] = gl##U * S[m][3] - acc_[3] + bf2f((u16)(ntv##U[m].y >> 16));                    \
    }                                                                                          \
  }
DI void dn_scan_wave(const Params& p, int task) {
  const int head = task & 3, dir = (task >> 2) & 1, cgp = task >> 3;
  const int lane = otid() & 63;
  const int cn = lane & 15, q4 = lane >> 4;
  const int dv = cgp * 16 + cn;
  u16* dnb = (u16*)(p.ws + OFF_DN);
  const float* glast = (const float*)(p.ws + OFF_GLAST);
  f32x4 S[4];
#pragma unroll
  for (int m = 0; m < 4; ++m) S[m] = (f32x4){0.f, 0.f, 0.f, 0.f};
  uint2 mlo0[4][2], mhi0[4][2], ntv0[4]; float gl0;
  uint2 mlo1[4][2], mhi1[4][2], ntv1[4]; float gl1;
  uint2 mlo2[4][2], mhi2[4][2], ntv2[4]; float gl2;
  uint2 mlo3[4][2], mhi3[4][2], ntv3[4]; float gl3;
  SCAN_LOAD(0, 0) SCAN_LOAD(1, 1) SCAN_LOAD(2, 2) SCAN_LOAD(3, 3)
  for (int pos0 = 0; pos0 < NCH; pos0 += 4) {
    const bool more = pos0 + 4 < NCH;
    SCAN_COMPUTE(0, pos0) if (more) SCAN_LOAD(0, pos0 + 4)
    SCAN_COMPUTE(1, pos0 + 1) if (more) SCAN_LOAD(1, pos0 + 5)
    SCAN_COMPUTE(2, pos0 + 2) if (more) SCAN_LOAD(2, pos0 + 6)
    SCAN_COMPUTE(3, pos0 + 3) if (more) SCAN_LOAD(3, pos0 + 7)
  }
}

constexpr int A_LD = 72;
constexpr int V_LD = 136;
DI void attn_item(const Params& p, int item, char* smem) {
  int head, q0, ntiles;
  if (item < 512) { head = item & 7; q0 = NCTX + (item >> 3) * 256; ntiles = NCH; }
  else { head = item - 512; q0 = 0; ntiles = 4; }
  const int kvh = head >> 2;
  const int tid = otid(), lane = tid & 63, wave = tid >> 6;
  const int lr = lane & 31, lh = lane >> 5;
  const u16* Qb = (const u16*)(p.ws + OFF_QB) + (size_t)head * T * 64;
  const u16* Kb = (const u16*)(p.ws + OFF_KB) + (size_t)kvh * T * 64;
  const u16* Vt = (const u16*)(p.ws + OFF_VT) + (size_t)kvh * 64 * T;
  u16* Ks = (u16*)smem;
  u16* Vs = Ks + 2 * 128 * A_LD;
  bf16x8 qf[2][4];
#pragma unroll
  for (int qt = 0; qt < 2; ++qt)
#pragma unroll
    for (int ks = 0; ks < 4; ++ks)
      qf[qt][ks] = *(const bf16x8*)(Qb + (size_t)(q0 + wave * 64 + qt * 32 + lr) * 64 + ks * 16 + lh * 8);

  f32x16 ot[2][2];
#pragma unroll
  for (int a = 0; a < 2; ++a)
#pragma unroll
    for (int b = 0; b < 2; ++b)
#pragma unroll
      for (int i = 0; i < 16; ++i) ot[a][b][i] = 0.f;
  float lrun[2] = {0.f, 0.f};

  uint4 rk0, rk1, rv0, rv1;
  const int srow = tid >> 3, sch = tid & 7;
  const u16* Kg = Kb + (size_t)srow * 64 + sch * 8;
  const u16* Vg = Vt + (size_t)srow * T + sch * 8;
#define A_LOAD(J_)                                                               \
  {                                                                              \
    const u16* kg_ = Kg + (size_t)(J_) * 4096;                                   \
    const u16* vg_ = Vg + (size_t)(J_) * 64;                                     \
    rk0 = *(const uint4*)(kg_);  rk1 = *(const uint4*)(kg_ + 32 * 64);           \
    rv0 = *(const uint4*)(vg_);  rv1 = *(const uint4*)(vg_ + (size_t)32 * T);    \
  }
#define A_STORE(BUF_, HALF_)                                                     \
  {                                                                              \
    u16* ks_ = Ks + ((BUF_) * 128 + (HALF_) * 64 + srow) * A_LD + sch * 8;       \
    u16* vs_ = Vs + ((BUF_) * 64 + srow) * V_LD + (HALF_) * 64 + sch * 8;        \
    *(uint4*)(ks_) = rk0;  *(uint4*)(ks_ + 32 * A_LD) = rk1;                     \
    *(uint4*)(vs_) = rv0;  *(uint4*)(vs_ + 32 * V_LD) = rv1;                     \
  }
  A_LOAD(0)
  A_STORE(0, 0)
  A_LOAD(1)
  A_STORE(0, 1)
  __syncthreads();
  const int npairs = ntiles >> 1;
  for (int jj = 0; jj < npairs; ++jj) {
    const int buf = jj & 1;
    const int jnext = (jj + 1 < npairs ? jj + 1 : jj) * 2;
#pragma unroll 1
    for (int half = 0; half < 2; ++half) {
    A_LOAD(jnext + half)
    __builtin_amdgcn_sched_barrier(0);
    const u16* Kt = Ks + (buf * 128 + half * 64) * A_LD;
    const u16* Vtile = Vs + buf * 64 * V_LD + half * 64;
    f32x16 st[2][2];
#pragma unroll
    for (int a = 0; a < 2; ++a)
#pragma unroll
      for (int b = 0; b < 2; ++b)
#pragma unroll
        for (int i = 0; i < 16; ++i) st[a][b][i] = 0.f;
    {
      bf16x8 kf[2][4];
#pragma unroll
      for (int kt = 0; kt < 2; ++kt)
#pragma unroll
        for (int ks = 0; ks < 4; ++ks) kf[kt][ks] = *(const bf16x8*)(Kt + (kt * 32 + lr) * A_LD + ks * 16 + lh * 8);
      __builtin_amdgcn_sched_barrier(0);
#pragma unroll
      for (int kt = 0; kt < 2; ++kt)
#pragma unroll
        for (int ks = 0; ks < 4; ++ks) {
          st[kt][0] = MFMA32(kf[kt][ks], qf[0][ks], st[kt][0]);
          st[kt][1] = MFMA32(kf[kt][ks], qf[1][ks], st[kt][1]);
        }
    }
#pragma unroll
    for (int kt = 0; kt < 2; ++kt) {
#pragma unroll
      for (int qt = 0; qt < 2; ++qt) {
        float ls0 = 0.f, ls1 = 0.f;
#pragma unroll
        for (int i = 0; i < 16; i += 2) {
          float p0 = __builtin_amdgcn_exp2f(st[kt][qt][i]);
          float p1 = __builtin_amdgcn_exp2f(st[kt][qt][i + 1]);
          st[kt][qt][i] = p0;
          st[kt][qt][i + 1] = p1;
          ls0 += p0;
          ls1 += p1;
        }
        lrun[qt] += ls0 + ls1;
      }
#pragma unroll
      for (int ss = 0; ss < 2; ++ss) {
        bf16x8 pb[2];
#pragma unroll
        for (int qt = 0; qt < 2; ++qt)
          pb[qt] = mk8u(pk2(st[kt][qt][8 * ss + 0], st[kt][qt][8 * ss + 1]), pk2(st[kt][qt][8 * ss + 2], st[kt][qt][8 * ss + 3]),
                        pk2(st[kt][qt][8 * ss + 4], st[kt][qt][8 * ss + 5]), pk2(st[kt][qt][8 * ss + 6], st[kt][qt][8 * ss + 7]));
#pragma unroll
        for (int dt = 0; dt < 2; ++dt) {
          const u16* pr = Vtile + (dt * 32 + lr) * V_LD + 32 * kt + 16 * ss + 4 * lh;
          uint2 lo = *(const uint2*)pr;
          uint2 hi = *(const uint2*)(pr + 8);
          bf16x8 a = mk8(lo, hi);
#pragma unroll
          for (int qt = 0; qt < 2; ++qt) ot[dt][qt] = MFMA32(a, pb[qt], ot[dt][qt]);
        }
      }
    }
    __builtin_amdgcn_sched_barrier(0);
    A_STORE(buf ^ 1, half)
    }
    __syncthreads();
  }
  const u16* gates = (const u16*)(p.ws + OFF_GATES);
  u16* mix = (u16*)(p.ws + OFF_H);
#pragma unroll
  for (int qt = 0; qt < 2; ++qt) {
    const float lt = lrun[qt] + __shfl_xor(lrun[qt], 32);
    const float inv = 1.f / lt;
    const size_t row = (size_t)(q0 + wave * 64 + qt * 32 + lr);
#pragma unroll
    for (int dt = 0; dt < 2; ++dt)
#pragma unroll
      for (int g4 = 0; g4 < 4; ++g4) {
        const int d0 = 32 * dt + 8 * g4 + 4 * lh;
        uint2 gg = *(const uint2*)(gates + row * 1024 + head * 64 + d0);
        float o0 = ot[dt][qt][4 * g4 + 0] * inv * bf2f((u16)(gg.x & 0xffff));
        float o1 = ot[dt][qt][4 * g4 + 1] * inv * bf2f((u16)(gg.x >> 16));
        float o2 = ot[dt][qt][4 * g4 + 2] * inv * bf2f((u16)(gg.y & 0xffff));
        float o3 = ot[dt][qt][4 * g4 + 3] * inv * bf2f((u16)(gg.y >> 16));
        uint2 o = {pk2(o0, o1), pk2(o2, o3)};
        *(uint2*)(mix + row * 1024 + head * 64 + d0) = o;
      }
  }
}

DI void final_ln_phase(const Params& p, int l, const float* ctx_src, const float* lat_src) {
  const int lane = otid() & 63, wave = otid() >> 6;
  const int nw = gridDim.x * 4;
  const float* y = (const float*)(p.ws + OFF_DN);
  const float* modv = (const float*)(p.ws + OFF_MODV);
  float* ctx1 = (float*)(p.ws + OFF_CTX1);
  u16* h = (u16*)(p.ws + OFF_H);
  const int rstart = (l == 1) ? NCTX : 0;
  for (int r = rstart + blockIdx.x * 4 + wave; r < T; r += nw) {
    const bool isc = r < NCTX;
    const float* src = isc ? ctx_src + (size_t)r * DM : lat_src + (size_t)(r - NCTX) * DM;
    float* dst = isc ? ctx1 + (size_t)r * DM : p.out + (size_t)(r - NCTX) * DM;
    const float* mod = modv + (l * 2 + (isc ? 1 : 0)) * 3072;
    float4 v[4];
    float s = 0.f;
#pragma unroll
    for (int i = 0; i < 4; ++i) {
      int c0 = (i * 64 + lane) * 4;
      float4 xv = *(const float4*)(src + c0);
      float4 yv = *(const float4*)(y + (size_t)r * DM + c0);
      float4 gv = *(const float4*)(mod + 2048 + c0);
      v[i].x = DN_ALPHA * xv.x + gv.x * yv.x;
      v[i].y = DN_ALPHA * xv.y + gv.y * yv.y;
      v[i].z = DN_ALPHA * xv.z + gv.z * yv.z;
      v[i].w = DN_ALPHA * xv.w + gv.w * yv.w;
      s += v[i].x + v[i].y + v[i].z + v[i].w;
    }
    float mu = wave_sum(s) * (1.f / DM);
    float q = 0.f;
#pragma unroll
    for (int i = 0; i < 4; ++i) {
      v[i].x -= mu; v[i].y -= mu; v[i].z -= mu; v[i].w -= mu;
      q += v[i].x * v[i].x + v[i].y * v[i].y + v[i].z * v[i].z + v[i].w * v[i].w;
    }
    float rstd = rsqrtf(wave_sum(q) * (1.f / DM) + EPS);
    float s2 = 0.f;
#pragma unroll
    for (int i = 0; i < 4; ++i) {
      int c0 = (i * 64 + lane) * 4;
      float4 g = *(const float4*)(p.ln_g + l * DM + c0);
      float4 b = *(const float4*)(p.ln_b + l * DM + c0);
      v[i].x = v[i].x * rstd * g.x + b.x;
      v[i].y = v[i].y * rstd * g.y + b.y;
      v[i].z = v[i].z * rstd * g.z + b.z;
      v[i].w = v[i].w * rstd * g.w + b.w;
      *(float4*)(dst + c0) = v[i];
      s2 += v[i].x + v[i].y + v[i].z + v[i].w;
    }
    if (l == 0) {
      const float* mod1 = modv + (2 + (isc ? 1 : 0)) * 3072;
      float mu2 = wave_sum(s2) * (1.f / DM);
      float q2 = 0.f;
#pragma unroll
      for (int i = 0; i < 4; ++i) {
        v[i].x -= mu2; v[i].y -= mu2; v[i].z -= mu2; v[i].w -= mu2;
        q2 += v[i].x * v[i].x + v[i].y * v[i].y + v[i].z * v[i].z + v[i].w * v[i].w;
      }
      float rstd2 = rsqrtf(wave_sum(q2) * (1.f / DM) + EPS);
#pragma unroll
      for (int i = 0; i < 4; ++i) {
        int c0 = (i * 64 + lane) * 4;
        float4 sh = *(const float4*)(mod1 + c0);
        float4 sc = *(const float4*)(mod1 + 1024 + c0);
        float o0 = v[i].x * rstd2 * (1.f + sc.x) + sh.x;
        float o1 = v[i].y * rstd2 * (1.f + sc.y) + sh.y;
        float o2 = v[i].z * rstd2 * (1.f + sc.z) + sh.z;
        float o3 = v[i].w * rstd2 * (1.f + sc.w) + sh.w;
        uint2 pk = {pk2(o0, o1), pk2(o2, o3)};
        *(uint2*)(h + (size_t)r * DM + c0) = pk;
      }
    }
  }
}

#ifndef REP_ATTN
#define REP_ATTN 1
#endif
#ifndef REP_SCAN
#define REP_SCAN 1
#endif
#ifndef REP_GEMM
#define REP_GEMM 1
#endif
#ifndef REP_PREP
#define REP_PREP 1
#endif
#ifndef REP_P5
#define REP_P5 1
#endif
typedef const __attribute__((address_space(4))) Params* KParamsPtr;
DI const Params& kp() {
  KParamsPtr q = (KParamsPtr)__builtin_amdgcn_kernarg_segment_ptr();
  asm volatile("" : "+s"(q));
  return *(const Params*)q;
}
__global__ void __launch_bounds__(256, 2) fwd_megakernel(Params pin) {
  cg::grid_group grid = cg::this_grid();
  __shared__ __attribute__((aligned(16))) char smem[SMEM_BYTES];
  const int nb = gridDim.x;
  __shared__ uint4 xb_words;
  if (threadIdx.x == 0) xb_words = make_uint4(0u, 0u, 0u, 0u);
  __syncthreads();
  (void)xcd_barrier_post((unsigned*)(kp().ws + OFF_BAR), (volatile LAS unsigned*)&xb_words);
#define GRID_BARRIER() do { XcdBarrier xb_; xb_.bar = (unsigned*)(kp().ws + OFF_BAR); xb_.x = xb_xcc_id(); xb_.st = (volatile LAS unsigned*)&xb_words; xcd_barrier(xb_); } while (0)

  if (kp().ws == nullptr) grid.sync();
  setup_phase(kp(), smem);
  GRID_BARRIER();
  { const Params& p = kp(); ln_mod_phase(p, p.ctx, p.x, 0); }
  GRID_BARRIER();

  for (int l = 0; l < 2; ++l) {
    for (int rep = 0; rep < REP_GEMM; ++rep) gemm_in_phase(kp(), l, smem);
    GRID_BARRIER();
    for (int rep = 0; rep < REP_PREP; ++rep)
    for (int item = blockIdx.x; item < 1040 + 2080; item += nb) {
      if (item < 1040) dn_prep_item(kp(), l, item, smem);
      else s5_a_item(kp(), l, item - 1040, smem);
    }
    GRID_BARRIER();
    for (int rep = 0; rep < REP_SCAN; ++rep)
    for (int item = blockIdx.x; item < 40; item += nb) {
      if (item < 32) { if ((otid() >> 6) == 0) dn_scan_wave(kp(), item); }
      else s5_carry(kp(), l, item - 32);
    }
    GRID_BARRIER();
    for (int rep = 0; rep < REP_ATTN; ++rep)
      for (int item = blockIdx.x; item < 520; item += nb) attn_item(kp(), item, smem);
    GRID_BARRIER();
    for (int rep = 0; rep < REP_P5; ++rep)
    for (int item = blockIdx.x; item < 1040 + 1040; item += nb) {
      if (item < 1040) s5_c_item(kp(), l, item, smem);
      else dn_out_item(kp(), l, item - 1040, smem);
    }
    GRID_BARRIER();
    gemm_glu_phase(kp(), l, smem);
    GRID_BARRIER();
    gemm_out_phase(kp(), l, smem);
    GRID_BARRIER();
    {
      const Params& p = kp();
      if (l == 0) final_ln_phase(p, 0, p.ctx, p.x);
      else final_ln_phase(p, 1, (const float*)(p.ws + OFF_CTX1), p.out);
    }
    if (l == 0) GRID_BARRIER();
  }
}

extern "C" void kernel_launch(void* const* d_in, const int* in_sizes, int n_in, void* d_out, int out_size, void* d_ws,
                              size_t ws_size, hipStream_t stream) {
  static int grid_blocks = 0;
  if (!grid_blocks) {
    int dev = 0, cus = 0, per_cu = 0;
    hipGetDevice(&dev);
    hipDeviceGetAttribute(&cus, hipDeviceAttributeMultiprocessorCount, dev);
    hipOccupancyMaxActiveBlocksPerMultiprocessor(&per_cu, fwd_megakernel, 256, 0);
    if (per_cu > 2) per_cu = 2;
    if (per_cu < 1) per_cu = 1;
    grid_blocks = cus * per_cu;
  }
  Params p{};
  const float** pp = (const float**)&p;
  for (int i = 0; i < 26; ++i) pp[i] = (const float*)d_in[i];
  p.out = (float*)d_out;
  p.ws = (char*)d_ws;
  void* args[] = {&p};
  (void)hipMemsetAsync((char*)d_ws + OFF_BAR, 0, XCD_BAR_WORDS * 4, stream);
  hipError_t e = hipLaunchCooperativeKernel((void*)fwd_megakernel, dim3(grid_blocks), dim3(256), args, 0, stream);
  if (e != hipSuccess) fprintf(stderr, "cooperative launch failed: %s (grid %d)\n", hipGetErrorString(e), grid_blocks);
}
```

```cpp
#include <hip/hip_runtime.h>
#include <hip/hip_cooperative_groups.h>
#include <cstdio>
namespace cg = cooperative_groups;

#define DI __device__ __forceinline__
typedef unsigned short u16;
using bf16x8 = __attribute__((ext_vector_type(8))) short;
using f32x16 = __attribute__((ext_vector_type(16))) float;
using f32x4 = __attribute__((ext_vector_type(4))) float;
typedef __bf16 bf2_t __attribute__((ext_vector_type(2)));
typedef float f2_t __attribute__((ext_vector_type(2)));

#define MFMA32(a, b, c) __builtin_amdgcn_mfma_f32_32x32x16_bf16((a), (b), (c), 0, 0, 0)
#define MFMA16(a, b, c) __builtin_amdgcn_mfma_f32_16x16x32_bf16((a), (b), (c), 0, 0, 0)

constexpr int T = 16640;
constexpr int NCTX = 256;
constexpr int DM = 1024;
constexpr int NIN = 2832;
constexpr int NINP = 2944;
constexpr int NCH = 260;
constexpr float EPS = 1e-6f;
constexpr float DN_ALPHA = 1.4142135623730951f;

constexpr size_t al256(size_t x) { return (x + 255) & ~(size_t)255; }
constexpr size_t OFF_WINT = 0;
constexpr size_t OFF_WOUTT = OFF_WINT + al256((size_t)2 * NINP * 1024 * 2);
constexpr size_t OFF_GLUWT = OFF_WOUTT + al256((size_t)2 * 1024 * 1024 * 2);
constexpr size_t OFF_MODV = OFF_GLUWT + al256((size_t)2 * 256 * 256 * 2);
constexpr size_t OFF_ROPE = OFF_MODV + al256((size_t)2 * 2 * 3072 * 4);
constexpr size_t OFF_H = OFF_ROPE + al256((size_t)256 * 16 * 2 * 4);
constexpr size_t OFF_QB = OFF_H + al256((size_t)T * 1024 * 2);
constexpr size_t OFF_KB = OFF_QB + al256((size_t)8 * T * 64 * 2);
constexpr size_t OFF_VT = OFF_KB + al256((size_t)2 * T * 64 * 2);
constexpr size_t OFF_GATES = OFF_VT + al256((size_t)2 * T * 64 * 2);
constexpr size_t OFF_QKVB = OFF_GATES + al256((size_t)T * 1024 * 2);
constexpr size_t OFF_UC = OFF_QKVB + al256((size_t)T * 768 * 2);
constexpr size_t OFF_BD = OFF_UC + al256((size_t)T * 256 * 4);
constexpr size_t OFF_DN = OFF_BD + al256((size_t)T * 16 * 4);
constexpr size_t OFF_GLAST = OFF_DN + al256((size_t)1040 * 2 * 5 * 4096 * 2);
constexpr size_t OFF_S5E = OFF_GLAST + al256((size_t)1040 * 2 * 4);
constexpr size_t OFF_S5H = OFF_S5E + al256((size_t)NCH * 2 * 16 * 64 * 2 * 4);
constexpr size_t OFF_CTX1 = OFF_S5H + al256((size_t)NCH * 2 * 16 * 64 * 2 * 4);
constexpr size_t OFF_BAR = OFF_CTX1 + al256((size_t)256 * 1024 * 4);
constexpr size_t WS_TOTAL = OFF_BAR + 16384;
static_assert(WS_TOTAL <= (size_t)256 * 1024 * 1024, "workspace too large");
static_assert((size_t)T * 1024 * 4 <= (size_t)1040 * 2 * 5 * 4096 * 2, "y alias");

struct Params {
  const float *x, *c, *ctx, *c_ctx, *w_mod, *b_mod, *w_in, *qg, *kg, *conv_w, *A_log, *dt_bias, *out_gain,
      *A_re, *A_im, *log_dt, *B_re, *B_im, *C_re, *C_im, *Dskip, *glu_w, *glu_b, *w_out, *ln_g, *ln_b;
  float* out;
  char* ws;
};

constexpr int SMEM_BYTES = 75 * 1024;

DI float bf2f(u16 v) { return __uint_as_float(((unsigned)v) << 16); }
DI unsigned pk2(float a, float b) {
  f2_t v = {a, b};
  bf2_t r = __builtin_convertvector(v, bf2_t);
  return __builtin_bit_cast(unsigned, r);
}
DI u16 f2bf(float a) { return (u16)(pk2(a, 0.f) & 0xffffu); }
DI float silu_f(float x) { return x / (1.f + __expf(-x)); }
DI float sigmoid_f(float x) { return 1.f / (1.f + __expf(-x)); }
template <int CTRL>
DI float dppf(float v) {
  return __builtin_bit_cast(float, __builtin_amdgcn_update_dpp(0, __builtin_bit_cast(int, v), CTRL, 0xf, 0xf, true));
}
DI float wave_sum(float v) {
  v += dppf<0xB1>(v);
  v += dppf<0x4E>(v);
  v += dppf<0x141>(v);
  v += dppf<0x140>(v);
  v += __shfl_xor(v, 16);
  v += __shfl_xor(v, 32);
  return v;
}
DI int otid() { int t = threadIdx.x; asm volatile("" : "+v"(t)); return t; }
DI float gelu_tanh(float x) {
  float u = 0.7978845608028654f * (x + 0.044715f * x * x * x);
  float t = 1.f - 2.f / (1.f + __expf(2.f * u));
  return 0.5f * x * (1.f + t);
}
DI bf16x8 mk8(uint2 lo, uint2 hi) {
  uint4 v = {lo.x, lo.y, hi.x, hi.y};
  return __builtin_bit_cast(bf16x8, v);
}
DI bf16x8 mk8u(unsigned a, unsigned b, unsigned c, unsigned d) {
  uint4 v = {a, b, c, d};
  return __builtin_bit_cast(bf16x8, v);
}


#define XB_TMO      128
#define XB_XCNT(j)  (256  + 64 * (j))
#define XB_XSUB(j)  (1280 + 64 * (j))
#define XB_XGEN(j)  (2304 + 64 * (j))
#define XB_TOP      3328
#define XB_TOPGEN   3392
#define XCD_BAR_WORDS 3456
#define XB_SPIN_CAP (1u << 18)
#define LAS __attribute__((address_space(3)))
DI unsigned xb_ld(unsigned* p) { return __hip_atomic_load(p, __ATOMIC_RELAXED, __HIP_MEMORY_SCOPE_AGENT); }
DI unsigned xb_add(unsigned* p, unsigned v) { return __hip_atomic_fetch_add(p, v, __ATOMIC_RELAXED, __HIP_MEMORY_SCOPE_AGENT); }
DI unsigned xb_xcc_id() { return (unsigned)__builtin_amdgcn_s_getreg((3 << 11) | 20) & 0xFu; }
#define XB_SPIN(cond, bar) do { unsigned _sp = 0; while (cond) { __builtin_amdgcn_s_sleep(1); \
    if ((++_sp & 255u) == 0u) { if (xb_ld(&(bar)[XB_TMO])) break; if (_sp > XB_SPIN_CAP) { atomicAdd(&(bar)[XB_TMO], 1u); break; } } } } while (0)
struct XcdBarrier { unsigned* bar; unsigned x; volatile LAS unsigned* st; };
DI XcdBarrier xcd_barrier_post(unsigned* bar, volatile LAS unsigned* st) {
  XcdBarrier b; b.bar = bar; b.x = xb_xcc_id(); b.st = st;
  if (threadIdx.x == 0) (void)xb_add(&bar[XB_XCNT(b.x)], 1u);
  return b;
}
DI void xcd_barrier_complete(unsigned* bar, unsigned x, unsigned& nloc, unsigned& nx) {
  const unsigned G = gridDim.x * gridDim.y * gridDim.z;
  unsigned sum, cnt, mine, sp = 0u;
  for (;;) {
    sum = 0u; cnt = 0u; mine = 0u;
#pragma unroll
    for (unsigned j = 0; j < 16; ++j) { const unsigned c = xb_ld(&bar[XB_XCNT(j)]); sum += c; cnt += (c > 0u) ? 1u : 0u; mine = (j == x) ? c : mine; }
    if (sum == G) break;
    __builtin_amdgcn_s_sleep(1);
    if ((++sp & 255u) == 0u) { if (xb_ld(&bar[XB_TMO])) break; if (sp > XB_SPIN_CAP) { atomicAdd(&bar[XB_TMO], 1u); break; } }
  }
  nloc = mine > 0u ? mine : 1u; nx = cnt > 0u ? cnt : 1u;
}
DI void xcd_barrier(const XcdBarrier& b) {
  asm volatile("s_waitcnt vmcnt(0)" ::: "memory");
  __syncthreads();
  if (threadIdx.x == 0) {
    unsigned* bar = b.bar;
    __builtin_amdgcn_s_waitcnt(0);
    unsigned nloc = b.st[0], nx = b.st[1];
    if (nloc == 0u) { xcd_barrier_complete(bar, b.x, nloc, nx); b.st[0] = nloc; b.st[1] = nx; }
    const unsigned old = xb_add(&bar[XB_XSUB(b.x)], 1u);
    const unsigned gen = old / nloc;
    if (old + 1u == (gen + 1u) * nloc) {
      __builtin_amdgcn_fence(__ATOMIC_RELEASE, "agent");
      asm volatile("s_waitcnt vmcnt(0)" ::: "memory");
      const unsigned og = xb_add(&bar[XB_TOP], 1u);
      const unsigned tg = og / nx;
      if (og + 1u == (tg + 1u) * nx) xb_add(&bar[XB_TOPGEN], 1u);
      else XB_SPIN(xb_ld(&bar[XB_TOPGEN]) == tg, bar);
      __builtin_amdgcn_fence(__ATOMIC_ACQUIRE, "agent");
      xb_add(&bar[XB_XGEN(b.x)], 1u);
      asm volatile("s_waitcnt vmcnt(0)" ::: "memory");
    } else {
      XB_SPIN(xb_ld(&bar[XB_XGEN(b.x)]) == gen, bar);
      __builtin_amdgcn_fence(__ATOMIC_ACQUIRE, "agent");
      asm volatile("s_waitcnt vmcnt(0)" ::: "memory");
    }
  }
  __syncthreads();
}

DI void transpose_item(const float* __restrict__ src, int src_ld, u16* __restrict__ dst, int dst_ld, int k0, int n0,
                       bool permute_in, char* smem) {
  float* tile = (float*)smem;
  const int tid = otid();
#pragma unroll
  for (int i = 0; i < 16; ++i) {
    int k = i * 4 + (tid >> 6), n = tid & 63;
    int nd = n0 + n, ns = nd;
    if (permute_in) {
      if (nd < 2304) ns = nd;
      else if (nd < 2816) ns = nd + 16;
      else if (nd < 2832) ns = nd - 512;
      else ns = -1;
    }
    float v = (ns >= 0) ? src[(size_t)(k0 + k) * src_ld + ns] : 0.f;
    tile[k * 65 + n] = v;
  }
  __syncthreads();
#pragma unroll 4
  for (int i = 0; i < 16; ++i) {
    int n = i * 4 + (tid >> 6), k = tid & 63;
    dst[(size_t)(n0 + n) * dst_ld + k0 + k] = f2bf(tile[k * 65 + n]);
  }
  __syncthreads();
}

DI void mod_item(const Params& p, int item, char* smem) {
  const int l = item / 96, grp = item % 96;
  float* ssc = (float*)smem;
  float* red = ssc + 2048;
  const int tid = otid();
  for (int i = tid; i < 1024; i += 256) {
    ssc[i] = silu_f(p.c[i]);
    ssc[1024 + i] = silu_f(p.c_ctx[i]);
  }
  __syncthreads();
  const int kq = tid >> 5, n = tid & 31, col = grp * 32 + n;
  const float* w = p.w_mod + (size_t)l * 1024 * 3072 + col;
  float a0 = 0.f, a1 = 0.f;
#pragma unroll 16
  for (int k = kq * 128; k < kq * 128 + 128; ++k) {
    float wv = w[(size_t)k * 3072];
    a0 += ssc[k] * wv;
    a1 += ssc[1024 + k] * wv;
  }
  red[(0 * 8 + kq) * 32 + n] = a0;
  red[(1 * 8 + kq) * 32 + n] = a1;
  __syncthreads();
  if (tid < 64) {
    int v = tid >> 5, nn = tid & 31;
    float s = 0.f;
    for (int q = 0; q < 8; ++q) s += red[(v * 8 + q) * 32 + nn];
    int cc = grp * 32 + nn;
    float* modv = (float*)(p.ws + OFF_MODV);
    modv[(l * 2 + v) * 3072 + cc] = s + p.b_mod[l * 3072 + cc];
  }
  __syncthreads();
}

DI void setup_phase(const Params& p, char* smem) {
  constexpr int N_A = 2 * 16 * 46, N_B = 2 * 16 * 16, N_C = 2 * 4 * 4, N_D = 192, N_E = 1;
  constexpr int NTOT = N_A + N_B + N_C + N_D + N_E;
  for (int item = blockIdx.x; item < NTOT; item += gridDim.x) {
    int it = item;
    if (it < N_A) {
      int l = it / (16 * 46), r = it % (16 * 46);
      int kt = r / 46, nt = r % 46;
      transpose_item(p.w_in + (size_t)l * 1024 * NIN, NIN, (u16*)(p.ws + OFF_WINT) + (size_t)l * NINP * 1024, 1024,
                     kt * 64, nt * 64, true, smem);
      continue;
    }
    it -= N_A;
    if (it < N_B) {
      int l = it / 256, r = it % 256;
      int kt = r / 16, nt = r % 16;
      transpose_item(p.w_out + (size_t)l * 1024 * 1024, 1024, (u16*)(p.ws + OFF_WOUTT) + (size_t)l * 1024 * 1024, 1024,
                     kt * 64, nt * 64, false, smem);
      continue;
    }
    it -= N_B;
    if (it < N_C) {
      int l = it / 16, r = it % 16;
      int kt = r / 4, nt = r % 4;
      transpose_item(p.glu_w + (size_t)l * 256 * 256, 256, (u16*)(p.ws + OFF_GLUWT) + (size_t)l * 256 * 256, 256,
                     kt * 64, nt * 64, false, smem);
      continue;
    }
    it -= N_C;
    if (it < N_D) { mod_item(p, it, smem); continue; }
    float* rope = (float*)(p.ws + OFF_ROPE);
    for (int e = otid(); e < 4096; e += 256) {
      int row = e >> 4, j = e & 15;
      float inv = powf(10000.f, -(float)j / 16.f);
      float ang = (float)row * inv;
      rope[e * 2] = cosf(ang);
      rope[e * 2 + 1] = sinf(ang);
    }
  }
}

DI void ln_mod_phase(const Params& p, const float* ctx_src, const float* lat_src, int l) {
  const int lane = otid() & 63, wave = otid() >> 6;
  const int nw = gridDim.x * 4;
  u16* h = (u16*)(p.ws + OFF_H);
  const float* modv = (const float*)(p.ws + OFF_MODV);
  for (int r = blockIdx.x * 4 + wave; r < T; r += nw) {
    const float* src = (r < NCTX) ? ctx_src + (size_t)r * DM : lat_src + (size_t)(r - NCTX) * DM;
    const float* mod = modv + (l * 2 + (r < NCTX ? 1 : 0)) * 3072;
    float4 v[4];
    float s = 0.f;
#pragma unroll
    for (int i = 0; i < 4; ++i) {
      v[i] = *(const float4*)(src + (i * 64 + lane) * 4);
      s += v[i].x + v[i].y + v[i].z + v[i].w;
    }
    float mu = wave_sum(s) * (1.f / DM);
    float q = 0.f;
#pragma unroll
    for (int i = 0; i < 4; ++i) {
      v[i].x -= mu; v[i].y -= mu; v[i].z -= mu; v[i].w -= mu;
      q += v[i].x * v[i].x + v[i].y * v[i].y + v[i].z * v[i].z + v[i].w * v[i].w;
    }
    float rstd = rsqrtf(wave_sum(q) * (1.f / DM) + EPS);
#pragma unroll
    for (int i = 0; i < 4; ++i) {
      int c0 = (i * 64 + lane) * 4;
      float4 sh = *(const float4*)(mod + c0);
      float4 sc = *(const float4*)(mod + 1024 + c0);
      float o0 = v[i].x * rstd * (1.f + sc.x) + sh.x;
      float o1 = v[i].y * rstd * (1.f + sc.y) + sh.y;
      float o2 = v[i].z * rstd * (1.f + sc.z) + sh.z;
      float o3 = v[i].w * rstd * (1.f + sc.w) + sh.w;
      uint2 pk = {pk2(o0, o1), pk2(o2, o3)};
      *(uint2*)(h + (size_t)r * DM + c0) = pk;
    }
  }
}

constexpr int G_LDA = 72;
DI void gemm_tile_compute(const u16* __restrict__ A, int lda, const u16* __restrict__ Bt, int ldb, int K, int m0, int n0,
                          char* smem) {
  u16* As = (u16*)smem;
  u16* Bs = As + 2 * 128 * G_LDA;
  const int tid = otid(), lane = tid & 63, wave = tid >> 6;
  const int wm = wave >> 1, wn = wave & 1;
  const int lr = lane & 31, lh = lane >> 5;
  f32x16 acc[2][2];
#pragma unroll
  for (int a = 0; a < 2; ++a)
#pragma unroll
    for (int b = 0; b < 2; ++b)
#pragma unroll
      for (int i = 0; i < 16; ++i) acc[a][b][i] = 0.f;

  const int KT = K / 64;
  uint4 ra0, ra1, ra2, ra3, rb0, rb1, rb2, rb3;
  const int srow = tid >> 3, sch = tid & 7;
  const u16* Ag = A + (size_t)(m0 + srow) * lda + sch * 8;
  const u16* Bg = Bt + (size_t)(n0 + srow) * ldb + sch * 8;
  const size_t a32 = (size_t)32 * lda, b32 = (size_t)32 * ldb;
#define G_LOAD(KT_)                                                                       \
  {                                                                                       \
    const u16* ag_ = Ag + (KT_) * 64;                                                     \
    const u16* bg_ = Bg + (KT_) * 64;                                                     \
    ra0 = *(const uint4*)(ag_);            rb0 = *(const uint4*)(bg_);                    \
    ra1 = *(const uint4*)(ag_ + a32);      rb1 = *(const uint4*)(bg_ + b32);              \
    ra2 = *(const uint4*)(ag_ + 2 * a32);  rb2 = *(const uint4*)(bg_ + 2 * b32);          \
    ra3 = *(const uint4*)(ag_ + 3 * a32);  rb3 = *(const uint4*)(bg_ + 3 * b32);          \
  }
#define G_STORE(BUF_)                                                                     \
  {                                                                                       \
    u16* as_ = As + ((BUF_) * 128 + srow) * G_LDA + sch * 8;                              \
    u16* bs_ = Bs + ((BUF_) * 128 + srow) * G_LDA + sch * 8;                              \
    *(uint4*)(as_) = ra0;                    *(uint4*)(bs_) = rb0;                        \
    *(uint4*)(as_ + 32 * G_LDA) = ra1;       *(uint4*)(bs_ + 32 * G_LDA) = rb1;           \
    *(uint4*)(as_ + 64 * G_LDA) = ra2;       *(uint4*)(bs_ + 64 * G_LDA) = rb2;           \
    *(uint4*)(as_ + 96 * G_LDA) = ra3;       *(uint4*)(bs_ + 96 * G_LDA) = rb3;           \
  }
  G_LOAD(0)
  G_STORE(0)
  __syncthreads();
  for (int kt = 0; kt < KT; ++kt) {
    const int buf = kt & 1;
    const int ktn = kt + 1 < KT ? kt + 1 : kt;
    G_LOAD(ktn)
    __builtin_amdgcn_sched_barrier(0);
    const u16* Ab = As + (buf * 128 + wm * 64 + lr) * G_LDA + lh * 8;
    const u16* Bb = Bs + (buf * 128 + wn * 64 + lr) * G_LDA + lh * 8;
    bf16x8 fa0[4], fa1[4], fb0[4], fb1[4];
#pragma unroll
    for (int ks = 0; ks < 4; ++ks) {
      fa0[ks] = *(const bf16x8*)(Ab + ks * 16);
      fa1[ks] = *(const bf16x8*)(Ab + 32 * G_LDA + ks * 16);
      fb0[ks] = *(const bf16x8*)(Bb + ks * 16);
      fb1[ks] = *(const bf16x8*)(Bb + 32 * G_LDA + ks * 16);
    }
    __builtin_amdgcn_sched_barrier(0);
#pragma unroll
    for (int ks = 0; ks < 4; ++ks) {
      acc[0][0] = MFMA32(fa0[ks], fb0[ks], acc[0][0]);
      acc[0][1] = MFMA32(fa0[ks], fb1[ks], acc[0][1]);
      acc[1][0] = MFMA32(fa1[ks], fb0[ks], acc[1][0]);
      acc[1][1] = MFMA32(fa1[ks], fb1[ks], acc[1][1]);
    }
    __builtin_amdgcn_sched_barrier(0);
    G_STORE(buf ^ 1)
    __syncthreads();
  }
  float* Cs = (float*)smem;
#pragma unroll
  for (int mi = 0; mi < 2; ++mi)
#pragma unroll
    for (int ni = 0; ni < 2; ++ni)
#pragma unroll
      for (int i = 0; i < 16; ++i) {
        int row = wm * 64 + mi * 32 + (i & 3) + 8 * (i >> 2) + 4 * lh;
        int col = wn * 64 + ni * 32 + lr;
        Cs[row * 132 + col] = acc[mi][ni][i];
      }
  __syncthreads();
}

template <bool OUT_BF16, bool SILU>
DI void epi_store(const float* Cs, void* dst, int ld, int m0, int coff, int ncols) {
  const int tid = otid();
  const int cpr = ncols >> 2;
  for (int idx = tid; idx < 128 * cpr; idx += 256) {
    int row = idx / cpr, c4 = idx % cpr;
    float4 v = *(const float4*)(Cs + row * 132 + 4 * c4);
    if (SILU) { v.x = silu_f(v.x); v.y = silu_f(v.y); v.z = silu_f(v.z); v.w = silu_f(v.w); }
    size_t o = (size_t)(m0 + row) * ld + coff + 4 * c4;
    if (OUT_BF16) *(uint2*)((u16*)dst + o) = make_uint2(pk2(v.x, v.y), pk2(v.z, v.w));
    else *(float4*)((float*)dst + o) = v;
  }
}

DI void epi_qk(const Params& p, const float* Cs, int l, int m0, int nt) {
  const int tid = otid();
  const int row = tid & 127, hh = tid >> 7;
  const int gr = m0 + row;
  const bool isk = (nt == 4);
  const float* gain = (isk ? p.kg : p.qg) + l * 64;
  float v[64];
  float ss = 0.f;
#pragma unroll
  for (int d4 = 0; d4 < 16; ++d4) {
    float4 t4 = *(const float4*)(Cs + row * 132 + hh * 64 + d4 * 4);
    v[4 * d4] = t4.x; v[4 * d4 + 1] = t4.y; v[4 * d4 + 2] = t4.z; v[4 * d4 + 3] = t4.w;
    ss += t4.x * t4.x + t4.y * t4.y + t4.z * t4.z + t4.w * t4.w;
  }
  float rinv = rsqrtf(ss * (1.f / 64.f) + EPS);
#pragma unroll
  for (int d = 0; d < 64; ++d) v[d] = v[d] * rinv * gain[d];
  if (gr >= NCTX) {
    const int t = gr - NCTX;
    const float* rope = (const float*)(p.ws + OFF_ROPE);
    const float* rr = rope + (t >> 6) * 32;
    const float* rc = rope + (t & 63) * 32;
#pragma unroll
    for (int j = 0; j < 16; ++j) {
      float c1 = rr[2 * j], s1 = rr[2 * j + 1];
      float a = v[j], b = v[j + 16];
      v[j] = a * c1 - b * s1;
      v[j + 16] = b * c1 + a * s1;
      float c2 = rc[2 * j], s2 = rc[2 * j + 1];
      float a2 = v[32 + j], b2 = v[48 + j];
      v[32 + j] = a2 * c2 - b2 * s2;
      v[48 + j] = b2 * c2 + a2 * s2;
    }
  }
  if (!isk) {
    constexpr float QS = 0.125f * 1.4426950408889634f;
#pragma unroll
    for (int d = 0; d < 64; ++d) v[d] *= QS;
  }
  u16* dst;
  if (isk) dst = (u16*)(p.ws + OFF_KB) + ((size_t)hh * T + gr) * 64;
  else dst = (u16*)(p.ws + OFF_QB) + ((size_t)(2 * nt + hh) * T + gr) * 64;
#pragma unroll
  for (int c = 0; c < 8; ++c) {
    uint4 o = {pk2(v[8 * c], v[8 * c + 1]), pk2(v[8 * c + 2], v[8 * c + 3]), pk2(v[8 * c + 4], v[8 * c + 5]),
               pk2(v[8 * c + 6], v[8 * c + 7])};
    *(uint4*)(dst + 8 * c) = o;
  }
}

DI void epi_v(const Params& p, const float* Cs, int m0) {
  const int tid = otid();
  const int c = tid & 127, half = tid >> 7;
  const int kvh = c >> 6, d = c & 63;
  u16* dst = (u16*)(p.ws + OFF_VT) + ((size_t)kvh * 64 + d) * T + m0 + half * 64;
#pragma unroll
  for (int g = 0; g < 8; ++g) {
    float v[8];
#pragma unroll
    for (int e = 0; e < 8; ++e) v[e] = Cs[(half * 64 + g * 8 + e) * 132 + c];
    uint4 o = {pk2(v[0], v[1]), pk2(v[2], v[3]), pk2(v[4], v[5]), pk2(v[6], v[7])};
    *(uint4*)(dst + g * 8) = o;
  }
}

DI void gemm_in_phase(const Params& p, int l, char* smem) {
  const u16* A = (const u16*)(p.ws + OFF_H);
  const u16* Bt = (const u16*)(p.ws + OFF_WINT) + (size_t)l * NINP * 1024;
  constexpr int MT = T / 128, NT = NINP / 128;
  const float* Cs = (const float*)smem;
  constexpr int MG = (MT + 7) / 8;
  for (int item = blockIdx.x; item < MG * 8 * NT; item += gridDim.x) {
    const int xcd = item & 7, r = item >> 3;
    const int mt = (r / NT) * 8 + xcd, nt = r % NT;
    if (mt >= MT) continue;
    const int m0 = mt * 128;
    gemm_tile_compute(A, 1024, Bt, 1024, 1024, m0, nt * 128, smem);
    if (nt <= 4) epi_qk(p, Cs, l, m0, nt);
    else if (nt == 5) epi_v(p, Cs, m0);
    else if (nt <= 9) epi_store<true, true>(Cs, p.ws + OFF_GATES, 1024, m0, (nt - 6) * 128, 128);
    else if (nt <= 15) epi_store<true, false>(Cs, p.ws + OFF_QKVB, 768, m0, (nt - 10) * 128, 128);
    else if (nt <= 17) epi_store<true, true>(Cs, p.ws + OFF_GATES, 1024, m0, 512 + (nt - 16) * 128, 128);
    else if (nt <= 19) epi_store<false, false>(Cs, p.ws + OFF_UC, 256, m0, (nt - 18) * 128, 128);
    else if (nt <= 21) epi_store<true, true>(Cs, p.ws + OFF_GATES, 1024, m0, 768 + (nt - 20) * 128, 128);
    else epi_store<false, false>(Cs, p.ws + OFF_BD, 16, m0, 0, 16);
    __syncthreads();
  }
}

DI void gemm_glu_phase(const Params& p, int l, char* smem) {
  const u16* A = (const u16*)(p.ws + OFF_QB);
  const u16* Bt = (const u16*)(p.ws + OFF_GLUWT) + (size_t)l * 256 * 256;
  const u16* gates = (const u16*)(p.ws + OFF_GATES);
  u16* mix = (u16*)(p.ws + OFF_H);
  const float* Cs = (const float*)smem;
  constexpr int MT = T / 128;
  for (int item = blockIdx.x; item < MT * 2; item += gridDim.x) {
    const int mt = item >> 1, nt = item & 1;
    const int m0 = mt * 128, n0 = nt * 128;
    gemm_tile_compute(A, 256, Bt, 256, 256, m0, n0, smem);
    for (int idx = otid(); idx < 128 * 64; idx += 256) {
      int row = idx >> 6, cp = idx & 63;
      int col = n0 + 2 * cp;
      size_t r = (size_t)(m0 + row);
      float a0 = Cs[row * 132 + 2 * cp] + p.glu_b[l * 256 + col];
      float a1 = Cs[row * 132 + 2 * cp + 1] + p.glu_b[l * 256 + col + 1];
      unsigned zz = *(const unsigned*)(A + r * 256 + col);
      unsigned gg = *(const unsigned*)(gates + r * 1024 + 768 + col);
      float z0 = bf2f((u16)(zz & 0xffff)), z1 = bf2f((u16)(zz >> 16));
      float g0 = bf2f((u16)(gg & 0xffff)), g1 = bf2f((u16)(gg >> 16));
      float o0 = z0 * sigmoid_f(a0) * g0, o1 = z1 * sigmoid_f(a1) * g1;
      *(unsigned*)(mix + r * 1024 + 768 + col) = pk2(o0, o1);
    }
    __syncthreads();
  }
}

DI void gemm_out_phase(const Params& p, int l, char* smem) {
  const u16* A = (const u16*)(p.ws + OFF_H);
  const u16* Bt = (const u16*)(p.ws + OFF_WOUTT) + (size_t)l * 1024 * 1024;
  const float* Cs = (const float*)smem;
  constexpr int MT = T / 128, NT = 8;
  const int mstart = (l == 1) ? 2 : 0;
  constexpr int MG = (MT + 7) / 8;
  for (int item = blockIdx.x; item < MG * 8 * NT; item += gridDim.x) {
    const int xcd = item & 7, r = item >> 3;
    const int mt = (r / NT) * 8 + xcd, nt = r % NT;
    if (mt >= MT || mt < mstart) continue;
    gemm_tile_compute(A, 1024, Bt, 1024, 1024, mt * 128, nt * 128, smem);
    epi_store<false, false>(Cs, p.ws + OFF_DN, 1024, mt * 128, nt * 128, 128);
    __syncthreads();
  }
}

DI void dn_solve(const float* Lr, const float* sb, const float* gc, bool isv, const char* src, int stride_bytes, float* x) {
  int off = 0;
  const int hioff = isv ? 0 : 2;
  const unsigned lomask = isv ? 0u : 0xffffu;
  const float gsel = isv ? 0.f : 1.f;
#pragma unroll
  for (int li = 0; li < 64; ++li) {
    const unsigned hi = *(const u16*)(src + off + hioff);
    const unsigned lo = *(const u16*)(src + off);
    const float gcl = gc[li];
    float r = __uint_as_float((hi << 16) | (lo & lomask)) * __expf(gcl * gsel);
    off += stride_bytes;
    asm volatile("" : "+v"(off));
    float acc = r * sb[li];
#pragma unroll
    for (int lj4 = 0; lj4 < (li + 3) / 4; ++lj4) {
      float4 Lq = *(const float4*)(Lr + li * 64 + lj4 * 4);
      if (lj4 * 4 + 0 < li) acc -= Lq.x * x[lj4 * 4 + 0];
      if (lj4 * 4 + 1 < li) acc -= Lq.y * x[lj4 * 4 + 1];
      if (lj4 * 4 + 2 < li) acc -= Lq.z * x[lj4 * 4 + 2];
      if (lj4 * 4 + 3 < li) acc -= Lq.w * x[lj4 * 4 + 3];
    }
    x[li] = acc;
    if (li & 1) __builtin_amdgcn_sched_barrier(0);
  }
}

DI void dn_prep_item(const Params& p, int l, int unit, char* smem) {
  const int cid = unit >> 2, head = unit & 3;
  const int tt0 = cid * 64;
  const int seg_lo = cid < 4 ? 0 : NCTX, seg_hi = cid < 4 ? NCTX : T;
  float* sq = (float*)smem;
  float* sk = sq + 64 * 65;
  float* sL = sk + 64 * 65;
  float* sbeta = sL + 2 * 4096;
  float* sgc = sbeta + 128;
  float* sg = sgc + 128;
  u16* sv = (u16*)(sg + 128);
  const u16* z = (const u16*)(p.ws + OFF_QKVB);
  const float* bd = (const float*)(p.ws + OFF_BD);
  const float* cw = p.conv_w + l * 3 * 768;
  u16* dn = (u16*)(p.ws + OFF_DN) + (size_t)unit * 2 * 5 * 4096;
  u16* tmp = (u16*)(p.ws + OFF_H) + (size_t)blockIdx.x * 32768;
  float* glast = (float*)(p.ws + OFF_GLAST);
  const int tid = otid(), lane = tid & 63, wave = tid >> 6;

  {
    const int cq = head * 64 + lane, ck = 256 + head * 64 + lane;
    const float wq0 = cw[cq], wq1 = cw[768 + cq], wq2 = cw[1536 + cq];
    const float wk0 = cw[ck], wk1 = cw[768 + ck], wk2 = cw[1536 + ck];
#pragma unroll 8
    for (int i = wave; i < 64; i += 4) {
      const int tt = tt0 + i;
      float zq0 = 0.f, zq2 = 0.f, zk0 = 0.f, zk2 = 0.f;
      if (tt - 1 >= seg_lo) { zq0 = bf2f(z[(size_t)(tt - 1) * 768 + cq]); zk0 = bf2f(z[(size_t)(tt - 1) * 768 + ck]); }
      if (tt + 1 < seg_hi) { zq2 = bf2f(z[(size_t)(tt + 1) * 768 + cq]); zk2 = bf2f(z[(size_t)(tt + 1) * 768 + ck]); }
      float zq1 = bf2f(z[(size_t)tt * 768 + cq]), zk1 = bf2f(z[(size_t)tt * 768 + ck]);
      float vq = silu_f(wq0 * zq0 + wq1 * zq1 + wq2 * zq2);
      float vk = silu_f(wk0 * zk0 + wk1 * zk1 + wk2 * zk2);
      float s1 = wave_sum(vq * vq), s2 = wave_sum(vk * vk);
      sq[i * 65 + lane] = vq * rsqrtf(s1 + EPS) * 0.125f;
      sk[i * 65 + lane] = vk * rsqrtf(s2 + EPS);
    }
  }
  if (tid < 128) {
    const int dir = tid >> 6, i = tid & 63;
    const int tt = tt0 + i;
    const int li = dir ? 63 - i : i;
    float br = bd[(size_t)tt * 16 + dir * 4 + head];
    float ar = bd[(size_t)tt * 16 + 8 + dir * 4 + head];
    sbeta[dir * 64 + li] = 1.f / (1.f + expf(-br));
    float xx = ar + p.dt_bias[l * 8 + dir * 4 + head];
    float sp = fmaxf(xx, 0.f) + log1pf(expf(-fabsf(xx)));
    sg[dir * 64 + li] = -expf(p.A_log[l * 8 + dir * 4 + head]) * sp;
  }
  __syncthreads();
  if (tid == 0 || tid == 64) {
    const int dir = tid >> 6;
    float a = 0.f;
    for (int li = 0; li < 64; ++li) { a += sg[dir * 64 + li]; sgc[dir * 64 + li] = a; }
  }
  __syncthreads();

  {
    const int it = wave >> 1, jt = wave & 1;
    const int lr = lane & 31, lh = lane >> 5;
    f32x16 kk, qk;
#pragma unroll
    for (int r = 0; r < 16; ++r) { kk[r] = 0.f; qk[r] = 0.f; }
    const float* ki = sk + (32 * it + lr) * 65 + 8 * lh;
    const float* qi = sq + (32 * it + lr) * 65 + 8 * lh;
    const float* kj = sk + (32 * jt + lr) * 65 + 8 * lh;
#pragma unroll
    for (int ks = 0; ks < 4; ++ks) {
      bf16x8 fa = mk8u(pk2(ki[16 * ks], ki[16 * ks + 1]), pk2(ki[16 * ks + 2], ki[16 * ks + 3]), pk2(ki[16 * ks + 4], ki[16 * ks + 5]),
                       pk2(ki[16 * ks + 6], ki[16 * ks + 7]));
      bf16x8 fq = mk8u(pk2(qi[16 * ks], qi[16 * ks + 1]), pk2(qi[16 * ks + 2], qi[16 * ks + 3]), pk2(qi[16 * ks + 4], qi[16 * ks + 5]),
                       pk2(qi[16 * ks + 6], qi[16 * ks + 7]));
      bf16x8 fb = mk8u(pk2(kj[16 * ks], kj[16 * ks + 1]), pk2(kj[16 * ks + 2], kj[16 * ks + 3]), pk2(kj[16 * ks + 4], kj[16 * ks + 5]),
                       pk2(kj[16 * ks + 6], kj[16 * ks + 7]));
      kk = MFMA32(fa, fb, kk);
      qk = MFMA32(fq, fb, qk);
    }
    const int j = 32 * jt + lr;
#pragma unroll
    for (int dir = 0; dir < 2; ++dir) {
      u16* attn = tmp + dir * 16384;
      const int lj = dir ? 63 - j : j;
      const float gcj = sgc[dir * 64 + lj];
#pragma unroll
      for (int r = 0; r < 16; ++r) {
        const int i = 32 * it + (r & 3) + 8 * (r >> 2) + 4 * lh;
        const int li = dir ? 63 - i : i;
        const float dec = __expf(fminf(sgc[dir * 64 + li] - gcj, 0.f));
        const float Lv = (lj < li) ? sbeta[dir * 64 + li] * kk[r] * dec : 0.f;
        const float Av = (lj <= li) ? qk[r] * dec : 0.f;
        sL[dir * 4096 + li * 64 + lj] = Lv;
        attn[li * 64 + lj] = f2bf(Av);
      }
    }
  }
#pragma unroll
  for (int dir = 0; dir < 2; ++dir) {
    u16* kdT = tmp + dir * 16384 + 4096;
    {
      const int d = tid >> 2, lq = tid & 3;
      const float gl = sgc[dir * 64 + 63];
      unsigned o[8];
#pragma unroll
      for (int e = 0; e < 8; ++e) {
        const int li0 = lq * 16 + 2 * e, li1 = li0 + 1;
        const int i0 = dir ? 63 - li0 : li0, i1 = dir ? 63 - li1 : li1;
        float v0 = sk[i0 * 65 + d] * __expf(gl - sgc[dir * 64 + li0]);
        float v1 = sk[i1 * 65 + d] * __expf(gl - sgc[dir * 64 + li1]);
        o[e] = pk2(v0, v1);
      }
      *(uint4*)(kdT + d * 64 + lq * 16) = make_uint4(o[0], o[1], o[2], o[3]);
      *(uint4*)(kdT + d * 64 + lq * 16 + 8) = make_uint4(o[4], o[5], o[6], o[7]);
    }
    if (tid == 0) glast[unit * 2 + dir] = __expf(sgc[dir * 64 + 63]);
  }
  {
    const int cv = 512 + head * 64 + lane;
    const float w0 = cw[cv], w1 = cw[768 + cv], w2 = cw[1536 + cv];
#pragma unroll 8
    for (int i = wave; i < 64; i += 4) {
      const int tt = tt0 + i;
      float z0 = 0.f, z2 = 0.f;
      if (tt - 1 >= seg_lo) z0 = bf2f(z[(size_t)(tt - 1) * 768 + cv]);
      if (tt + 1 < seg_hi) z2 = bf2f(z[(size_t)(tt + 1) * 768 + cv]);
      float z1 = bf2f(z[(size_t)tt * 768 + cv]);
      sv[i * 72 + lane] = f2bf(silu_f(w0 * z0 + w1 * z1 + w2 * z2));
    }
  }
  __syncthreads();
  {
    const int dir = tid >> 7, col = tid & 127;
    const bool isv = col < 64;
    const int c6 = col & 63;
    float x[64];
    const char* src = isv ? (const char*)(sv + (dir ? 63 * 72 : 0) + c6) : (const char*)(sk + (dir ? 63 * 65 : 0) + c6);
    const int strideb = (isv ? 144 : 260) * (dir ? -1 : 1);
    dn_solve(sL + dir * 4096, sbeta + dir * 64, sgc + dir * 64, isv, src, strideb, x);
    u16* XT = tmp + dir * 16384 + 8192 + col * 64;
#pragma unroll
    for (int c = 0; c < 8; ++c)
      *(uint4*)(XT + 8 * c) = make_uint4(pk2(x[8 * c], x[8 * c + 1]), pk2(x[8 * c + 2], x[8 * c + 3]),
                                         pk2(x[8 * c + 4], x[8 * c + 5]), pk2(x[8 * c + 6], x[8 * c + 7]));
  }
  __threadfence_block();
  __syncthreads();
  {
    const int dir = wave >> 1, prod = wave & 1;
    const int lr = lane & 31, lh = lane >> 5;
    const u16* Aop = tmp + dir * 16384 + (prod ? 0 : 4096);
    const u16* XT = tmp + dir * 16384 + 8192;
    u16* dnd = dn + (size_t)dir * 5 * 4096;
    bf16x8 af[2][4];
#pragma unroll
    for (int mt = 0; mt < 2; ++mt)
#pragma unroll
      for (int ks = 0; ks < 4; ++ks) af[mt][ks] = *(const bf16x8*)(Aop + (mt * 32 + lr) * 64 + ks * 16 + lh * 8);
    {
      f32x16 acc[2][2];
#pragma unroll
      for (int a = 0; a < 2; ++a)
#pragma unroll
        for (int b = 0; b < 2; ++b)
#pragma unroll
          for (int i = 0; i < 16; ++i) acc[a][b][i] = 0.f;
#pragma unroll
      for (int nt = 0; nt < 2; ++nt)
#pragma unroll
        for (int ks = 0; ks < 4; ++ks) {
          bf16x8 b = *(const bf16x8*)(XT + (nt * 32 + lr) * 64 + ks * 16 + lh * 8);
          acc[0][nt] = MFMA32(af[0][ks], b, acc[0][nt]);
          acc[1][nt] = MFMA32(af[1][ks], b, acc[1][nt]);
        }
      u16* dst = dnd + (prod ? 3 : 1) * 4096;
#pragma unroll
      for (int mt = 0; mt < 2; ++mt)
#pragma unroll
        for (int nt = 0; nt < 2; ++nt)
#pragma unroll
          for (int g4 = 0; g4 < 4; ++g4) {
            uint2 o = {pk2(acc[mt][nt][4 * g4], acc[mt][nt][4 * g4 + 1]), pk2(acc[mt][nt][4 * g4 + 2], acc[mt][nt][4 * g4 + 3])};
            if (prod) {
              *(uint2*)(dst + (nt * 32 + lr) * 64 + mt * 32 + 8 * g4 + 4 * lh) = o;
            } else {
              const int dvv = nt * 32 + lr;
              const int mm = 2 * mt + (g4 >> 1), qq = 2 * (g4 & 1) + lh;
              *(uint2*)(dst + (((dvv >> 4) * 64 + qq * 16 + (dvv & 15)) * 4 + mm) * 4) = o;
            }
          }
    }
    {
      f32x16 acc[2][2];
#pragma unroll
      for (int a = 0; a < 2; ++a)
#pragma unroll
        for (int b = 0; b < 2; ++b)
#pragma unroll
          for (int i = 0; i < 16; ++i) acc[a][b][i] = 0.f;
#pragma unroll
      for (int mt = 0; mt < 2; ++mt)
#pragma unroll
        for (int ks = 0; ks < 4; ++ks) {
          bf16x8 a = *(const bf16x8*)(XT + (64 + mt * 32 + lr) * 64 + ks * 16 + lh * 8);
          acc[mt][0] = MFMA32(a, af[0][ks], acc[mt][0]);
          acc[mt][1] = MFMA32(a, af[1][ks], acc[mt][1]);
        }
      u16* dst = dnd + (prod ? 2 : 0) * 4096;
#pragma unroll
      for (int nt = 0; nt < 2; ++nt) {
        const int n = nt * 32 + lr;
        const int i = dir ? 63 - n : n;
        const float eg = __expf(sgc[dir * 64 + n]);
#pragma unroll
        for (int mt = 0; mt < 2; ++mt)
#pragma unroll
          for (int g4 = 0; g4 < 4; ++g4) {
            const int d0 = mt * 32 + 8 * g4 + 4 * lh;
            float v0 = acc[mt][nt][4 * g4], v1 = acc[mt][nt][4 * g4 + 1], v2 = acc[mt][nt][4 * g4 + 2], v3 = acc[mt][nt][4 * g4 + 3];
            if (prod) {
              v0 = sq[i * 65 + d0] * eg - v0;
              v1 = sq[i * 65 + d0 + 1] * eg - v1;
              v2 = sq[i * 65 + d0 + 2] * eg - v2;
              v3 = sq[i * 65 + d0 + 3] * eg - v3;
            }
            uint2 o = {pk2(v0, v1), pk2(v2, v3)};
            if (prod) {
              *(uint2*)(dst + n * 64 + d0) = o;
            } else {
              const int mm = n >> 4, cnn = n & 15, ss = mt, hif = g4 >> 1, qq = 2 * (g4 & 1) + lh;
              *(uint2*)(dst + ((mm * 2 + ss) * 64 + qq * 16 + cnn) * 8 + 4 * hif) = o;
            }
          }
      }
    }
  }
  __syncthreads();
}

DI void s5_coeffs(const Params& p, int l, int dir, int g, int pp, float& a_re, float& a_im, float* b_re, float* b_im) {
  const int gi = (l * 2 + dir) * 16 + g;
  const int idx = gi * 64 + pp;
  const float lr = p.A_re[idx], lim = p.A_im[idx];
  const float dt = expf(p.log_dt[gi]);
  const float mag = expf(lr * dt);
  const float ang = lim * dt;
  float sn, cs;
  sincosf(ang, &sn, &cs);
  a_re = mag * cs;
  a_im = mag * sn;
  const float nr = a_re - 1.f, ni = a_im;
  const float den = 1.f / (lr * lr + lim * lim);
  const float c_re = (nr * lr + ni * lim) * den;
  const float c_im = (ni * lr - nr * lim) * den;
  const float* Br = p.B_re + (size_t)idx * 16;
  const float* Bi = p.B_im + (size_t)idx * 16;
#pragma unroll
  for (int c = 0; c < 16; ++c) {
    float br = Br[c], bi = Bi[c];
    b_re[c] = c_re * br - c_im * bi;
    b_im[c] = c_re * bi + c_im * br;
  }
}


constexpr int S5_WAVE_LDS = 12800;
DI void s5_wave_sync() { asm volatile("s_waitcnt lgkmcnt(0)" ::: "memory"); }
DI void s5_bfrags(u16* sbw, const float* b_re, const float* b_im, int lane, bf16x8* bfrag) {
  *(uint4*)(sbw + lane * 32) = make_uint4(pk2(b_re[0], b_re[1]), pk2(b_re[2], b_re[3]), pk2(b_re[4], b_re[5]), pk2(b_re[6], b_re[7]));
  *(uint4*)(sbw + lane * 32 + 8) = make_uint4(pk2(b_re[8], b_re[9]), pk2(b_re[10], b_re[11]), pk2(b_re[12], b_re[13]), pk2(b_re[14], b_re[15]));
  *(uint4*)(sbw + lane * 32 + 16) = make_uint4(pk2(b_im[0], b_im[1]), pk2(b_im[2], b_im[3]), pk2(b_im[4], b_im[5]), pk2(b_im[6], b_im[7]));
  *(uint4*)(sbw + lane * 32 + 24) = make_uint4(pk2(b_im[8], b_im[9]), pk2(b_im[10], b_im[11]), pk2(b_im[12], b_im[13]), pk2(b_im[14], b_im[15]));
  s5_wave_sync();
  const int n = lane & 15, q4 = lane >> 4;
  const unsigned keep = (q4 < 2) ? 0xffffffffu : 0u;
#pragma unroll
  for (int nt = 0; nt < 8; ++nt) {
    const int state = 16 * (nt & 3) + n, part = nt >> 2;
    uint4 v = *(const uint4*)(sbw + state * 32 + part * 16 + 8 * (q4 & 1));
    bfrag[nt] = mk8u(v.x & keep, v.y & keep, v.z & keep, v.w & keep);
  }
}
DI void s5_bu_slab(const float* su, int wave, int dir, int s, int lane, const bf16x8* bfrag, u16* busw) {
  const int n = lane & 15, q4 = lane >> 4;
  const int li = 16 * s + n;
  const int i = dir ? 63 - li : li;
  const float* ur = su + i * 64 + wave * 16 + 8 * (q4 & 1);
  const float4 u0 = *(const float4*)ur, u1 = *(const float4*)(ur + 4);
  const unsigned keep = (q4 < 2) ? 0xffffffffu : 0u;
  const bf16x8 a = mk8u(pk2(u0.x, u0.y) & keep, pk2(u0.z, u0.w) & keep, pk2(u1.x, u1.y) & keep, pk2(u1.z, u1.w) & keep);
#pragma unroll
  for (int nt = 0; nt < 8; ++nt) {
    f32x4 acc = {0.f, 0.f, 0.f, 0.f};
    acc = MFMA16(a, bfrag[nt], acc);
    const int col = (nt >> 2) * 64 + 16 * (nt & 3) + n;
#pragma unroll
    for (int j = 0; j < 4; ++j) busw[(4 * q4 + j) * 136 + col] = f2bf(acc[j]);
  }
  s5_wave_sync();
}

DI void s5_a_item(const Params& p, int l, int item, char* smem) {
  const int quarter = item & 3, dir = (item >> 2) & 1, cid = item >> 3;
  const int tid = otid(), lane = tid & 63, wave = tid >> 6;
  const int g = quarter * 4 + wave;
  float* su = (float*)smem;
  const float* uC = (const float*)(p.ws + OFF_UC);
  for (int e = tid; e < 64 * 16; e += 256) {
    int i = e >> 4, c4 = e & 15;
    *(float4*)(su + i * 64 + c4 * 4) = *(const float4*)(uC + (size_t)(cid * 64 + i) * 256 + quarter * 64 + c4 * 4);
  }
  float a_re, a_im, b_re[16], b_im[16];
  s5_coeffs(p, l, dir, g, lane, a_re, a_im, b_re, b_im);
  u16* wl = (u16*)(smem + 16384 + wave * S5_WAVE_LDS);
  u16* busw = wl + 2176;
  u16* sbw = wl + 4352;
  bf16x8 bfrag[8];
  s5_bfrags(sbw, b_re, b_im, lane, bfrag);
  __syncthreads();
  float h_re = 0.f, h_im = 0.f;
  for (int s4 = 0; s4 < 4; ++s4) {
    s5_bu_slab(su, wave, dir, s4, lane, bfrag, busw);
#pragma unroll
    for (int r = 0; r < 16; ++r) {
      const float bu_re = bf2f(busw[r * 136 + lane]), bu_im = bf2f(busw[r * 136 + 64 + lane]);
      float nr = a_re * h_re - a_im * h_im + bu_re;
      float ni = a_re * h_im + a_im * h_re + bu_im;
      h_re = nr; h_im = ni;
    }
    s5_wave_sync();
  }
  float2* E = (float2*)(p.ws + OFF_S5E);
  E[((size_t)(cid * 2 + dir) * 16 + g) * 64 + lane] = make_float2(h_re, h_im);
  __syncthreads();
}

DI int chain_cid(int dir, int pos) { return dir == 0 ? pos : (pos < 4 ? 3 - pos : 263 - pos); }

DI void s5_carry(const Params& p, int l, int sblk) {
  const int id = sblk * 256 + otid();
  const int dir = id >> 10, g = (id >> 6) & 15, pp = id & 63;
  const int gi = (l * 2 + dir) * 16 + g;
  const float lr = p.A_re[gi * 64 + pp], lim = p.A_im[gi * 64 + pp];
  const float dt = expf(p.log_dt[gi]);
  const float mag = expf(lr * dt);
  float sn, cs;
  sincosf(lim * dt, &sn, &cs);
  float ar = mag * cs, ai = mag * sn;
#pragma unroll
  for (int i = 0; i < 6; ++i) { float nr = ar * ar - ai * ai, ni = 2.f * ar * ai; ar = nr; ai = ni; }
  const float2* E = (const float2*)(p.ws + OFF_S5E);
  float2* H = (float2*)(p.ws + OFF_S5H);
  float hr = 0.f, hi = 0.f;
  asm volatile("" : "+v"(hr), "+v"(hi));
  for (int pos0 = 0; pos0 < NCH; pos0 += 20) {
    float2 e[20];
    size_t o[20];
#pragma unroll
    for (int u = 0; u < 20; ++u) {
      int cid = chain_cid(dir, pos0 + u);
      o[u] = ((size_t)(cid * 2 + dir) * 16 + g) * 64 + pp;
      e[u] = E[o[u]];
    }
#pragma unroll
    for (int u = 0; u < 20; ++u) {
      H[o[u]] = make_float2(hr, hi);
      float nr = ar * hr - ai * hi + e[u].x;
      float ni = ar * hi + ai * hr + e[u].y;
      hr = nr; hi = ni;
    }
  }
}

DI void s5_c_item(const Params& p, int l, int item, char* smem) {
  const int quarter = item & 3, cid = item >> 2;
  const int tid = otid(), lane = tid & 63, wave = tid >> 6;
  const int g = quarter * 4 + wave;
  float* su = (float*)smem;
  u16* hs = (u16*)(smem + 16384 + wave * S5_WAVE_LDS);
  u16* busw = hs + 2176;
  u16* sbw = hs + 4352;
  const float* uC = (const float*)(p.ws + OFF_UC);
  const float2* Hin = (const float2*)(p.ws + OFF_S5H);
  u16* zg = (u16*)(p.ws + OFF_QB);
  for (int e = tid; e < 64 * 16; e += 256) {
    int i = e >> 4, c4 = e & 15;
    *(float4*)(su + i * 64 + c4 * 4) = *(const float4*)(uC + (size_t)(cid * 64 + i) * 256 + quarter * 64 + c4 * 4);
  }
  __syncthreads();
  const int cc = lane & 15, q4 = lane >> 4;
  f32x4 yacc[4];
#pragma unroll
  for (int t = 0; t < 4; ++t) yacc[t] = (f32x4){0.f, 0.f, 0.f, 0.f};
#pragma unroll
  for (int dir = 0; dir < 2; ++dir) {
    float a_re, a_im, b_re[16], b_im[16];
    s5_coeffs(p, l, dir, g, lane, a_re, a_im, b_re, b_im);
    bf16x8 cf[4];
    {
      const size_t cb = ((size_t)((l * 2 + dir) * 16 + g) * 16 + cc) * 64;
#pragma unroll
      for (int s = 0; s < 4; ++s) {
        const float* src = (s < 2 ? p.C_re : p.C_im) + cb + 32 * (s & 1) + 8 * q4;
        const float sgn = (s < 2) ? 1.f : -1.f;
        float4 v0 = *(const float4*)src, v1 = *(const float4*)(src + 4);
        cf[s] = mk8u(pk2(sgn * v0.x, sgn * v0.y), pk2(sgn * v0.z, sgn * v0.w), pk2(sgn * v1.x, sgn * v1.y),
                     pk2(sgn * v1.z, sgn * v1.w));
      }
    }
    bf16x8 bfrag[8];
    s5_bfrags(sbw, b_re, b_im, lane, bfrag);
    float2 h0 = Hin[((size_t)(cid * 2 + dir) * 16 + g) * 64 + lane];
    float h_re = h0.x, h_im = h0.y;
#pragma unroll
    for (int s = 0; s < 4; ++s) {
      s5_bu_slab(su, wave, dir, s, lane, bfrag, busw);
#pragma unroll
      for (int r = 0; r < 16; ++r) {
        const float bu_re = bf2f(busw[r * 136 + lane]), bu_im = bf2f(busw[r * 136 + 64 + lane]);
        float nr = a_re * h_re - a_im * h_im + bu_re;
        float ni = a_re * h_im + a_im * h_re + bu_im;
        h_re = nr; h_im = ni;
        const int rr = dir ? 15 - r : r;
        hs[rr * 136 + lane] = f2bf(h_re);
        hs[rr * 136 + 64 + lane] = f2bf(h_im);
      }
      asm volatile("s_waitcnt lgkmcnt(0)" ::: "memory");
      const int tile = dir ? 3 - s : s;
#pragma unroll
      for (int ks = 0; ks < 4; ++ks) {
        bf16x8 a = *(const bf16x8*)(hs + cc * 136 + 32 * ks + 8 * q4);
        yacc[tile] = MFMA16(a, cf[ks], yacc[tile]);
      }
      asm volatile("s_waitcnt lgkmcnt(0)" ::: "memory");
    }
  }
  const int ch = g * 16 + cc;
  const float dsk = p.Dskip[l * 256 + ch];
#pragma unroll
  for (int tile = 0; tile < 4; ++tile)
#pragma unroll
    for (int j = 0; j < 4; ++j) {
      const int t = 16 * tile + 4 * q4 + j;
      float y = yacc[tile][j] + su[t * 64 + wave * 16 + cc] * dsk;
      zg[(size_t)(cid * 64 + t) * 256 + ch] = f2bf(gelu_tanh(y));
    }
  __syncthreads();
}

DI void dn_out_item(const Params& p, int l, int unit, char* smem) {
  const int cid = unit >> 2, head = unit & 3;
  const int tid = otid(), lane = tid & 63, wave = tid >> 6;
  const int lr = lane & 31, lh = lane >> 5;
  float* so = (float*)smem;
  const u16* gates = (const u16*)(p.ws + OFF_GATES);
  u16* mix = (u16*)(p.ws + OFF_H);
  const int dir = wave >> 1, mt = wave & 1;
  const u16* dnd = (const u16*)(p.ws + OFF_DN) + ((size_t)unit * 2 + dir) * 5 * 4096;
  const u16* Pm = dnd + 2 * 4096, *RT = dnd + 3 * 4096, *ST = dnd + 4 * 4096;
  f32x16 acc[2];
#pragma unroll
  for (int nt = 0; nt < 2; ++nt)
#pragma unroll
    for (int i = 0; i < 16; ++i) acc[nt][i] = 0.f;
#pragma unroll
  for (int ks = 0; ks < 4; ++ks) {
    bf16x8 a = *(const bf16x8*)(Pm + (mt * 32 + lr) * 64 + ks * 16 + lh * 8);
#pragma unroll
    for (int nt = 0; nt < 2; ++nt) {
      bf16x8 b = *(const bf16x8*)(ST + (nt * 32 + lr) * 64 + ks * 16 + lh * 8);
      acc[nt] = MFMA32(a, b, acc[nt]);
    }
  }
#pragma unroll
  for (int nt = 0; nt < 2; ++nt)
#pragma unroll
    for (int g4 = 0; g4 < 4; ++g4) {
      uint2 rr = *(const uint2*)(RT + (nt * 32 + lr) * 64 + mt * 32 + 8 * g4 + 4 * lh);
      acc[nt][4 * g4 + 0] += bf2f((u16)(rr.x & 0xffff));
      acc[nt][4 * g4 + 1] += bf2f((u16)(rr.x >> 16));
      acc[nt][4 * g4 + 2] += bf2f((u16)(rr.y & 0xffff));
      acc[nt][4 * g4 + 3] += bf2f((u16)(rr.y >> 16));
    }
  if (dir == 0) {
#pragma unroll
    for (int nt = 0; nt < 2; ++nt)
#pragma unroll
      for (int i = 0; i < 16; ++i) {
        const int li = mt * 32 + (i & 3) + 8 * (i >> 2) + 4 * lh;
        so[li * 65 + nt * 32 + lr] = acc[nt][i];
      }
  }
  __syncthreads();
  if (dir == 1) {
#pragma unroll
    for (int nt = 0; nt < 2; ++nt)
#pragma unroll
      for (int i = 0; i < 16; ++i) {
        const int li = mt * 32 + (i & 3) + 8 * (i >> 2) + 4 * lh;
        so[(63 - li) * 65 + nt * 32 + lr] += acc[nt][i];
      }
  }
  __syncthreads();
  const float gain = p.out_gain[l * 64 + lane];
#pragma unroll
  for (int i0 = 0; i0 < 16; ++i0) {
    const int i = wave + 4 * i0;
    const size_t tt = (size_t)cid * 64 + i;
    const int c = head * 64 + lane;
    float o = so[i * 65 + lane];
    float ms = wave_sum(o * o) * (1.f / 64.f);
    float v = o * rsqrtf(ms + EPS) * gain * bf2f(gates[tt * 1024 + 512 + c]);
    mix[tt * 1024 + 512 + c] = f2bf(v);
  }
  __syncthreads();
}

#define SCAN_LOAD(U, POS)                                                                      \
  {                                                                                            \
    const int cid_ = chain_cid(dir, (POS));                                                    \
    const u16* base_ = dnb + ((size_t)(cid_ * 4 + head) * 2 + dir) * 5 * 4096;                 \
    _Pragma("unroll") for (int m = 0; m < 4; ++m) {                                            \
      _Pragma("unroll") for (int s2 = 0; s2 < 2; ++s2) {                                       \
        const uint4 t_ = *(const uint4*)(base_ + ((m * 2 + s2) * 64 + lane) * 8);              \
        mlo##U[m][s2] = make_uint2(t_.x, t_.y);                                                \
        mhi##U[m][s2] = make_uint2(t_.z, t_.w);                                                \
      }                                                                                        \
    }                                                                                          \
    {                                                                                          \
      const uint4 t0_ = *(const uint4*)(base_ + 4096 + (cgp * 64 + lane) * 16);                \
      const uint4 t1_ = *(const uint4*)(base_ + 4096 + (cgp * 64 + lane) * 16 + 8);            \
      ntv##U[0] = make_uint2(t0_.x, t0_.y); ntv##U[1] = make_uint2(t0_.z, t0_.w);              \
      ntv##U[2] = make_uint2(t1_.x, t1_.y); ntv##U[3] = make_uint2(t1_.z, t1_.w);              \
    }                                                                                          \
    gl##U = glast[(cid_ * 4 + head) * 2 + dir];                                                \
  }
#define SCAN_COMPUTE(U, POS)                                                                   \
  {                                                                                            \
    const int cid_ = chain_cid(dir, (POS));                                                    \
    u16* STp_ = dnb + (((size_t)(cid_ * 4 + head) * 2 + dir) * 5 + 4) * 4096 + dv * 64 + 4 * q4; \
    unsigned pk_[4][2];                                                                        \
    _Pragma("unroll") for (int m = 0; m < 4; ++m) {                                            \
      pk_[m][0] = pk2(S[m][0], S[m][1]);                                                       \
      pk_[m][1] = pk2(S[m][2], S[m][3]);                                                       \
      *(uint2*)(STp_ + 16 * m) = make_uint2(pk_[m][0], pk_[m][1]);                             \
    }                                                                                          \
    bf16x8 sb0_ = mk8u(pk_[0][0], pk_[0][1], pk_[1][0], pk_[1][1]);                            \
    bf16x8 sb1_ = mk8u(pk_[2][0], pk_[2][1], pk_[3][0], pk_[3][1]);                            \
    _Pragma("unroll") for (int m = 0; m < 4; ++m) {                                            \
      f32x4 acc_ = {0.f, 0.f, 0.f, 0.f};                                                       \
      acc_ = MFMA16(mk8(mlo##U[m][0], mhi##U[m][0]), sb0_, acc_);                              \
      acc_ = MFMA16(mk8(mlo##U[m][1], mhi##U[m][1]), sb1_, acc_);                              \
      S[m][0] = gl##U * S[m][0] - acc_[0] + bf2f((u16)(ntv##U[m].x & 0xffff));                 \
      S[m][1] = gl##U * S[m][1] - acc_[1] + bf2f((u16)(ntv##U[m].x >> 16));                    \
      S[m][2] = gl##U * S[m][2] - acc_[2] + bf2f((u16)(ntv##U[m].y & 0xffff));                 \
      S[m][3] = gl##U * S[m][3] - acc_[3] + bf2f((u16)(ntv##U[m].y >> 16));                    \
    }                                                                                          \
  }
DI void dn_scan_wave(const Params& p, int task) {
  const int head = task & 3, dir = (task >> 2) & 1, cgp = task >> 3;
  const int lane = otid() & 63;
  const int cn = lane & 15, q4 = lane >> 4;
  const int dv = cgp * 16 + cn;
  u16* dnb = (u16*)(p.ws + OFF_DN);
  const float* glast = (const float*)(p.ws + OFF_GLAST);
  f32x4 S[4];
#pragma unroll
  for (int m = 0; m < 4; ++m) S[m] = (f32x4){0.f, 0.f, 0.f, 0.f};
  uint2 mlo0[4][2], mhi0[4][2], ntv0[4]; float gl0;
  uint2 mlo1[4][2], mhi1[4][2], ntv1[4]; float gl1;
  uint2 mlo2[4][2], mhi2[4][2], ntv2[4]; float gl2;
  uint2 mlo3[4][2], mhi3[4][2], ntv3[4]; float gl3;
  SCAN_LOAD(0, 0) SCAN_LOAD(1, 1) SCAN_LOAD(2, 2) SCAN_LOAD(3, 3)
  for (int pos0 = 0; pos0 < NCH; pos0 += 4) {
    const bool more = pos0 + 4 < NCH;
    SCAN_COMPUTE(0, pos0) if (more) SCAN_LOAD(0, pos0 + 4)
    SCAN_COMPUTE(1, pos0 + 1) if (more) SCAN_LOAD(1, pos0 + 5)
    SCAN_COMPUTE(2, pos0 + 2) if (more) SCAN_LOAD(2, pos0 + 6)
    SCAN_COMPUTE(3, pos0 + 3) if (more) SCAN_LOAD(3, pos0 + 7)
  }
}

constexpr int A_LD = 72;
constexpr int V_LD = 136;
DI void attn_item(const Params& p, int item, char* smem) {
  int head, q0, ntiles;
  if (item < 512) { head = item & 7; q0 = NCTX + (item >> 3) * 256; ntiles = NCH; }
  else { head = item - 512; q0 = 0; ntiles = 4; }
  const int kvh = head >> 2;
  const int tid = otid(), lane = tid & 63, wave = tid >> 6;
  const int lr = lane & 31, lh = lane >> 5;
  const u16* Qb = (const u16*)(p.ws + OFF_QB) + (size_t)head * T * 64;
  const u16* Kb = (const u16*)(p.ws + OFF_KB) + (size_t)kvh * T * 64;
  const u16* Vt = (const u16*)(p.ws + OFF_VT) + (size_t)kvh * 64 * T;
  u16* Ks = (u16*)smem;
  u16* Vs = Ks + 2 * 128 * A_LD;
  bf16x8 qf[2][4];
#pragma unroll
  for (int qt = 0; qt < 2; ++qt)
#pragma unroll
    for (int ks = 0; ks < 4; ++ks)
      qf[qt][ks] = *(const bf16x8*)(Qb + (size_t)(q0 + wave * 64 + qt * 32 + lr) * 64 + ks * 16 + lh * 8);

  f32x16 ot[2][2];
#pragma unroll
  for (int a = 0; a < 2; ++a)
#pragma unroll
    for (int b = 0; b < 2; ++b)
#pragma unroll
      for (int i = 0; i < 16; ++i) ot[a][b][i] = 0.f;
  float lrun[2] = {0.f, 0.f};

  uint4 rk0, rk1, rv0, rv1;
  const int srow = tid >> 3, sch = tid & 7;
  const u16* Kg = Kb + (size_t)srow * 64 + sch * 8;
  const u16* Vg = Vt + (size_t)srow * T + sch * 8;
#define A_LOAD(J_)                                                               \
  {                                                                              \
    const u16* kg_ = Kg + (size_t)(J_) * 4096;                                   \
    const u16* vg_ = Vg + (size_t)(J_) * 64;                                     \
    rk0 = *(const uint4*)(kg_);  rk1 = *(const uint4*)(kg_ + 32 * 64);           \
    rv0 = *(const uint4*)(vg_);  rv1 = *(const uint4*)(vg_ + (size_t)32 * T);    \
  }
#define A_STORE(BUF_, HALF_)                                                     \
  {                                                                              \
    u16* ks_ = Ks + ((BUF_) * 128 + (HALF_) * 64 + srow) * A_LD + sch * 8;       \
    u16* vs_ = Vs + ((BUF_) * 64 + srow) * V_LD + (HALF_) * 64 + sch * 8;        \
    *(uint4*)(ks_) = rk0;  *(uint4*)(ks_ + 32 * A_LD) = rk1;                     \
    *(uint4*)(vs_) = rv0;  *(uint4*)(vs_ + 32 * V_LD) = rv1;                     \
  }
  A_LOAD(0)
  A_STORE(0, 0)
  A_LOAD(1)
  A_STORE(0, 1)
  __syncthreads();
  const int npairs = ntiles >> 1;
  for (int jj = 0; jj < npairs; ++jj) {
    const int buf = jj & 1;
    const int jnext = (jj + 1 < npairs ? jj + 1 : jj) * 2;
#pragma unroll 1
    for (int half = 0; half < 2; ++half) {
    A_LOAD(jnext + half)
    __builtin_amdgcn_sched_barrier(0);
    const u16* Kt = Ks + (buf * 128 + half * 64) * A_LD;
    const u16* Vtile = Vs + buf * 64 * V_LD + half * 64;
    f32x16 st[2][2];
#pragma unroll
    for (int a = 0; a < 2; ++a)
#pragma unroll
      for (int b = 0; b < 2; ++b)
#pragma unroll
        for (int i = 0; i < 16; ++i) st[a][b][i] = 0.f;
    {
      bf16x8 kf[2][4];
#pragma unroll
      for (int kt = 0; kt < 2; ++kt)
#pragma unroll
        for (int ks = 0; ks < 4; ++ks) kf[kt][ks] = *(const bf16x8*)(Kt + (kt * 32 + lr) * A_LD + ks * 16 + lh * 8);
      __builtin_amdgcn_sched_barrier(0);
#pragma unroll
      for (int kt = 0; kt < 2; ++kt)
#pragma unroll
        for (int ks = 0; ks < 4; ++ks) {
          st[kt][0] = MFMA32(kf[kt][ks], qf[0][ks], st[kt][0]);
          st[kt][1] = MFMA32(kf[kt][ks], qf[1][ks], st[kt][1]);
        }
    }
#pragma unroll
    for (int kt = 0; kt < 2; ++kt) {
#pragma unroll
      for (int qt = 0; qt < 2; ++qt) {
        float ls0 = 0.f, ls1 = 0.f;
#pragma unroll
        for (int i = 0; i < 16; i += 2) {
          float p0 = __builtin_amdgcn_exp2f(st[kt][qt][i]);
          float p1 = __builtin_amdgcn_exp2f(st[kt][qt][i + 1]);
          st[kt][qt][i] = p0;
          st[kt][qt][i + 1] = p1;
          ls0 += p0;
          ls1 += p1;
        }
        lrun[qt] += ls0 + ls1;
      }
#pragma unroll
      for (int ss = 0; ss < 2; ++ss) {
        bf16x8 pb[2];
#pragma unroll
        for (int qt = 0; qt < 2; ++qt)
          pb[qt] = mk8u(pk2(st[kt][qt][8 * ss + 0], st[kt][qt][8 * ss + 1]), pk2(st[kt][qt][8 * ss + 2], st[kt][qt][8 * ss + 3]),
                        pk2(st[kt][qt][8 * ss + 4], st[kt][qt][8 * ss + 5]), pk2(st[kt][qt][8 * ss + 6], st[kt][qt][8 * ss + 7]));
#pragma unroll
        for (int dt = 0; dt < 2; ++dt) {
          const u16* pr = Vtile + (dt * 32 + lr) * V_LD + 32 * kt + 16 * ss + 4 * lh;
          uint2 lo = *(const uint2*)pr;
          uint2 hi = *(const uint2*)(pr + 8);
          bf16x8 a = mk8(lo, hi);
#pragma unroll
          for (int qt = 0; qt < 2; ++qt) ot[dt][qt] = MFMA32(a, pb[qt], ot[dt][qt]);
        }
      }
    }
    __builtin_amdgcn_sched_barrier(0);
    A_STORE(buf ^ 1, half)
    }
    __syncthreads();
  }
  const u16* gates = (const u16*)(p.ws + OFF_GATES);
  u16* mix = (u16*)(p.ws + OFF_H);
#pragma unroll
  for (int qt = 0; qt < 2; ++qt) {
    const float lt = lrun[qt] + __shfl_xor(lrun[qt], 32);
    const float inv = 1.f / lt;
    const size_t row = (size_t)(q0 + wave * 64 + qt * 32 + lr);
#pragma unroll
    for (int dt = 0; dt < 2; ++dt)
#pragma unroll
      for (int g4 = 0; g4 < 4; ++g4) {
        const int d0 = 32 * dt + 8 * g4 + 4 * lh;
        uint2 gg = *(const uint2*)(gates + row * 1024 + head * 64 + d0);
        float o0 = ot[dt][qt][4 * g4 + 0] * inv * bf2f((u16)(gg.x & 0xffff));
        float o1 = ot[dt][qt][4 * g4 + 1] * inv * bf2f((u16)(gg.x >> 16));
        float o2 = ot[dt][qt][4 * g4 + 2] * inv * bf2f((u16)(gg.y & 0xffff));
        float o3 = ot[dt][qt][4 * g4 + 3] * inv * bf2f((u16)(gg.y >> 16));
        uint2 o = {pk2(o0, o1), pk2(o2, o3)};
        *(uint2*)(mix + row * 1024 + head * 64 + d0) = o;
      }
  }
}

DI void final_ln_phase(const Params& p, int l, const float* ctx_src, const float* lat_src) {
  const int lane = otid() & 63, wave = otid() >> 6;
  const int nw = gridDim.x * 4;
  const float* y = (const float*)(p.ws + OFF_DN);
  const float* modv = (const float*)(p.ws + OFF_MODV);
  float* ctx1 = (float*)(p.ws + OFF_CTX1);
  u16* h = (u16*)(p.ws + OFF_H);
  const int rstart = (l == 1) ? NCTX : 0;
  for (int r = rstart + blockIdx.x * 4 + wave; r < T; r += nw) {
    const bool isc = r < NCTX;
    const float* src = isc ? ctx_src + (size_t)r * DM : lat_src + (size_t)(r - NCTX) * DM;
    float* dst = isc ? ctx1 + (size_t)r * DM : p.out + (size_t)(r - NCTX) * DM;
    const float* mod = modv + (l * 2 + (isc ? 1 : 0)) * 3072;
    float4 v[4];
    float s = 0.f;
#pragma unroll
    for (int i = 0; i < 4; ++i) {
      int c0 = (i * 64 + lane) * 4;
      float4 xv = *(const float4*)(src + c0);
      float4 yv = *(const float4*)(y + (size_t)r * DM + c0);
      float4 gv = *(const float4*)(mod + 2048 + c0);
      v[i].x = DN_ALPHA * xv.x + gv.x * yv.x;
      v[i].y = DN_ALPHA * xv.y + gv.y * yv.y;
      v[i].z = DN_ALPHA * xv.z + gv.z * yv.z;
      v[i].w = DN_ALPHA * xv.w + gv.w * yv.w;
      s += v[i].x + v[i].y + v[i].z + v[i].w;
    }
    float mu = wave_sum(s) * (1.f / DM);
    float q = 0.f;
#pragma unroll
    for (int i = 0; i < 4; ++i) {
      v[i].x -= mu; v[i].y -= mu; v[i].z -= mu; v[i].w -= mu;
      q += v[i].x * v[i].x + v[i].y * v[i].y + v[i].z * v[i].z + v[i].w * v[i].w;
    }
    float rstd = rsqrtf(wave_sum(q) * (1.f / DM) + EPS);
    float s2 = 0.f;
#pragma unroll
    for (int i = 0; i < 4; ++i) {
      int c0 = (i * 64 + lane) * 4;
      float4 g = *(const float4*)(p.ln_g + l * DM + c0);
      float4 b = *(const float4*)(p.ln_b + l * DM + c0);
      v[i].x = v[i].x * rstd * g.x + b.x;
      v[i].y = v[i].y * rstd * g.y + b.y;
      v[i].z = v[i].z * rstd * g.z + b.z;
      v[i].w = v[i].w * rstd * g.w + b.w;
      *(float4*)(dst + c0) = v[i];
      s2 += v[i].x + v[i].y + v[i].z + v[i].w;
    }
    if (l == 0) {
      const float* mod1 = modv + (2 + (isc ? 1 : 0)) * 3072;
      float mu2 = wave_sum(s2) * (1.f / DM);
      float q2 = 0.f;
#pragma unroll
      for (int i = 0; i < 4; ++i) {
        v[i].x -= mu2; v[i].y -= mu2; v[i].z -= mu2; v[i].w -= mu2;
        q2 += v[i].x * v[i].x + v[i].y * v[i].y + v[i].z * v[i].z + v[i].w * v[i].w;
      }
      float rstd2 = rsqrtf(wave_sum(q2) * (1.f / DM) + EPS);
#pragma unroll
      for (int i = 0; i < 4; ++i) {
        int c0 = (i * 64 + lane) * 4;
        float4 sh = *(const float4*)(mod1 + c0);
        float4 sc = *(const float4*)(mod1 + 1024 + c0);
        float o0 = v[i].x * rstd2 * (1.f + sc.x) + sh.x;
        float o1 = v[i].y * rstd2 * (1.f + sc.y) + sh.y;
        float o2 = v[i].z * rstd2 * (1.f + sc.z) + sh.z;
        float o3 = v[i].w * rstd2 * (1.f + sc.w) + sh.w;
        uint2 pk = {pk2(o0, o1), pk2(o2, o3)};
        *(uint2*)(h + (size_t)r * DM + c0) = pk;
      }
    }
  }
}

#ifndef REP_ATTN
#define REP_ATTN 1
#endif
#ifndef REP_SCAN
#define REP_SCAN 1
#endif
#ifndef REP_GEMM
#define REP_GEMM 1
#endif
#ifndef REP_PREP
#define REP_PREP 1
#endif
#ifndef REP_P5
#define REP_P5 1
#endif
typedef const __attribute__((address_space(4))) Params* KParamsPtr;
DI const Params& kp() {
  KParamsPtr q = (KParamsPtr)__builtin_amdgcn_kernarg_segment_ptr();
  asm volatile("" : "+s"(q));
  return *(const Params*)q;
}
__global__ void __launch_bounds__(256, 2) fwd_megakernel(Params pin) {
  cg::grid_group grid = cg::this_grid();
  __shared__ __attribute__((aligned(16))) char smem[SMEM_BYTES];
  const int nb = gridDim.x;
  __shared__ uint4 xb_words;
  if (threadIdx.x == 0) xb_words = make_uint4(0u, 0u, 0u, 0u);
  __syncthreads();
  (void)xcd_barrier_post((unsigned*)(kp().ws + OFF_BAR), (volatile LAS unsigned*)&xb_words);
#define GRID_BARRIER() do { XcdBarrier xb_; xb_.bar = (unsigned*)(kp().ws + OFF_BAR); xb_.x = xb_xcc_id(); xb_.st = (volatile LAS unsigned*)&xb_words; xcd_barrier(xb_); } while (0)

  if (kp().ws == nullptr) grid.sync();
  setup_phase(kp(), smem);
  GRID_BARRIER();
  { const Params& p = kp(); ln_mod_phase(p, p.ctx, p.x, 0); }
  GRID_BARRIER();

  for (int l = 0; l < 2; ++l) {
    for (int rep = 0; rep < REP_GEMM; ++rep) gemm_in_phase(kp(), l, smem);
    GRID_BARRIER();
    for (int rep = 0; rep < REP_PREP; ++rep)
    for (int item = blockIdx.x; item < 1040 + 2080; item += nb) {
      if (item < 1040) dn_prep_item(kp(), l, item, smem);
      else s5_a_item(kp(), l, item - 1040, smem);
    }
    GRID_BARRIER();
    for (int rep = 0; rep < REP_SCAN; ++rep)
    for (int item = blockIdx.x; item < 40; item += nb) {
      if (item < 32) { if ((otid() >> 6) == 0) dn_scan_wave(kp(), item); }
      else s5_carry(kp(), l, item - 32);
    }
    GRID_BARRIER();
    for (int rep = 0; rep < REP_ATTN; ++rep)
      for (int item = blockIdx.x; item < 520; item += nb) attn_item(kp(), item, smem);
    GRID_BARRIER();
    for (int rep = 0; rep < REP_P5; ++rep)
    for (int item = blockIdx.x; item < 1040 + 1040; item += nb) {
      if (item < 1040) s5_c_item(kp(), l, item, smem);
      else dn_out_item(kp(), l, item - 1040, smem);
    }
    GRID_BARRIER();
    gemm_glu_phase(kp(), l, smem);
    GRID_BARRIER();
    gemm_out_phase(kp(), l, smem);
    GRID_BARRIER();
    {
      const Params& p = kp();
      if (l == 0) final_ln_phase(p, 0, p.ctx, p.x);
      else final_ln_phase(p, 1, (const float*)(p.ws + OFF_CTX1), p.out);
    }
    if (l == 0) GRID_BARRIER();
  }
}

extern "C" void kernel_launch(void* const* d_in, const int* in_sizes, int n_in, void* d_out, int out_size, void* d_ws,
                              size_t ws_size, hipStream_t stream) {
  static int grid_blocks = 0;
  if (!grid_blocks) {
    int dev = 0, cus = 0, per_cu = 0;
    hipGetDevice(&dev);
    hipDeviceGetAttribute(&cus, hipDeviceAttributeMultiprocessorCount, dev);
    hipOccupancyMaxActiveBlocksPerMultiprocessor(&per_cu, fwd_megakernel, 256, 0);
    if (per_cu > 2) per_cu = 2;
    if (per_cu < 1) per_cu = 1;
    grid_blocks = cus * per_cu;
  }
  Params p{};
  const float** pp = (const float**)&p;
  for (int i = 0; i < 26; ++i) pp[i] = (const float*)d_in[i];
  p.out = (float*)d_out;
  p.ws = (char*)d_ws;
  void* args[] = {&p};
  (void)hipMemsetAsync((char*)d_ws + OFF_BAR, 0, XCD_BAR_WORDS * 4, stream);
  hipError_t e = hipLaunchCooperativeKernel((void*)fwd_megakernel, dim3(grid_blocks), dim3(256), args, 0, stream);
  if (e != hipSuccess) fprintf(stderr, "cooperative launch failed: %s (grid %d)\n", hipGetErrorString(e), grid_blocks);
}
```

```cpp
#include <hip/hip_runtime.h>
#include <hip/hip_cooperative_groups.h>
#include <cstdio>
namespace cg = cooperative_groups;

#define DI __device__ __forceinline__
typedef unsigned short u16;
using bf16x8 = __attribute__((ext_vector_type(8))) short;
using f32x16 = __attribute__((ext_vector_type(16))) float;
using f32x4 = __attribute__((ext_vector_type(4))) float;
typedef __bf16 bf2_t __attribute__((ext_vector_type(2)));
typedef float f2_t __attribute__((ext_vector_type(2)));

#define MFMA32(a, b, c) __builtin_amdgcn_mfma_f32_32x32x16_bf16((a), (b), (c), 0, 0, 0)
#define MFMA16(a, b, c) __builtin_amdgcn_mfma_f32_16x16x32_bf16((a), (b), (c), 0, 0, 0)

constexpr int T = 16640;
constexpr int NCTX = 256;
constexpr int DM = 1024;
constexpr int NIN = 2832;
constexpr int NINP = 2944;
constexpr int NCH = 260;
constexpr float EPS = 1e-6f;
constexpr float DN_ALPHA = 1.4142135623730951f;

constexpr size_t al256(size_t x) { return (x + 255) & ~(size_t)255; }
constexpr size_t OFF_WINT = 0;
constexpr size_t OFF_WOUTT = OFF_WINT + al256((size_t)2 * NINP * 1024 * 2);
constexpr size_t OFF_GLUWT = OFF_WOUTT + al256((size_t)2 * 1024 * 1024 * 2);
constexpr size_t OFF_MODV = OFF_GLUWT + al256((size_t)2 * 256 * 256 * 2);
constexpr size_t OFF_ROPE = OFF_MODV + al256((size_t)2 * 2 * 3072 * 4);
constexpr size_t OFF_H = OFF_ROPE + al256((size_t)256 * 16 * 2 * 4);
constexpr size_t OFF_QB = OFF_H + al256((size_t)T * 1024 * 2);
constexpr size_t OFF_KB = OFF_QB + al256((size_t)8 * T * 64 * 2);
constexpr size_t OFF_VT = OFF_KB + al256((size_t)2 * T * 64 * 2);
constexpr size_t OFF_GATES = OFF_VT + al256((size_t)2 * T * 64 * 2);
constexpr size_t OFF_QKVB = OFF_GATES + al256((size_t)T * 1024 * 2);
constexpr size_t OFF_UC = OFF_QKVB + al256((size_t)T * 768 * 2);
constexpr size_t OFF_BD = OFF_UC + al256((size_t)T * 256 * 4);
constexpr size_t OFF_DN = OFF_BD + al256((size_t)T * 16 * 4);
constexpr size_t OFF_GLAST = OFF_DN + al256((size_t)1040 * 2 * 5 * 4096 * 2);
constexpr size_t OFF_S5E = OFF_GLAST + al256((size_t)1040 * 2 * 4);
constexpr size_t OFF_S5H = OFF_S5E + al256((size_t)NCH * 2 * 16 * 64 * 2 * 4);
constexpr size_t OFF_CTX1 = OFF_S5H + al256((size_t)NCH * 2 * 16 * 64 * 2 * 4);
constexpr size_t OFF_BAR = OFF_CTX1 + al256((size_t)256 * 1024 * 4);
constexpr size_t WS_TOTAL = OFF_BAR + 16384;
static_assert(WS_TOTAL <= (size_t)256 * 1024 * 1024, "workspace too large");
static_assert((size_t)T * 1024 * 4 <= (size_t)1040 * 2 * 5 * 4096 * 2, "y alias");

struct Params {
  const float *x, *c, *ctx, *c_ctx, *w_mod, *b_mod, *w_in, *qg, *kg, *conv_w, *A_log, *dt_bias, *out_gain,
      *A_re, *A_im, *log_dt, *B_re, *B_im, *C_re, *C_im, *Dskip, *glu_w, *glu_b, *w_out, *ln_g, *ln_b;
  float* out;
  char* ws;
};

constexpr int SMEM_BYTES = 75 * 1024;

DI float bf2f(u16 v) { return __uint_as_float(((unsigned)v) << 16); }
DI unsigned pk2(float a, float b) {
  f2_t v = {a, b};
  bf2_t r = __builtin_convertvector(v, bf2_t);
  return __builtin_bit_cast(unsigned, r);
}
DI u16 f2bf(float a) { return (u16)(pk2(a, 0.f) & 0xffffu); }
DI float silu_f(float x) { return x / (1.f + __expf(-x)); }
DI float sigmoid_f(float x) { return 1.f / (1.f + __expf(-x)); }
template <int CTRL>
DI float dppf(float v) {
  return __builtin_bit_cast(float, __builtin_amdgcn_update_dpp(0, __builtin_bit_cast(int, v), CTRL, 0xf, 0xf, true));
}
DI float wave_sum(float v) {
  v += dppf<0xB1>(v);
  v += dppf<0x4E>(v);
  v += dppf<0x141>(v);
  v += dppf<0x140>(v);
  v += __shfl_xor(v, 16);
  v += __shfl_xor(v, 32);
  return v;
}
DI int otid() { int t = threadIdx.x; asm volatile("" : "+v"(t)); return t; }
DI float gelu_tanh(float x) {
  float u = 0.7978845608028654f * (x + 0.044715f * x * x * x);
  float t = 1.f - 2.f / (1.f + __expf(2.f * u));
  return 0.5f * x * (1.f + t);
}
DI bf16x8 mk8(uint2 lo, uint2 hi) {
  uint4 v = {lo.x, lo.y, hi.x, hi.y};
  return __builtin_bit_cast(bf16x8, v);
}
DI bf16x8 mk8u(unsigned a, unsigned b, unsigned c, unsigned d) {
  uint4 v = {a, b, c, d};
  return __builtin_bit_cast(bf16x8, v);
}


#define XB_TMO      128
#define XB_XCNT(j)  (256  + 64 * (j))
#define XB_XSUB(j)  (1280 + 64 * (j))
#define XB_XGEN(j)  (2304 + 64 * (j))
#define XB_TOP      3328
#define XB_TOPGEN   3392
#define XCD_BAR_WORDS 3456
#define XB_SPIN_CAP (1u << 18)
#define LAS __attribute__((address_space(3)))
DI unsigned xb_ld(unsigned* p) { return __hip_atomic_load(p, __ATOMIC_RELAXED, __HIP_MEMORY_SCOPE_AGENT); }
DI unsigned xb_add(unsigned* p, unsigned v) { return __hip_atomic_fetch_add(p, v, __ATOMIC_RELAXED, __HIP_MEMORY_SCOPE_AGENT); }
DI unsigned xb_xcc_id() { return (unsigned)__builtin_amdgcn_s_getreg((3 << 11) | 20) & 0xFu; }
#define XB_SPIN(cond, bar) do { unsigned _sp = 0; while (cond) { __builtin_amdgcn_s_sleep(1); \
    if ((++_sp & 255u) == 0u) { if (xb_ld(&(bar)[XB_TMO])) break; if (_sp > XB_SPIN_CAP) { atomicAdd(&(bar)[XB_TMO], 1u); break; } } } } while (0)
struct XcdBarrier { unsigned* bar; unsigned x; volatile LAS unsigned* st; };
DI XcdBarrier xcd_barrier_post(unsigned* bar, volatile LAS unsigned* st) {
  XcdBarrier b; b.bar = bar; b.x = xb_xcc_id(); b.st = st;
  if (threadIdx.x == 0) (void)xb_add(&bar[XB_XCNT(b.x)], 1u);
  return b;
}
DI void xcd_barrier_complete(unsigned* bar, unsigned x, unsigned& nloc, unsigned& nx) {
  const unsigned G = gridDim.x * gridDim.y * gridDim.z;
  unsigned sum, cnt, mine, sp = 0u;
  for (;;) {
    sum = 0u; cnt = 0u; mine = 0u;
#pragma unroll
    for (unsigned j = 0; j < 16; ++j) { const unsigned c = xb_ld(&bar[XB_XCNT(j)]); sum += c; cnt += (c > 0u) ? 1u : 0u; mine = (j == x) ? c : mine; }
    if (sum == G) break;
    __builtin_amdgcn_s_sleep(1);
    if ((++sp & 255u) == 0u) { if (xb_ld(&bar[XB_TMO])) break; if (sp > XB_SPIN_CAP) { atomicAdd(&bar[XB_TMO], 1u); break; } }
  }
  nloc = mine > 0u ? mine : 1u; nx = cnt > 0u ? cnt : 1u;
}
DI void xcd_barrier(const XcdBarrier& b) {
  asm volatile("s_waitcnt vmcnt(0)" ::: "memory");
  __syncthreads();
  if (threadIdx.x == 0) {
    unsigned* bar = b.bar;
    __builtin_amdgcn_s_waitcnt(0);
    unsigned nloc = b.st[0], nx = b.st[1];
    if (nloc == 0u) { xcd_barrier_complete(bar, b.x, nloc, nx); b.st[0] = nloc; b.st[1] = nx; }
    const unsigned old = xb_add(&bar[XB_XSUB(b.x)], 1u);
    const unsigned gen = old / nloc;
    if (old + 1u == (gen + 1u) * nloc) {
      __builtin_amdgcn_fence(__ATOMIC_RELEASE, "agent");
      asm volatile("s_waitcnt vmcnt(0)" ::: "memory");
      const unsigned og = xb_add(&bar[XB_TOP], 1u);
      const unsigned tg = og / nx;
      if (og + 1u == (tg + 1u) * nx) xb_add(&bar[XB_TOPGEN], 1u);
      else XB_SPIN(xb_ld(&bar[XB_TOPGEN]) == tg, bar);
      __builtin_amdgcn_fence(__ATOMIC_ACQUIRE, "agent");
      xb_add(&bar[XB_XGEN(b.x)], 1u);
      asm volatile("s_waitcnt vmcnt(0)" ::: "memory");
    } else {
      XB_SPIN(xb_ld(&bar[XB_XGEN(b.x)]) == gen, bar);
      __builtin_amdgcn_fence(__ATOMIC_ACQUIRE, "agent");
      asm volatile("s_waitcnt vmcnt(0)" ::: "memory");
    }
  }
  __syncthreads();
}

DI void transpose_item(const float* __restrict__ src, int src_ld, u16* __restrict__ dst, int dst_ld, int k0, int n0,
                       bool permute_in, char* smem) {
  float* tile = (float*)smem;
  const int tid = otid();
#pragma unroll
  for (int i = 0; i < 16; ++i) {
    int k = i * 4 + (tid >> 6), n = tid & 63;
    int nd = n0 + n, ns = nd;
    if (permute_in) {
      if (nd < 2304) ns = nd;
      else if (nd < 2816) ns = nd + 16;
      else if (nd < 2832) ns = nd - 512;
      else ns = -1;
    }
    float v = (ns >= 0) ? src[(size_t)(k0 + k) * src_ld + ns] : 0.f;
    tile[k * 65 + n] = v;
  }
  __syncthreads();
#pragma unroll 4
  for (int i = 0; i < 16; ++i) {
    int n = i * 4 + (tid >> 6), k = tid & 63;
    dst[(size_t)(n0 + n) * dst_ld + k0 + k] = f2bf(tile[k * 65 + n]);
  }
  __syncthreads();
}

DI void mod_item(const Params& p, int item, char* smem) {
  const int l = item / 96, grp = item % 96;
  float* ssc = (float*)smem;
  float* red = ssc + 2048;
  const int tid = otid();
  for (int i = tid; i < 1024; i += 256) {
    ssc[i] = silu_f(p.c[i]);
    ssc[1024 + i] = silu_f(p.c_ctx[i]);
  }
  __syncthreads();
  const int kq = tid >> 5, n = tid & 31, col = grp * 32 + n;
  const float* w = p.w_mod + (size_t)l * 1024 * 3072 + col;
  float a0 = 0.f, a1 = 0.f;
#pragma unroll 16
  for (int k = kq * 128; k < kq * 128 + 128; ++k) {
    float wv = w[(size_t)k * 3072];
    a0 += ssc[k] * wv;
    a1 += ssc[1024 + k] * wv;
  }
  red[(0 * 8 + kq) * 32 + n] = a0;
  red[(1 * 8 + kq) * 32 + n] = a1;
  __syncthreads();
  if (tid < 64) {
    int v = tid >> 5, nn = tid & 31;
    float s = 0.f;
    for (int q = 0; q < 8; ++q) s += red[(v * 8 + q) * 32 + nn];
    int cc = grp * 32 + nn;
    float* modv = (float*)(p.ws + OFF_MODV);
    modv[(l * 2 + v) * 3072 + cc] = s + p.b_mod[l * 3072 + cc];
  }
  __syncthreads();
}

DI void setup_phase(const Params& p, char* smem) {
  constexpr int N_A = 2 * 16 * 46, N_B = 2 * 16 * 16, N_C = 2 * 4 * 4, N_D = 192, N_E = 1;
  constexpr int NTOT = N_A + N_B + N_C + N_D + N_E;
  for (int item = blockIdx.x; item < NTOT; item += gridDim.x) {
    int it = item;
    if (it < N_A) {
      int l = it / (16 * 46), r = it % (16 * 46);
      int kt = r / 46, nt = r % 46;
      transpose_item(p.w_in + (size_t)l * 1024 * NIN, NIN, (u16*)(p.ws + OFF_WINT) + (size_t)l * NINP * 1024, 1024,
                     kt * 64, nt * 64, true, smem);
      continue;
    }
    it -= N_A;
    if (it < N_B) {
      int l = it / 256, r = it % 256;
      int kt = r / 16, nt = r % 16;
      transpose_item(p.w_out + (size_t)l * 1024 * 1024, 1024, (u16*)(p.ws + OFF_WOUTT) + (size_t)l * 1024 * 1024, 1024,
                     kt * 64, nt * 64, false, smem);
      continue;
    }
    it -= N_B;
    if (it < N_C) {
      int l = it / 16, r = it % 16;
      int kt = r / 4, nt = r % 4;
      transpose_item(p.glu_w + (size_t)l * 256 * 256, 256, (u16*)(p.ws + OFF_GLUWT) + (size_t)l * 256 * 256, 256,
                     kt * 64, nt * 64, false, smem);
      continue;
    }
    it -= N_C;
    if (it < N_D) { mod_item(p, it, smem); continue; }
    float* rope = (float*)(p.ws + OFF_ROPE);
    for (int e = otid(); e < 4096; e += 256) {
      int row = e >> 4, j = e & 15;
      float inv = powf(10000.f, -(float)j / 16.f);
      float ang = (float)row * inv;
      rope[e * 2] = cosf(ang);
      rope[e * 2 + 1] = sinf(ang);
    }
  }
}

DI void ln_mod_phase(const Params& p, const float* ctx_src, const float* lat_src, int l) {
  const int lane = otid() & 63, wave = otid() >> 6;
  const int nw = gridDim.x * 4;
  u16* h = (u16*)(p.ws + OFF_H);
  const float* modv = (const float*)(p.ws + OFF_MODV);
  for (int r = blockIdx.x * 4 + wave; r < T; r += nw) {
    const float* src = (r < NCTX) ? ctx_src + (size_t)r * DM : lat_src + (size_t)(r - NCTX) * DM;
    const float* mod = modv + (l * 2 + (r < NCTX ? 1 : 0)) * 3072;
    float4 v[4];
    float s = 0.f;
#pragma unroll
    for (int i = 0; i < 4; ++i) {
      v[i] = *(const float4*)(src + (i * 64 + lane) * 4);
      s += v[i].x + v[i].y + v[i].z + v[i].w;
    }
    float mu = wave_sum(s) * (1.f / DM);
    float q = 0.f;
#pragma unroll
    for (int i = 0; i < 4; ++i) {
      v[i].x -= mu; v[i].y -= mu; v[i].z -= mu; v[i].w -= mu;
      q += v[i].x * v[i].x + v[i].y * v[i].y + v[i].z * v[i].z + v[i].w * v[i].w;
    }
    float rstd = rsqrtf(wave_sum(q) * (1.f / DM) + EPS);
#pragma unroll
    for (int i = 0; i < 4; ++i) {
      int c0 = (i * 64 + lane) * 4;
      float4 sh = *(const float4*)(mod + c0);
      float4 sc = *(const float4*)(mod + 1024 + c0);
      float o0 = v[i].x * rstd * (1.f + sc.x) + sh.x;
      float o1 = v[i].y * rstd * (1.f + sc.y) + sh.y;
      float o2 = v[i].z * rstd * (1.f + sc.z) + sh.z;
      float o3 = v[i].w * rstd * (1.f + sc.w) + sh.w;
      uint2 pk = {pk2(o0, o1), pk2(o2, o3)};
      *(uint2*)(h + (size_t)r * DM + c0) = pk;
    }
  }
}

constexpr int G_LDA = 72;
DI void gemm_tile_compute(const u16* __restrict__ A, int lda, const u16* __restrict__ Bt, int ldb, int K, int m0, int n0,
                          char* smem) {
  u16* As = (u16*)smem;
  u16* Bs = As + 2 * 128 * G_LDA;
  const int tid = otid(), lane = tid & 63, wave = tid >> 6;
  const int wm = wave >> 1, wn = wave & 1;
  const int lr = lane & 31, lh = lane >> 5;
  f32x16 acc[2][2];
#pragma unroll
  for (int a = 0; a < 2; ++a)
#pragma unroll
    for (int b = 0; b < 2; ++b)
#pragma unroll
      for (int i = 0; i < 16; ++i) acc[a][b][i] = 0.f;

  const int KT = K / 64;
  uint4 ra0, ra1, ra2, ra3, rb0, rb1, rb2, rb3;
  const int srow = tid >> 3, sch = tid & 7;
  const u16* Ag = A + (size_t)(m0 + srow) * lda + sch * 8;
  const u16* Bg = Bt + (size_t)(n0 + srow) * ldb + sch * 8;
  const size_t a32 = (size_t)32 * lda, b32 = (size_t)32 * ldb;
#define G_LOAD(KT_)                                                                       \
  {                                                                                       \
    const u16* ag_ = Ag + (KT_) * 64;                                                     \
    const u16* bg_ = Bg + (KT_) * 64;                                                     \
    ra0 = *(const uint4*)(ag_);            rb0 = *(const uint4*)(bg_);                    \
    ra1 = *(const uint4*)(ag_ + a32);      rb1 = *(const uint4*)(bg_ + b32);              \
    ra2 = *(const uint4*)(ag_ + 2 * a32);  rb2 = *(const uint4*)(bg_ + 2 * b32);          \
    ra3 = *(const uint4*)(ag_ + 3 * a32);  rb3 = *(const uint4*)(bg_ + 3 * b32);          \
  }
#define G_STORE(BUF_)                                                                     \
  {                                                                                       \
    u16* as_ = As + ((BUF_) * 128 + srow) * G_LDA + sch * 8;                              \
    u16* bs_ = Bs + ((BUF_) * 128 + srow) * G_LDA + sch * 8;                              \
    *(uint4*)(as_) = ra0;                    *(uint4*)(bs_) = rb0;                        \
    *(uint4*)(as_ + 32 * G_LDA) = ra1;       *(uint4*)(bs_ + 32 * G_LDA) = rb1;           \
    *(uint4*)(as_ + 64 * G_LDA) = ra2;       *(uint4*)(bs_ + 64 * G_LDA) = rb2;           \
    *(uint4*)(as_ + 96 * G_LDA) = ra3;       *(uint4*)(bs_ + 96 * G_LDA) = rb3;           \
  }
  G_LOAD(0)
  G_STORE(0)
  __syncthreads();
  for (int kt = 0; kt < KT; ++kt) {
    const int buf = kt & 1;
    const int ktn = kt + 1 < KT ? kt + 1 : kt;
    G_LOAD(ktn)
    __builtin_amdgcn_sched_barrier(0);
    const u16* Ab = As + (buf * 128 + wm * 64 + lr) * G_LDA + lh * 8;
    const u16* Bb = Bs + (buf * 128 + wn * 64 + lr) * G_LDA + lh * 8;
    bf16x8 fa0[4], fa1[4], fb0[4], fb1[4];
#pragma unroll
    for (int ks = 0; ks < 4; ++ks) {
      fa0[ks] = *(const bf16x8*)(Ab + ks * 16);
      fa1[ks] = *(const bf16x8*)(Ab + 32 * G_LDA + ks * 16);
      fb0[ks] = *(const bf16x8*)(Bb + ks * 16);
      fb1[ks] = *(const bf16x8*)(Bb + 32 * G_LDA + ks * 16);
    }
    __builtin_amdgcn_sched_barrier(0);
#pragma unroll
    for (int ks = 0; ks < 4; ++ks) {
      acc[0][0] = MFMA32(fa0[ks], fb0[ks], acc[0][0]);
      acc[0][1] = MFMA32(fa0[ks], fb1[ks], acc[0][1]);
      acc[1][0] = MFMA32(fa1[ks], fb0[ks], acc[1][0]);
      acc[1][1] = MFMA32(fa1[ks], fb1[ks], acc[1][1]);
    }
    __builtin_amdgcn_sched_barrier(0);
    G_STORE(buf ^ 1)
    __syncthreads();
  }
  float* Cs = (float*)smem;
#pragma unroll
  for (int mi = 0; mi < 2; ++mi)
#pragma unroll
    for (int ni = 0; ni < 2; ++ni)
#pragma unroll
      for (int i = 0; i < 16; ++i) {
        int row = wm * 64 + mi * 32 + (i & 3) + 8 * (i >> 2) + 4 * lh;
        int col = wn * 64 + ni * 32 + lr;
        Cs[row * 132 + col] = acc[mi][ni][i];
      }
  __syncthreads();
}

template <bool OUT_BF16, bool SILU>
DI void epi_store(const float* Cs, void* dst, int ld, int m0, int coff, int ncols) {
  const int tid = otid();
  const int cpr = ncols >> 2;
  for (int idx = tid; idx < 128 * cpr; idx += 256) {
    int row = idx / cpr, c4 = idx % cpr;
    float4 v = *(const float4*)(Cs + row * 132 + 4 * c4);
    if (SILU) { v.x = silu_f(v.x); v.y = silu_f(v.y); v.z = silu_f(v.z); v.w = silu_f(v.w); }
    size_t o = (size_t)(m0 + row) * ld + coff + 4 * c4;
    if (OUT_BF16) *(uint2*)((u16*)dst + o) = make_uint2(pk2(v.x, v.y), pk2(v.z, v.w));
    else *(float4*)((float*)dst + o) = v;
  }
}

DI void epi_qk(const Params& p, const float* Cs, int l, int m0, int nt) {
  const int tid = otid();
  const int row = tid & 127, hh = tid >> 7;
  const int gr = m0 + row;
  const bool isk = (nt == 4);
  const float* gain = (isk ? p.kg : p.qg) + l * 64;
  float v[64];
  float ss = 0.f;
#pragma unroll
  for (int d4 = 0; d4 < 16; ++d4) {
    float4 t4 = *(const float4*)(Cs + row * 132 + hh * 64 + d4 * 4);
    v[4 * d4] = t4.x; v[4 * d4 + 1] = t4.y; v[4 * d4 + 2] = t4.z; v[4 * d4 + 3] = t4.w;
    ss += t4.x * t4.x + t4.y * t4.y + t4.z * t4.z + t4.w * t4.w;
  }
  float rinv = rsqrtf(ss * (1.f / 64.f) + EPS);
#pragma unroll
  for (int d = 0; d < 64; ++d) v[d] = v[d] * rinv * gain[d];
  if (gr >= NCTX) {
    const int t = gr - NCTX;
    const float* rope = (const float*)(p.ws + OFF_ROPE);
    const float* rr = rope + (t >> 6) * 32;
    const float* rc = rope + (t & 63) * 32;
#pragma unroll
    for (int j = 0; j < 16; ++j) {
      float c1 = rr[2 * j], s1 = rr[2 * j + 1];
      float a = v[j], b = v[j + 16];
      v[j] = a * c1 - b * s1;
      v[j + 16] = b * c1 + a * s1;
      float c2 = rc[2 * j], s2 = rc[2 * j + 1];
      float a2 = v[32 + j], b2 = v[48 + j];
      v[32 + j] = a2 * c2 - b2 * s2;
      v[48 + j] = b2 * c2 + a2 * s2;
    }
  }
  if (!isk) {
    constexpr float QS = 0.125f * 1.4426950408889634f;
#pragma unroll
    for (int d = 0; d < 64; ++d) v[d] *= QS;
  }
  u16* dst;
  if (isk) dst = (u16*)(p.ws + OFF_KB) + ((size_t)hh * T + gr) * 64;
  else dst = (u16*)(p.ws + OFF_QB) + ((size_t)(2 * nt + hh) * T + gr) * 64;
#pragma unroll
  for (int c = 0; c < 8; ++c) {
    uint4 o = {pk2(v[8 * c], v[8 * c + 1]), pk2(v[8 * c + 2], v[8 * c + 3]), pk2(v[8 * c + 4], v[8 * c + 5]),
               pk2(v[8 * c + 6], v[8 * c + 7])};
    *(uint4*)(dst + 8 * c) = o;
  }
}

DI void epi_v(const Params& p, const float* Cs, int m0) {
  const int tid = otid();
  const int c = tid & 127, half = tid >> 7;
  const int kvh = c >> 6, d = c & 63;
  u16* dst = (u16*)(p.ws + OFF_VT) + ((size_t)kvh * 64 + d) * T + m0 + half * 64;
#pragma unroll
  for (int g = 0; g < 8; ++g) {
    float v[8];
#pragma unroll
    for (int e = 0; e < 8; ++e) v[e] = Cs[(half * 64 + g * 8 + e) * 132 + c];
    uint4 o = {pk2(v[0], v[1]), pk2(v[2], v[3]), pk2(v[4], v[5]), pk2(v[6], v[7])};
    *(uint4*)(dst + g * 8) = o;
  }
}

DI void gemm_in_phase(const Params& p, int l, char* smem) {
  const u16* A = (const u16*)(p.ws + OFF_H);
  const u16* Bt = (const u16*)(p.ws + OFF_WINT) + (size_t)l * NINP * 1024;
  constexpr int MT = T / 128, NT = NINP / 128;
  const float* Cs = (const float*)smem;
  constexpr int NFULL = (MT / 8) * 8 * NT, MREM = MT % 8;
  for (int item = blockIdx.x; item < MT * NT; item += gridDim.x) {
    int mt, nt;
    if (item < NFULL) { const int xcd = item & 7, r = item >> 3; mt = (r / NT) * 8 + xcd; nt = r % NT; }
    else { const int j = item - NFULL; mt = (MT / 8) * 8 + j % MREM; nt = j / MREM; }
    const int m0 = mt * 128;
    gemm_tile_compute(A, 1024, Bt, 1024, 1024, m0, nt * 128, smem);
    if (nt <= 4) epi_qk(p, Cs, l, m0, nt);
    else if (nt == 5) epi_v(p, Cs, m0);
    else if (nt <= 9) epi_store<true, true>(Cs, p.ws + OFF_GATES, 1024, m0, (nt - 6) * 128, 128);
    else if (nt <= 15) epi_store<true, false>(Cs, p.ws + OFF_QKVB, 768, m0, (nt - 10) * 128, 128);
    else if (nt <= 17) epi_store<true, true>(Cs, p.ws + OFF_GATES, 1024, m0, 512 + (nt - 16) * 128, 128);
    else if (nt <= 19) epi_store<false, false>(Cs, p.ws + OFF_UC, 256, m0, (nt - 18) * 128, 128);
    else if (nt <= 21) epi_store<true, true>(Cs, p.ws + OFF_GATES, 1024, m0, 768 + (nt - 20) * 128, 128);
    else epi_store<false, false>(Cs, p.ws + OFF_BD, 16, m0, 0, 16);
    __syncthreads();
  }
}

DI void gemm_glu_phase(const Params& p, int l, char* smem) {
  const u16* A = (const u16*)(p.ws + OFF_QB);
  const u16* Bt = (const u16*)(p.ws + OFF_GLUWT) + (size_t)l * 256 * 256;
  const u16* gates = (const u16*)(p.ws + OFF_GATES);
  u16* mix = (u16*)(p.ws + OFF_H);
  const float* Cs = (const float*)smem;
  constexpr int MT = T / 128;
  for (int item = blockIdx.x; item < MT * 2; item += gridDim.x) {
    const int mt = item >> 1, nt = item & 1;
    const int m0 = mt * 128, n0 = nt * 128;
    gemm_tile_compute(A, 256, Bt, 256, 256, m0, n0, smem);
    for (int idx = otid(); idx < 128 * 64; idx += 256) {
      int row = idx >> 6, cp = idx & 63;
      int col = n0 + 2 * cp;
      size_t r = (size_t)(m0 + row);
      float a0 = Cs[row * 132 + 2 * cp] + p.glu_b[l * 256 + col];
      float a1 = Cs[row * 132 + 2 * cp + 1] + p.glu_b[l * 256 + col + 1];
      unsigned zz = *(const unsigned*)(A + r * 256 + col);
      unsigned gg = *(const unsigned*)(gates + r * 1024 + 768 + col);
      float z0 = bf2f((u16)(zz & 0xffff)), z1 = bf2f((u16)(zz >> 16));
      float g0 = bf2f((u16)(gg & 0xffff)), g1 = bf2f((u16)(gg >> 16));
      float o0 = z0 * sigmoid_f(a0) * g0, o1 = z1 * sigmoid_f(a1) * g1;
      *(unsigned*)(mix + r * 1024 + 768 + col) = pk2(o0, o1);
    }
    __syncthreads();
  }
}

DI void gemm_out_phase(const Params& p, int l, char* smem) {
  const u16* A = (const u16*)(p.ws + OFF_H);
  const u16* Bt = (const u16*)(p.ws + OFF_WOUTT) + (size_t)l * 1024 * 1024;
  const float* Cs = (const float*)smem;
  constexpr int MT = T / 128, NT = 8;
  const int mstart = (l == 1) ? 2 : 0;
  constexpr int NFULL = (MT / 8) * 8 * NT, MREM = MT % 8;
  const int nitems = (l == 1) ? NFULL : MT * NT;
  for (int item = blockIdx.x; item < nitems; item += gridDim.x) {
    int mt, nt;
    if (item < NFULL) { const int xcd = item & 7, r = item >> 3; mt = (r / NT) * 8 + xcd; nt = r % NT; }
    else { const int j = item - NFULL; mt = (MT / 8) * 8 + j % MREM; nt = j / MREM; }
    if (mt < mstart) mt += (MT / 8) * 8;
    gemm_tile_compute(A, 1024, Bt, 1024, 1024, mt * 128, nt * 128, smem);
    epi_store<false, false>(Cs, p.ws + OFF_DN, 1024, mt * 128, nt * 128, 128);
    __syncthreads();
  }
}

DI void dn_solve(const float* Lr, const float* sb, const float* gc, bool isv, const char* src, int stride_bytes, float* x) {
  int off = 0;
  const int hioff = isv ? 0 : 2;
  const unsigned lomask = isv ? 0u : 0xffffu;
  const float gsel = isv ? 0.f : 1.f;
#pragma unroll
  for (int li = 0; li < 64; ++li) {
    const unsigned hi = *(const u16*)(src + off + hioff);
    const unsigned lo = *(const u16*)(src + off);
    const float gcl = gc[li];
    float r = __uint_as_float((hi << 16) | (lo & lomask)) * __expf(gcl * gsel);
    off += stride_bytes;
    asm volatile("" : "+v"(off));
    float acc = r * sb[li];
#pragma unroll
    for (int lj4 = 0; lj4 < (li + 3) / 4; ++lj4) {
      float4 Lq = *(const float4*)(Lr + li * 64 + lj4 * 4);
      if (lj4 * 4 + 0 < li) acc -= Lq.x * x[lj4 * 4 + 0];
      if (lj4 * 4 + 1 < li) acc -= Lq.y * x[lj4 * 4 + 1];
      if (lj4 * 4 + 2 < li) acc -= Lq.z * x[lj4 * 4 + 2];
      if (lj4 * 4 + 3 < li) acc -= Lq.w * x[lj4 * 4 + 3];
    }
    x[li] = acc;
    if (li & 1) __builtin_amdgcn_sched_barrier(0);
  }
}

DI void dn_prep_item(const Params& p, int l, int unit, char* smem) {
  const int cid = unit >> 2, head = unit & 3;
  const int tt0 = cid * 64;
  const int seg_lo = cid < 4 ? 0 : NCTX, seg_hi = cid < 4 ? NCTX : T;
  float* sq = (float*)smem;
  float* sk = sq + 64 * 65;
  float* sL = sk + 64 * 65;
  float* sbeta = sL + 2 * 4096;
  float* sgc = sbeta + 128;
  float* sg = sgc + 128;
  u16* sv = (u16*)(sg + 128);
  const u16* z = (const u16*)(p.ws + OFF_QKVB);
  const float* bd = (const float*)(p.ws + OFF_BD);
  const float* cw = p.conv_w + l * 3 * 768;
  u16* dn = (u16*)(p.ws + OFF_DN) + (size_t)unit * 2 * 5 * 4096;
  u16* tmp = (u16*)(p.ws + OFF_H) + (size_t)blockIdx.x * 32768;
  float* glast = (float*)(p.ws + OFF_GLAST);
  const int tid = otid(), lane = tid & 63, wave = tid >> 6;

  {
    const int cq = head * 64 + lane, ck = 256 + head * 64 + lane;
    const float wq0 = cw[cq], wq1 = cw[768 + cq], wq2 = cw[1536 + cq];
    const float wk0 = cw[ck], wk1 = cw[768 + ck], wk2 = cw[1536 + ck];
#pragma unroll 8
    for (int i = wave; i < 64; i += 4) {
      const int tt = tt0 + i;
      float zq0 = 0.f, zq2 = 0.f, zk0 = 0.f, zk2 = 0.f;
      if (tt - 1 >= seg_lo) { zq0 = bf2f(z[(size_t)(tt - 1) * 768 + cq]); zk0 = bf2f(z[(size_t)(tt - 1) * 768 + ck]); }
      if (tt + 1 < seg_hi) { zq2 = bf2f(z[(size_t)(tt + 1) * 768 + cq]); zk2 = bf2f(z[(size_t)(tt + 1) * 768 + ck]); }
      float zq1 = bf2f(z[(size_t)tt * 768 + cq]), zk1 = bf2f(z[(size_t)tt * 768 + ck]);
      float vq = silu_f(wq0 * zq0 + wq1 * zq1 + wq2 * zq2);
      float vk = silu_f(wk0 * zk0 + wk1 * zk1 + wk2 * zk2);
      float s1 = wave_sum(vq * vq), s2 = wave_sum(vk * vk);
      sq[i * 65 + lane] = vq * rsqrtf(s1 + EPS) * 0.125f;
      sk[i * 65 + lane] = vk * rsqrtf(s2 + EPS);
    }
  }
  if (tid < 128) {
    const int dir = tid >> 6, i = tid & 63;
    const int tt = tt0 + i;
    const int li = dir ? 63 - i : i;
    float br = bd[(size_t)tt * 16 + dir * 4 + head];
    float ar = bd[(size_t)tt * 16 + 8 + dir * 4 + head];
    sbeta[dir * 64 + li] = 1.f / (1.f + expf(-br));
    float xx = ar + p.dt_bias[l * 8 + dir * 4 + head];
    float sp = fmaxf(xx, 0.f) + log1pf(expf(-fabsf(xx)));
    sg[dir * 64 + li] = -expf(p.A_log[l * 8 + dir * 4 + head]) * sp;
  }
  __syncthreads();
  if (tid == 0 || tid == 64) {
    const int dir = tid >> 6;
    float a = 0.f;
    for (int li = 0; li < 64; ++li) { a += sg[dir * 64 + li]; sgc[dir * 64 + li] = a; }
  }
  __syncthreads();

  {
    const int it = wave >> 1, jt = wave & 1;
    const int lr = lane & 31, lh = lane >> 5;
    f32x16 kk, qk;
#pragma unroll
    for (int r = 0; r < 16; ++r) { kk[r] = 0.f; qk[r] = 0.f; }
    const float* ki = sk + (32 * it + lr) * 65 + 8 * lh;
    const float* qi = sq + (32 * it + lr) * 65 + 8 * lh;
    const float* kj = sk + (32 * jt + lr) * 65 + 8 * lh;
#pragma unroll
    for (int ks = 0; ks < 4; ++ks) {
      bf16x8 fa = mk8u(pk2(ki[16 * ks], ki[16 * ks + 1]), pk2(ki[16 * ks + 2], ki[16 * ks + 3]), pk2(ki[16 * ks + 4], ki[16 * ks + 5]),
                       pk2(ki[16 * ks + 6], ki[16 * ks + 7]));
      bf16x8 fq = mk8u(pk2(qi[16 * ks], qi[16 * ks + 1]), pk2(qi[16 * ks + 2], qi[16 * ks + 3]), pk2(qi[16 * ks + 4], qi[16 * ks + 5]),
                       pk2(qi[16 * ks + 6], qi[16 * ks + 7]));
      bf16x8 fb = mk8u(pk2(kj[16 * ks], kj[16 * ks + 1]), pk2(kj[16 * ks + 2], kj[16 * ks + 3]), pk2(kj[16 * ks + 4], kj[16 * ks + 5]),
                       pk2(kj[16 * ks + 6], kj[16 * ks + 7]));
      kk = MFMA32(fa, fb, kk);
      qk = MFMA32(fq, fb, qk);
    }
    const int j = 32 * jt + lr;
#pragma unroll
    for (int dir = 0; dir < 2; ++dir) {
      u16* attn = tmp + dir * 16384;
      const int lj = dir ? 63 - j : j;
      const float gcj = sgc[dir * 64 + lj];
#pragma unroll
      for (int r = 0; r < 16; ++r) {
        const int i = 32 * it + (r & 3) + 8 * (r >> 2) + 4 * lh;
        const int li = dir ? 63 - i : i;
        const float dec = __expf(fminf(sgc[dir * 64 + li] - gcj, 0.f));
        const float Lv = (lj < li) ? sbeta[dir * 64 + li] * kk[r] * dec : 0.f;
        const float Av = (lj <= li) ? qk[r] * dec : 0.f;
        sL[dir * 4096 + li * 64 + lj] = Lv;
        attn[li * 64 + lj] = f2bf(Av);
      }
    }
  }
#pragma unroll
  for (int dir = 0; dir < 2; ++dir) {
    u16* kdT = tmp + dir * 16384 + 4096;
    {
      const int d = tid >> 2, lq = tid & 3;
      const float gl = sgc[dir * 64 + 63];
      unsigned o[8];
#pragma unroll
      for (int e = 0; e < 8; ++e) {
        const int li0 = lq * 16 + 2 * e, li1 = li0 + 1;
        const int i0 = dir ? 63 - li0 : li0, i1 = dir ? 63 - li1 : li1;
        float v0 = sk[i0 * 65 + d] * __expf(gl - sgc[dir * 64 + li0]);
        float v1 = sk[i1 * 65 + d] * __expf(gl - sgc[dir * 64 + li1]);
        o[e] = pk2(v0, v1);
      }
      *(uint4*)(kdT + d * 64 + lq * 16) = make_uint4(o[0], o[1], o[2], o[3]);
      *(uint4*)(kdT + d * 64 + lq * 16 + 8) = make_uint4(o[4], o[5], o[6], o[7]);
    }
    if (tid == 0) glast[unit * 2 + dir] = __expf(sgc[dir * 64 + 63]);
  }
  {
    const int cv = 512 + head * 64 + lane;
    const float w0 = cw[cv], w1 = cw[768 + cv], w2 = cw[1536 + cv];
#pragma unroll 8
    for (int i = wave; i < 64; i += 4) {
      const int tt = tt0 + i;
      float z0 = 0.f, z2 = 0.f;
      if (tt - 1 >= seg_lo) z0 = bf2f(z[(size_t)(tt - 1) * 768 + cv]);
      if (tt + 1 < seg_hi) z2 = bf2f(z[(size_t)(tt + 1) * 768 + cv]);
      float z1 = bf2f(z[(size_t)tt * 768 + cv]);
      sv[i * 72 + lane] = f2bf(silu_f(w0 * z0 + w1 * z1 + w2 * z2));
    }
  }
  __syncthreads();
  {
    const int dir = tid >> 7, col = tid & 127;
    const bool isv = col < 64;
    const int c6 = col & 63;
    float x[64];
    const char* src = isv ? (const char*)(sv + (dir ? 63 * 72 : 0) + c6) : (const char*)(sk + (dir ? 63 * 65 : 0) + c6);
    const int strideb = (isv ? 144 : 260) * (dir ? -1 : 1);
    dn_solve(sL + dir * 4096, sbeta + dir * 64, sgc + dir * 64, isv, src, strideb, x);
    u16* XT = tmp + dir * 16384 + 8192 + col * 64;
#pragma unroll
    for (int c = 0; c < 8; ++c)
      *(uint4*)(XT + 8 * c) = make_uint4(pk2(x[8 * c], x[8 * c + 1]), pk2(x[8 * c + 2], x[8 * c + 3]),
                                         pk2(x[8 * c + 4], x[8 * c + 5]), pk2(x[8 * c + 6], x[8 * c + 7]));
  }
  __threadfence_block();
  __syncthreads();
  {
    const int dir = wave >> 1, prod = wave & 1;
    const int lr = lane & 31, lh = lane >> 5;
    const u16* Aop = tmp + dir * 16384 + (prod ? 0 : 4096);
    const u16* XT = tmp + dir * 16384 + 8192;
    u16* dnd = dn + (size_t)dir * 5 * 4096;
    bf16x8 af[2][4];
#pragma unroll
    for (int mt = 0; mt < 2; ++mt)
#pragma unroll
      for (int ks = 0; ks < 4; ++ks) af[mt][ks] = *(const bf16x8*)(Aop + (mt * 32 + lr) * 64 + ks * 16 + lh * 8);
    {
      f32x16 acc[2][2];
#pragma unroll
      for (int a = 0; a < 2; ++a)
#pragma unroll
        for (int b = 0; b < 2; ++b)
#pragma unroll
          for (int i = 0; i < 16; ++i) acc[a][b][i] = 0.f;
#pragma unroll
      for (int nt = 0; nt < 2; ++nt)
#pragma unroll
        for (int ks = 0; ks < 4; ++ks) {
          bf16x8 b = *(const bf16x8*)(XT + (nt * 32 + lr) * 64 + ks * 16 + lh * 8);
          acc[0][nt] = MFMA32(af[0][ks], b, acc[0][nt]);
          acc[1][nt] = MFMA32(af[1][ks], b, acc[1][nt]);
        }
      u16* dst = dnd + (prod ? 3 : 1) * 4096;
#pragma unroll
      for (int mt = 0; mt < 2; ++mt)
#pragma unroll
        for (int nt = 0; nt < 2; ++nt)
#pragma unroll
          for (int g4 = 0; g4 < 4; ++g4) {
            uint2 o = {pk2(acc[mt][nt][4 * g4], acc[mt][nt][4 * g4 + 1]), pk2(acc[mt][nt][4 * g4 + 2], acc[mt][nt][4 * g4 + 3])};
            if (prod) {
              *(uint2*)(dst + (nt * 32 + lr) * 64 + mt * 32 + 8 * g4 + 4 * lh) = o;
            } else {
              const int dvv = nt * 32 + lr;
              const int mm = 2 * mt + (g4 >> 1), qq = 2 * (g4 & 1) + lh;
              *(uint2*)(dst + (((dvv >> 4) * 64 + qq * 16 + (dvv & 15)) * 4 + mm) * 4) = o;
            }
          }
    }
    {
      f32x16 acc[2][2];
#pragma unroll
      for (int a = 0; a < 2; ++a)
#pragma unroll
        for (int b = 0; b < 2; ++b)
#pragma unroll
          for (int i = 0; i < 16; ++i) acc[a][b][i] = 0.f;
#pragma unroll
      for (int mt = 0; mt < 2; ++mt)
#pragma unroll
        for (int ks = 0; ks < 4; ++ks) {
          bf16x8 a = *(const bf16x8*)(XT + (64 + mt * 32 + lr) * 64 + ks * 16 + lh * 8);
          acc[mt][0] = MFMA32(a, af[0][ks], acc[mt][0]);
          acc[mt][1] = MFMA32(a, af[1][ks], acc[mt][1]);
        }
      u16* dst = dnd + (prod ? 2 : 0) * 4096;
#pragma unroll
      for (int nt = 0; nt < 2; ++nt) {
        const int n = nt * 32 + lr;
        const int i = dir ? 63 - n : n;
        const float eg = __expf(sgc[dir * 64 + n]);
#pragma unroll
        for (int mt = 0; mt < 2; ++mt)
#pragma unroll
          for (int g4 = 0; g4 < 4; ++g4) {
            const int d0 = mt * 32 + 8 * g4 + 4 * lh;
            float v0 = acc[mt][nt][4 * g4], v1 = acc[mt][nt][4 * g4 + 1], v2 = acc[mt][nt][4 * g4 + 2], v3 = acc[mt][nt][4 * g4 + 3];
            if (prod) {
              v0 = sq[i * 65 + d0] * eg - v0;
              v1 = sq[i * 65 + d0 + 1] * eg - v1;
              v2 = sq[i * 65 + d0 + 2] * eg - v2;
              v3 = sq[i * 65 + d0 + 3] * eg - v3;
            }
            uint2 o = {pk2(v0, v1), pk2(v2, v3)};
            if (prod) {
              *(uint2*)(dst + n * 64 + d0) = o;
            } else {
              const int mm = n >> 4, cnn = n & 15, ss = mt, hif = g4 >> 1, qq = 2 * (g4 & 1) + lh;
              *(uint2*)(dst + ((mm * 2 + ss) * 64 + qq * 16 + cnn) * 8 + 4 * hif) = o;
            }
          }
      }
    }
  }
  __syncthreads();
}

DI void s5_coeffs(const Params& p, int l, int dir, int g, int pp, float& a_re, float& a_im, float* b_re, float* b_im) {
  const int gi = (l * 2 + dir) * 16 + g;
  const int idx = gi * 64 + pp;
  const float lr = p.A_re[idx], lim = p.A_im[idx];
  const float dt = expf(p.log_dt[gi]);
  const float mag = expf(lr * dt);
  const float ang = lim * dt;
  float sn, cs;
  sincosf(ang, &sn, &cs);
  a_re = mag * cs;
  a_im = mag * sn;
  const float nr = a_re - 1.f, ni = a_im;
  const float den = 1.f / (lr * lr + lim * lim);
  const float c_re = (nr * lr + ni * lim) * den;
  const float c_im = (ni * lr - nr * lim) * den;
  const float* Br = p.B_re + (size_t)idx * 16;
  const float* Bi = p.B_im + (size_t)idx * 16;
#pragma unroll
  for (int c = 0; c < 16; ++c) {
    float br = Br[c], bi = Bi[c];
    b_re[c] = c_re * br - c_im * bi;
    b_im[c] = c_re * bi + c_im * br;
  }
}


constexpr int S5_WAVE_LDS = 12800;
DI void s5_wave_sync() { asm volatile("s_waitcnt lgkmcnt(0)" ::: "memory"); }
DI void s5_bfrags(u16* sbw, const float* b_re, const float* b_im, int lane, bf16x8* bfrag) {
  *(uint4*)(sbw + lane * 32) = make_uint4(pk2(b_re[0], b_re[1]), pk2(b_re[2], b_re[3]), pk2(b_re[4], b_re[5]), pk2(b_re[6], b_re[7]));
  *(uint4*)(sbw + lane * 32 + 8) = make_uint4(pk2(b_re[8], b_re[9]), pk2(b_re[10], b_re[11]), pk2(b_re[12], b_re[13]), pk2(b_re[14], b_re[15]));
  *(uint4*)(sbw + lane * 32 + 16) = make_uint4(pk2(b_im[0], b_im[1]), pk2(b_im[2], b_im[3]), pk2(b_im[4], b_im[5]), pk2(b_im[6], b_im[7]));
  *(uint4*)(sbw + lane * 32 + 24) = make_uint4(pk2(b_im[8], b_im[9]), pk2(b_im[10], b_im[11]), pk2(b_im[12], b_im[13]), pk2(b_im[14], b_im[15]));
  s5_wave_sync();
  const int n = lane & 15, q4 = lane >> 4;
  const unsigned keep = (q4 < 2) ? 0xffffffffu : 0u;
#pragma unroll
  for (int nt = 0; nt < 8; ++nt) {
    const int state = 16 * (nt & 3) + n, part = nt >> 2;
    uint4 v = *(const uint4*)(sbw + state * 32 + part * 16 + 8 * (q4 & 1));
    bfrag[nt] = mk8u(v.x & keep, v.y & keep, v.z & keep, v.w & keep);
  }
}
DI void s5_bu_slab(const float* su, int wave, int dir, int s, int lane, const bf16x8* bfrag, u16* busw) {
  const int n = lane & 15, q4 = lane >> 4;
  const int li = 16 * s + n;
  const int i = dir ? 63 - li : li;
  const float* ur = su + i * 64 + wave * 16 + 8 * (q4 & 1);
  const float4 u0 = *(const float4*)ur, u1 = *(const float4*)(ur + 4);
  const unsigned keep = (q4 < 2) ? 0xffffffffu : 0u;
  const bf16x8 a = mk8u(pk2(u0.x, u0.y) & keep, pk2(u0.z, u0.w) & keep, pk2(u1.x, u1.y) & keep, pk2(u1.z, u1.w) & keep);
#pragma unroll
  for (int nt = 0; nt < 8; ++nt) {
    f32x4 acc = {0.f, 0.f, 0.f, 0.f};
    acc = MFMA16(a, bfrag[nt], acc);
    const int col = (nt >> 2) * 64 + 16 * (nt & 3) + n;
#pragma unroll
    for (int j = 0; j < 4; ++j) busw[(4 * q4 + j) * 136 + col] = f2bf(acc[j]);
  }
  s5_wave_sync();
}

DI void s5_a_item(const Params& p, int l, int item, char* smem) {
  const int quarter = item & 3, dir = (item >> 2) & 1, cid = item >> 3;
  const int tid = otid(), lane = tid & 63, wave = tid >> 6;
  const int g = quarter * 4 + wave;
  float* su = (float*)smem;
  const float* uC = (const float*)(p.ws + OFF_UC);
  for (int e = tid; e < 64 * 16; e += 256) {
    int i = e >> 4, c4 = e & 15;
    *(float4*)(su + i * 64 + c4 * 4) = *(const float4*)(uC + (size_t)(cid * 64 + i) * 256 + quarter * 64 + c4 * 4);
  }
  float a_re, a_im, b_re[16], b_im[16];
  s5_coeffs(p, l, dir, g, lane, a_re, a_im, b_re, b_im);
  u16* wl = (u16*)(smem + 16384 + wave * S5_WAVE_LDS);
  u16* busw = wl + 2176;
  u16* sbw = wl + 4352;
  bf16x8 bfrag[8];
  s5_bfrags(sbw, b_re, b_im, lane, bfrag);
  __syncthreads();
  float h_re = 0.f, h_im = 0.f;
  for (int s4 = 0; s4 < 4; ++s4) {
    s5_bu_slab(su, wave, dir, s4, lane, bfrag, busw);
#pragma unroll
    for (int r = 0; r < 16; ++r) {
      const float bu_re = bf2f(busw[r * 136 + lane]), bu_im = bf2f(busw[r * 136 + 64 + lane]);
      float nr = a_re * h_re - a_im * h_im + bu_re;
      float ni = a_re * h_im + a_im * h_re + bu_im;
      h_re = nr; h_im = ni;
    }
    s5_wave_sync();
  }
  float2* E = (float2*)(p.ws + OFF_S5E);
  E[((size_t)(cid * 2 + dir) * 16 + g) * 64 + lane] = make_float2(h_re, h_im);
  __syncthreads();
}

DI int chain_cid(int dir, int pos) { return dir == 0 ? pos : (pos < 4 ? 3 - pos : 263 - pos); }

DI void s5_carry(const Params& p, int l, int sblk) {
  const int id = sblk * 256 + otid();
  const int dir = id >> 10, g = (id >> 6) & 15, pp = id & 63;
  const int gi = (l * 2 + dir) * 16 + g;
  const float lr = p.A_re[gi * 64 + pp], lim = p.A_im[gi * 64 + pp];
  const float dt = expf(p.log_dt[gi]);
  const float mag = expf(lr * dt);
  float sn, cs;
  sincosf(lim * dt, &sn, &cs);
  float ar = mag * cs, ai = mag * sn;
#pragma unroll
  for (int i = 0; i < 6; ++i) { float nr = ar * ar - ai * ai, ni = 2.f * ar * ai; ar = nr; ai = ni; }
  const float2* E = (const float2*)(p.ws + OFF_S5E);
  float2* H = (float2*)(p.ws + OFF_S5H);
  float hr = 0.f, hi = 0.f;
  asm volatile("" : "+v"(hr), "+v"(hi));
  for (int pos0 = 0; pos0 < NCH; pos0 += 20) {
    float2 e[20];
    size_t o[20];
#pragma unroll
    for (int u = 0; u < 20; ++u) {
      int cid = chain_cid(dir, pos0 + u);
      o[u] = ((size_t)(cid * 2 + dir) * 16 + g) * 64 + pp;
      e[u] = E[o[u]];
    }
#pragma unroll
    for (int u = 0; u < 20; ++u) {
      H[o[u]] = make_float2(hr, hi);
      float nr = ar * hr - ai * hi + e[u].x;
      float ni = ar * hi + ai * hr + e[u].y;
      hr = nr; hi = ni;
    }
  }
}

DI void s5_c_item(const Params& p, int l, int item, char* smem) {
  const int quarter = item & 3, cid = item >> 2;
  const int tid = otid(), lane = tid & 63, wave = tid >> 6;
  const int g = quarter * 4 + wave;
  float* su = (float*)smem;
  u16* hs = (u16*)(smem + 16384 + wave * S5_WAVE_LDS);
  u16* busw = hs + 2176;
  u16* sbw = hs + 4352;
  const float* uC = (const float*)(p.ws + OFF_UC);
  const float2* Hin = (const float2*)(p.ws + OFF_S5H);
  u16* zg = (u16*)(p.ws + OFF_QB);
  for (int e = tid; e < 64 * 16; e += 256) {
    int i = e >> 4, c4 = e & 15;
    *(float4*)(su + i * 64 + c4 * 4) = *(const float4*)(uC + (size_t)(cid * 64 + i) * 256 + quarter * 64 + c4 * 4);
  }
  __syncthreads();
  const int cc = lane & 15, q4 = lane >> 4;
  f32x4 yacc[4];
#pragma unroll
  for (int t = 0; t < 4; ++t) yacc[t] = (f32x4){0.f, 0.f, 0.f, 0.f};
#pragma unroll
  for (int dir = 0; dir < 2; ++dir) {
    float a_re, a_im, b_re[16], b_im[16];
    s5_coeffs(p, l, dir, g, lane, a_re, a_im, b_re, b_im);
    bf16x8 cf[4];
    {
      const size_t cb = ((size_t)((l * 2 + dir) * 16 + g) * 16 + cc) * 64;
#pragma unroll
      for (int s = 0; s < 4; ++s) {
        const float* src = (s < 2 ? p.C_re : p.C_im) + cb + 32 * (s & 1) + 8 * q4;
        const float sgn = (s < 2) ? 1.f : -1.f;
        float4 v0 = *(const float4*)src, v1 = *(const float4*)(src + 4);
        cf[s] = mk8u(pk2(sgn * v0.x, sgn * v0.y), pk2(sgn * v0.z, sgn * v0.w), pk2(sgn * v1.x, sgn * v1.y),
                     pk2(sgn * v1.z, sgn * v1.w));
      }
    }
    bf16x8 bfrag[8];
    s5_bfrags(sbw, b_re, b_im, lane, bfrag);
    float2 h0 = Hin[((size_t)(cid * 2 + dir) * 16 + g) * 64 + lane];
    float h_re = h0.x, h_im = h0.y;
#pragma unroll
    for (int s = 0; s < 4; ++s) {
      s5_bu_slab(su, wave, dir, s, lane, bfrag, busw);
#pragma unroll
      for (int r = 0; r < 16; ++r) {
        const float bu_re = bf2f(busw[r * 136 + lane]), bu_im = bf2f(busw[r * 136 + 64 + lane]);
        float nr = a_re * h_re - a_im * h_im + bu_re;
        float ni = a_re * h_im + a_im * h_re + bu_im;
        h_re = nr; h_im = ni;
        const int rr = dir ? 15 - r : r;
        hs[rr * 136 + lane] = f2bf(h_re);
        hs[rr * 136 + 64 + lane] = f2bf(h_im);
      }
      asm volatile("s_waitcnt lgkmcnt(0)" ::: "memory");
      const int tile = dir ? 3 - s : s;
#pragma unroll
      for (int ks = 0; ks < 4; ++ks) {
        bf16x8 a = *(const bf16x8*)(hs + cc * 136 + 32 * ks + 8 * q4);
        yacc[tile] = MFMA16(a, cf[ks], yacc[tile]);
      }
      asm volatile("s_waitcnt lgkmcnt(0)" ::: "memory");
    }
  }
  const int ch = g * 16 + cc;
  const float dsk = p.Dskip[l * 256 + ch];
#pragma unroll
  for (int tile = 0; tile < 4; ++tile)
#pragma unroll
    for (int j = 0; j < 4; ++j) {
      const int t = 16 * tile + 4 * q4 + j;
      float y = yacc[tile][j] + su[t * 64 + wave * 16 + cc] * dsk;
      zg[(size_t)(cid * 64 + t) * 256 + ch] = f2bf(gelu_tanh(y));
    }
  __syncthreads();
}

DI void dn_out_item(const Params& p, int l, int unit, char* smem) {
  const int cid = unit >> 2, head = unit & 3;
  const int tid = otid(), lane = tid & 63, wave = tid >> 6;
  const int lr = lane & 31, lh = lane >> 5;
  float* so = (float*)smem;
  const u16* gates = (const u16*)(p.ws + OFF_GATES);
  u16* mix = (u16*)(p.ws + OFF_H);
  const int dir = wave >> 1, mt = wave & 1;
  const u16* dnd = (const u16*)(p.ws + OFF_DN) + ((size_t)unit * 2 + dir) * 5 * 4096;
  const u16* Pm = dnd + 2 * 4096, *RT = dnd + 3 * 4096, *ST = dnd + 4 * 4096;
  f32x16 acc[2];
#pragma unroll
  for (int nt = 0; nt < 2; ++nt)
#pragma unroll
    for (int i = 0; i < 16; ++i) acc[nt][i] = 0.f;
#pragma unroll
  for (int ks = 0; ks < 4; ++ks) {
    bf16x8 a = *(const bf16x8*)(Pm + (mt * 32 + lr) * 64 + ks * 16 + lh * 8);
#pragma unroll
    for (int nt = 0; nt < 2; ++nt) {
      bf16x8 b = *(const bf16x8*)(ST + (nt * 32 + lr) * 64 + ks * 16 + lh * 8);
      acc[nt] = MFMA32(a, b, acc[nt]);
    }
  }
#pragma unroll
  for (int nt = 0; nt < 2; ++nt)
#pragma unroll
    for (int g4 = 0; g4 < 4; ++g4) {
      uint2 rr = *(const uint2*)(RT + (nt * 32 + lr) * 64 + mt * 32 + 8 * g4 + 4 * lh);
      acc[nt][4 * g4 + 0] += bf2f((u16)(rr.x & 0xffff));
      acc[nt][4 * g4 + 1] += bf2f((u16)(rr.x >> 16));
      acc[nt][4 * g4 + 2] += bf2f((u16)(rr.y & 0xffff));
      acc[nt][4 * g4 + 3] += bf2f((u16)(rr.y >> 16));
    }
  if (dir == 0) {
#pragma unroll
    for (int nt = 0; nt < 2; ++nt)
#pragma unroll
      for (int i = 0; i < 16; ++i) {
        const int li = mt * 32 + (i & 3) + 8 * (i >> 2) + 4 * lh;
        so[li * 65 + nt * 32 + lr] = acc[nt][i];
      }
  }
  __syncthreads();
  if (dir == 1) {
#pragma unroll
    for (int nt = 0; nt < 2; ++nt)
#pragma unroll
      for (int i = 0; i < 16; ++i) {
        const int li = mt * 32 + (i & 3) + 8 * (i >> 2) + 4 * lh;
        so[(63 - li) * 65 + nt * 32 + lr] += acc[nt][i];
      }
  }
  __syncthreads();
  const float gain = p.out_gain[l * 64 + lane];
#pragma unroll
  for (int i0 = 0; i0 < 16; ++i0) {
    const int i = wave + 4 * i0;
    const size_t tt = (size_t)cid * 64 + i;
    const int c = head * 64 + lane;
    float o = so[i * 65 + lane];
    float ms = wave_sum(o * o) * (1.f / 64.f);
    float v = o * rsqrtf(ms + EPS) * gain * bf2f(gates[tt * 1024 + 512 + c]);
    mix[tt * 1024 + 512 + c] = f2bf(v);
  }
  __syncthreads();
}

#define SCAN_LOAD(U, POS)                                                                      \
  {                                                                                            \
    const int cid_ = chain_cid(dir, (POS));                                                    \
    const u16* base_ = dnb + ((size_t)(cid_ * 4 + head) * 2 + dir) * 5 * 4096;                 \
    _Pragma("unroll") for (int m = 0; m < 4; ++m) {                                            \
      _Pragma("unroll") for (int s2 = 0; s2 < 2; ++s2) {                                       \
        const uint4 t_ = *(const uint4*)(base_ + ((m * 2 + s2) * 64 + lane) * 8);              \
        mlo##U[m][s2] = make_uint2(t_.x, t_.y);                                                \
        mhi##U[m][s2] = make_uint2(t_.z, t_.w);                                                \
      }                                                                                        \
    }                                                                                          \
    {                                                                                          \
      const uint4 t0_ = *(const uint4*)(base_ + 4096 + (cgp * 64 + lane) * 16);                \
      const uint4 t1_ = *(const uint4*)(base_ + 4096 + (cgp * 64 + lane) * 16 + 8);            \
      ntv##U[0] = make_uint2(t0_.x, t0_.y); ntv##U[1] = make_uint2(t0_.z, t0_.w);              \
      ntv##U[2] = make_uint2(t1_.x, t1_.y); ntv##U[3] = make_uint2(t1_.z, t1_.w);              \
    }                                                                                          \
    gl##U = glast[(cid_ * 4 + head) * 2 + dir];                                                \
  }
#define SCAN_COMPUTE(U, POS)                                                                   \
  {                                                                                            \
    const int cid_ = chain_cid(dir, (POS));                                                    \
    u16* STp_ = dnb + (((size_t)(cid_ * 4 + head) * 2 + dir) * 5 + 4) * 4096 + dv * 64 + 4 * q4; \
    unsigned pk_[4][2];                                                                        \
    _Pragma("unroll") for (int m = 0; m < 4; ++m) {                                            \
      pk_[m][0] = pk2(S[m][0], S[m][1]);                                                       \
      pk_[m][1] = pk2(S[m][2], S[m][3]);                                                       \
      *(uint2*)(STp_ + 16 * m) = make_uint2(pk_[m][0], pk_[m][1]);                             \
    }                                                                                          \
    bf16x8 sb0_ = mk8u(pk_[0][0], pk_[0][1], pk_[1][0], pk_[1][1]);                            \
    bf16x8 sb1_ = mk8u(pk_[2][0], pk_[2][1], pk_[3][0], pk_[3][1]);                            \
    _Pragma("unroll") for (int m = 0; m < 4; ++m) {                                            \
      f32x4 acc_ = {0.f, 0.f, 0.f, 0.f};                                                       \
      acc_ = MFMA16(mk8(mlo##U[m][0], mhi##U[m][0]), sb0_, acc_);                              \
      acc_ = MFMA16(mk8(mlo##U[m][1], mhi##U[m][1]), sb1_, acc_);                              \
      S[m][0] = gl##U * S[m][0] - acc_[0] + bf2f((u16)(ntv##U[m].x & 0xffff));                 \
      S[m][1] = gl##U * S[m][1] - acc_[1] + bf2f((u16)(ntv##U[m].x >> 16));                    \
      S[m][2] = gl##U * S[m][2] - acc_[2] + bf2f((u16)(ntv##U[m].y & 0xffff));                 \
      S[m][3] = gl##U * S[m][3] - acc_[3] + bf2f((u16)(ntv##U[m].y >> 16));                    \
    }                                                                                          \
  }
DI void dn_scan_wave(const Params& p, int task) {
  const int head = task & 3, dir = (task >> 2) & 1, cgp = task >> 3;
  const int lane = otid() & 63;
  const int cn = lane & 15, q4 = lane >> 4;
  const int dv = cgp * 16 + cn;
  u16* dnb = (u16*)(p.ws + OFF_DN);
  const float* glast = (const float*)(p.ws + OFF_GLAST);
  f32x4 S[4];
#pragma unroll
  for (int m = 0; m < 4; ++m) S[m] = (f32x4){0.f, 0.f, 0.f, 0.f};
  uint2 mlo0[4][2], mhi0[4][2], ntv0[4]; float gl0;
  uint2 mlo1[4][2], mhi1[4][2], ntv1[4]; float gl1;
  uint2 mlo2[4][2], mhi2[4][2], ntv2[4]; float gl2;
  uint2 mlo3[4][2], mhi3[4][2], ntv3[4]; float gl3;
  SCAN_LOAD(0, 0) SCAN_LOAD(1, 1) SCAN_LOAD(2, 2) SCAN_LOAD(3, 3)
  for (int pos0 = 0; pos0 < NCH; pos0 += 4) {
    const bool more = pos0 + 4 < NCH;
    SCAN_COMPUTE(0, pos0) if (more) SCAN_LOAD(0, pos0 + 4)
    SCAN_COMPUTE(1, pos0 + 1) if (more) SCAN_LOAD(1, pos0 + 5)
    SCAN_COMPUTE(2, pos0 + 2) if (more) SCAN_LOAD(2, pos0 + 6)
    SCAN_COMPUTE(3, pos0 + 3) if (more) SCAN_LOAD(3, pos0 + 7)
  }
}

constexpr int A_LD = 72;
constexpr int V_LD = 136;
DI void attn_item(const Params& p, int item, char* smem) {
  int head, q0, ntiles;
  if (item < 512) { head = item & 7; q0 = NCTX + (item >> 3) * 256; ntiles = NCH; }
  else { head = item - 512; q0 = 0; ntiles = 4; }
  const int kvh = head >> 2;
  const int tid = otid(), lane = tid & 63, wave = tid >> 6;
  const int lr = lane & 31, lh = lane >> 5;
  const u16* Qb = (const u16*)(p.ws + OFF_QB) + (size_t)head * T * 64;
  const u16* Kb = (const u16*)(p.ws + OFF_KB) + (size_t)kvh * T * 64;
  const u16* Vt = (const u16*)(p.ws + OFF_VT) + (size_t)kvh * 64 * T;
  u16* Ks = (u16*)smem;
  u16* Vs = Ks + 2 * 128 * A_LD;
  bf16x8 qf[2][4];
#pragma unroll
  for (int qt = 0; qt < 2; ++qt)
#pragma unroll
    for (int ks = 0; ks < 4; ++ks)
      qf[qt][ks] = *(const bf16x8*)(Qb + (size_t)(q0 + wave * 64 + qt * 32 + lr) * 64 + ks * 16 + lh * 8);

  f32x16 ot[2][2];
#pragma unroll
  for (int a = 0; a < 2; ++a)
#pragma unroll
    for (int b = 0; b < 2; ++b)
#pragma unroll
      for (int i = 0; i < 16; ++i) ot[a][b][i] = 0.f;
  float lrun[2] = {0.f, 0.f};

  uint4 rk0, rk1, rv0, rv1;
  const int srow = tid >> 3, sch = tid & 7;
  const u16* Kg = Kb + (size_t)srow * 64 + sch * 8;
  const u16* Vg = Vt + (size_t)srow * T + sch * 8;
#define A_LOAD(J_)                                                               \
  {                                                                              \
    const u16* kg_ = Kg + (size_t)(J_) * 4096;                                   \
    const u16* vg_ = Vg + (size_t)(J_) * 64;                                     \
    rk0 = *(const uint4*)(kg_);  rk1 = *(const uint4*)(kg_ + 32 * 64);           \
    rv0 = *(const uint4*)(vg_);  rv1 = *(const uint4*)(vg_ + (size_t)32 * T);    \
  }
#define A_STORE(BUF_, HALF_)                                                     \
  {                                                                              \
    u16* ks_ = Ks + ((BUF_) * 128 + (HALF_) * 64 + srow) * A_LD + sch * 8;       \
    u16* vs_ = Vs + ((BUF_) * 64 + srow) * V_LD + (HALF_) * 64 + sch * 8;        \
    *(uint4*)(ks_) = rk0;  *(uint4*)(ks_ + 32 * A_LD) = rk1;                     \
    *(uint4*)(vs_) = rv0;  *(uint4*)(vs_ + 32 * V_LD) = rv1;                     \
  }
  A_LOAD(0)
  A_STORE(0, 0)
  A_LOAD(1)
  A_STORE(0, 1)
  __syncthreads();
  const int npairs = ntiles >> 1;
  for (int jj = 0; jj < npairs; ++jj) {
    const int buf = jj & 1;
    const int jnext = (jj + 1 < npairs ? jj + 1 : jj) * 2;
#pragma unroll 1
    for (int half = 0; half < 2; ++half) {
    A_LOAD(jnext + half)
    __builtin_amdgcn_sched_barrier(0);
    const u16* Kt = Ks + (buf * 128 + half * 64) * A_LD;
    const u16* Vtile = Vs + buf * 64 * V_LD + half * 64;
    f32x16 st[2][2];
#pragma unroll
    for (int a = 0; a < 2; ++a)
#pragma unroll
      for (int b = 0; b < 2; ++b)
#pragma unroll
        for (int i = 0; i < 16; ++i) st[a][b][i] = 0.f;
    {
      bf16x8 kf[2][4];
#pragma unroll
      for (int kt = 0; kt < 2; ++kt)
#pragma unroll
        for (int ks = 0; ks < 4; ++ks) kf[kt][ks] = *(const bf16x8*)(Kt + (kt * 32 + lr) * A_LD + ks * 16 + lh * 8);
      __builtin_amdgcn_sched_barrier(0);
#pragma unroll
      for (int kt = 0; kt < 2; ++kt)
#pragma unroll
        for (int ks = 0; ks < 4; ++ks) {
          st[kt][0] = MFMA32(kf[kt][ks], qf[0][ks], st[kt][0]);
          st[kt][1] = MFMA32(kf[kt][ks], qf[1][ks], st[kt][1]);
        }
    }
#pragma unroll
    for (int kt = 0; kt < 2; ++kt) {
#pragma unroll
      for (int qt = 0; qt < 2; ++qt) {
        float ls0 = 0.f, ls1 = 0.f;
#pragma unroll
        for (int i = 0; i < 16; i += 2) {
          float p0 = __builtin_amdgcn_exp2f(st[kt][qt][i]);
          float p1 = __builtin_amdgcn_exp2f(st[kt][qt][i + 1]);
          st[kt][qt][i] = p0;
          st[kt][qt][i + 1] = p1;
          ls0 += p0;
          ls1 += p1;
        }
        lrun[qt] += ls0 + ls1;
      }
#pragma unroll
      for (int ss = 0; ss < 2; ++ss) {
        bf16x8 pb[2];
#pragma unroll
        for (int qt = 0; qt < 2; ++qt)
          pb[qt] = mk8u(pk2(st[kt][qt][8 * ss + 0], st[kt][qt][8 * ss + 1]), pk2(st[kt][qt][8 * ss + 2], st[kt][qt][8 * ss + 3]),
                        pk2(st[kt][qt][8 * ss + 4], st[kt][qt][8 * ss + 5]), pk2(st[kt][qt][8 * ss + 6], st[kt][qt][8 * ss + 7]));
#pragma unroll
        for (int dt = 0; dt < 2; ++dt) {
          const u16* pr = Vtile + (dt * 32 + lr) * V_LD + 32 * kt + 16 * ss + 4 * lh;
          uint2 lo = *(const uint2*)pr;
          uint2 hi = *(const uint2*)(pr + 8);
          bf16x8 a = mk8(lo, hi);
#pragma unroll
          for (int qt = 0; qt < 2; ++qt) ot[dt][qt] = MFMA32(a, pb[qt], ot[dt][qt]);
        }
      }
    }
    __builtin_amdgcn_sched_barrier(0);
    A_STORE(buf ^ 1, half)
    }
    __syncthreads();
  }
  const u16* gates = (const u16*)(p.ws + OFF_GATES);
  u16* mix = (u16*)(p.ws + OFF_H);
#pragma unroll
  for (int qt = 0; qt < 2; ++qt) {
    const float lt = lrun[qt] + __shfl_xor(lrun[qt], 32);
    const float inv = 1.f / lt;
    const size_t row = (size_t)(q0 + wave * 64 + qt * 32 + lr);
#pragma unroll
    for (int dt = 0; dt < 2; ++dt)
#pragma unroll
      for (int g4 = 0; g4 < 4; ++g4) {
        const int d0 = 32 * dt + 8 * g4 + 4 * lh;
        uint2 gg = *(const uint2*)(gates + row * 1024 + head * 64 + d0);
        float o0 = ot[dt][qt][4 * g4 + 0] * inv * bf2f((u16)(gg.x & 0xffff));
        float o1 = ot[dt][qt][4 * g4 + 1] * inv * bf2f((u16)(gg.x >> 16));
        float o2 = ot[dt][qt][4 * g4 + 2] * inv * bf2f((u16)(gg.y & 0xffff));
        float o3 = ot[dt][qt][4 * g4 + 3] * inv * bf2f((u16)(gg.y >> 16));
        uint2 o = {pk2(o0, o1), pk2(o2, o3)};
        *(uint2*)(mix + row * 1024 + head * 64 + d0) = o;
      }
  }
}

DI void final_ln_phase(const Params& p, int l, const float* ctx_src, const float* lat_src) {
  const int lane = otid() & 63, wave = otid() >> 6;
  const int nw = gridDim.x * 4;
  const float* y = (const float*)(p.ws + OFF_DN);
  const float* modv = (const float*)(p.ws + OFF_MODV);
  float* ctx1 = (float*)(p.ws + OFF_CTX1);
  u16* h = (u16*)(p.ws + OFF_H);
  const int rstart = (l == 1) ? NCTX : 0;
  for (int r = rstart + blockIdx.x * 4 + wave; r < T; r += nw) {
    const bool isc = r < NCTX;
    const float* src = isc ? ctx_src + (size_t)r * DM : lat_src + (size_t)(r - NCTX) * DM;
    float* dst = isc ? ctx1 + (size_t)r * DM : p.out + (size_t)(r - NCTX) * DM;
    const float* mod = modv + (l * 2 + (isc ? 1 : 0)) * 3072;
    float4 v[4];
    float s = 0.f;
#pragma unroll
    for (int i = 0; i < 4; ++i) {
      int c0 = (i * 64 + lane) * 4;
      float4 xv = *(const float4*)(src + c0);
      float4 yv = *(const float4*)(y + (size_t)r * DM + c0);
      float4 gv = *(const float4*)(mod + 2048 + c0);
      v[i].x = DN_ALPHA * xv.x + gv.x * yv.x;
      v[i].y = DN_ALPHA * xv.y + gv.y * yv.y;
      v[i].z = DN_ALPHA * xv.z + gv.z * yv.z;
      v[i].w = DN_ALPHA * xv.w + gv.w * yv.w;
      s += v[i].x + v[i].y + v[i].z + v[i].w;
    }
    float mu = wave_sum(s) * (1.f / DM);
    float q = 0.f;
#pragma unroll
    for (int i = 0; i < 4; ++i) {
      v[i].x -= mu; v[i].y -= mu; v[i].z -= mu; v[i].w -= mu;
      q += v[i].x * v[i].x + v[i].y * v[i].y + v[i].z * v[i].z + v[i].w * v[i].w;
    }
    float rstd = rsqrtf(wave_sum(q) * (1.f / DM) + EPS);
    float s2 = 0.f;
#pragma unroll
    for (int i = 0; i < 4; ++i) {
      int c0 = (i * 64 + lane) * 4;
      float4 g = *(const float4*)(p.ln_g + l * DM + c0);
      float4 b = *(const float4*)(p.ln_b + l * DM + c0);
      v[i].x = v[i].x * rstd * g.x + b.x;
      v[i].y = v[i].y * rstd * g.y + b.y;
      v[i].z = v[i].z * rstd * g.z + b.z;
      v[i].w = v[i].w * rstd * g.w + b.w;
      *(float4*)(dst + c0) = v[i];
      s2 += v[i].x + v[i].y + v[i].z + v[i].w;
    }
    if (l == 0) {
      const float* mod1 = modv + (2 + (isc ? 1 : 0)) * 3072;
      float mu2 = wave_sum(s2) * (1.f / DM);
      float q2 = 0.f;
#pragma unroll
      for (int i = 0; i < 4; ++i) {
        v[i].x -= mu2; v[i].y -= mu2; v[i].z -= mu2; v[i].w -= mu2;
        q2 += v[i].x * v[i].x + v[i].y * v[i].y + v[i].z * v[i].z + v[i].w * v[i].w;
      }
      float rstd2 = rsqrtf(wave_sum(q2) * (1.f / DM) + EPS);
#pragma unroll
      for (int i = 0; i < 4; ++i) {
        int c0 = (i * 64 + lane) * 4;
        float4 sh = *(const float4*)(mod1 + c0);
        float4 sc = *(const float4*)(mod1 + 1024 + c0);
        float o0 = v[i].x * rstd2 * (1.f + sc.x) + sh.x;
        float o1 = v[i].y * rstd2 * (1.f + sc.y) + sh.y;
        float o2 = v[i].z * rstd2 * (1.f + sc.z) + sh.z;
        float o3 = v[i].w * rstd2 * (1.f + sc.w) + sh.w;
        uint2 pk = {pk2(o0, o1), pk2(o2, o3)};
        *(uint2*)(h + (size_t)r * DM + c0) = pk;
      }
    }
  }
}

#ifndef REP_ATTN
#define REP_ATTN 1
#endif
#ifndef REP_SCAN
#define REP_SCAN 1
#endif
#ifndef REP_GEMM
#define REP_GEMM 1
#endif
#ifndef REP_PREP
#define REP_PREP 1
#endif
#ifndef REP_P5
#define REP_P5 1
#endif
typedef const __attribute__((address_space(4))) Params* KParamsPtr;
DI const Params& kp() {
  KParamsPtr q = (KParamsPtr)__builtin_amdgcn_kernarg_segment_ptr();
  asm volatile("" : "+s"(q));
  return *(const Params*)q;
}
__global__ void __launch_bounds__(256, 2) fwd_megakernel(Params pin) {
  cg::grid_group grid = cg::this_grid();
  __shared__ __attribute__((aligned(16))) char smem[SMEM_BYTES];
  const int nb = gridDim.x;
  __shared__ uint4 xb_words;
  if (threadIdx.x == 0) xb_words = make_uint4(0u, 0u, 0u, 0u);
  __syncthreads();
  (void)xcd_barrier_post((unsigned*)(kp().ws + OFF_BAR), (volatile LAS unsigned*)&xb_words);
#define GRID_BARRIER() do { XcdBarrier xb_; xb_.bar = (unsigned*)(kp().ws + OFF_BAR); xb_.x = xb_xcc_id(); xb_.st = (volatile LAS unsigned*)&xb_words; xcd_barrier(xb_); } while (0)

  if (kp().ws == nullptr) grid.sync();
  setup_phase(kp(), smem);
  GRID_BARRIER();
  { const Params& p = kp(); ln_mod_phase(p, p.ctx, p.x, 0); }
  GRID_BARRIER();

  for (int l = 0; l < 2; ++l) {
    for (int rep = 0; rep < REP_GEMM; ++rep) gemm_in_phase(kp(), l, smem);
    GRID_BARRIER();
    for (int rep = 0; rep < REP_PREP; ++rep)
    for (int item = blockIdx.x; item < 1040 + 2080; item += nb) {
      if (item < 1040) dn_prep_item(kp(), l, item, smem);
      else s5_a_item(kp(), l, item - 1040, smem);
    }
    GRID_BARRIER();
    for (int rep = 0; rep < REP_SCAN; ++rep)
    for (int item = blockIdx.x; item < 40; item += nb) {
      if (item < 32) { if ((otid() >> 6) == 0) dn_scan_wave(kp(), item); }
      else s5_carry(kp(), l, item - 32);
    }
    GRID_BARRIER();
    for (int rep = 0; rep < REP_ATTN; ++rep)
      for (int item = blockIdx.x; item < 520; item += nb) attn_item(kp(), item, smem);
    GRID_BARRIER();
    for (int rep = 0; rep < REP_P5; ++rep)
    for (int item = blockIdx.x; item < 1040 + 1040; item += nb) {
      if (item < 1040) s5_c_item(kp(), l, item, smem);
      else dn_out_item(kp(), l, item - 1040, smem);
    }
    GRID_BARRIER();
    gemm_glu_phase(kp(), l, smem);
    GRID_BARRIER();
    gemm_out_phase(kp(), l, smem);
    GRID_BARRIER();
    {
      const Params& p = kp();
      if (l == 0) final_ln_phase(p, 0, p.ctx, p.x);
      else final_ln_phase(p, 1, (const float*)(p.ws + OFF_CTX1), p.out);
    }
    if (l == 0) GRID_BARRIER();
  }
}

extern "C" void kernel_launch(void* const* d_in, const int* in_sizes, int n_in, void* d_out, int out_size, void* d_ws,
                              size_t ws_size, hipStream_t stream) {
  static int grid_blocks = 0;
  if (!grid_blocks) {
    int dev = 0, cus = 0, per_cu = 0;
    hipGetDevice(&dev);
    hipDeviceGetAttribute(&cus, hipDeviceAttributeMultiprocessorCount, dev);
    hipOccupancyMaxActiveBlocksPerMultiprocessor(&per_cu, fwd_megakernel, 256, 0);
    if (per_cu > 2) per_cu = 2;
    if (per_cu < 1) per_cu = 1;
    grid_blocks = cus * per_cu;
  }
  Params p{};
  const float** pp = (const float**)&p;
  for (int i = 0; i < 26; ++i) pp[i] = (const float*)d_in[i];
  p.out = (float*)d_out;
  p.ws = (char*)d_ws;
  void* args[] = {&p};
  (void)hipMemsetAsync((char*)d_ws + OFF_BAR, 0, XCD_BAR_WORDS * 4, stream);
  hipError_t e = hipLaunchCooperativeKernel((void*)fwd_megakernel, dim3(grid_blocks), dim3(256), args, 0, stream);
  if (e != hipSuccess) fprintf(stderr, "cooperative launch failed: %s (grid %d)\n", hipGetErrorString(e), grid_blocks);
}
```

```cpp
#include <hip/hip_runtime.h>
#include <hip/hip_cooperative_groups.h>
#include <cstdio>
namespace cg = cooperative_groups;

#define DI __device__ __forceinline__
typedef unsigned short u16;
using bf16x8 = __attribute__((ext_vector_type(8))) short;
using f32x16 = __attribute__((ext_vector_type(16))) float;
using f32x4 = __attribute__((ext_vector_type(4))) float;
typedef __bf16 bf2_t __attribute__((ext_vector_type(2)));
typedef float f2_t __attribute__((ext_vector_type(2)));

#define MFMA32(a, b, c) __builtin_amdgcn_mfma_f32_32x32x16_bf16((a), (b), (c), 0, 0, 0)
#define MFMA16(a, b, c) __builtin_amdgcn_mfma_f32_16x16x32_bf16((a), (b), (c), 0, 0, 0)

constexpr int T = 16640;
constexpr int NCTX = 256;
constexpr int DM = 1024;
constexpr int NIN = 2832;
constexpr int NINP = 2944;
constexpr int NCH = 260;
constexpr float EPS = 1e-6f;
constexpr float DN_ALPHA = 1.4142135623730951f;

constexpr size_t al256(size_t x) { return (x + 255) & ~(size_t)255; }
constexpr size_t OFF_WINT = 0;
constexpr size_t OFF_WOUTT = OFF_WINT + al256((size_t)2 * NINP * 1024 * 2);
constexpr size_t OFF_GLUWT = OFF_WOUTT + al256((size_t)2 * 1024 * 1024 * 2);
constexpr size_t OFF_MODV = OFF_GLUWT + al256((size_t)2 * 256 * 256 * 2);
constexpr size_t OFF_ROPE = OFF_MODV + al256((size_t)2 * 2 * 3072 * 4);
constexpr size_t OFF_H = OFF_ROPE + al256((size_t)256 * 16 * 2 * 4);
constexpr size_t OFF_QB = OFF_H + al256((size_t)T * 1024 * 2);
constexpr size_t OFF_KB = OFF_QB + al256((size_t)8 * T * 64 * 2);
constexpr size_t OFF_VT = OFF_KB + al256((size_t)2 * T * 64 * 2);
constexpr size_t OFF_GATES = OFF_VT + al256((size_t)2 * T * 64 * 2);
constexpr size_t OFF_QKVB = OFF_GATES + al256((size_t)T * 1024 * 2);
constexpr size_t OFF_UC = OFF_QKVB + al256((size_t)T * 768 * 2);
constexpr size_t OFF_BD = OFF_UC + al256((size_t)T * 256 * 4);
constexpr size_t OFF_DN = OFF_BD + al256((size_t)T * 16 * 4);
constexpr size_t OFF_GLAST = OFF_DN + al256((size_t)1040 * 2 * 5 * 4096 * 2);
constexpr size_t OFF_S5E = OFF_GLAST + al256((size_t)1040 * 2 * 4);
constexpr size_t OFF_S5H = OFF_S5E + al256((size_t)NCH * 2 * 16 * 64 * 2 * 4);
constexpr size_t OFF_CTX1 = OFF_S5H + al256((size_t)NCH * 2 * 16 * 64 * 2 * 4);
constexpr size_t OFF_BAR = OFF_CTX1 + al256((size_t)256 * 1024 * 4);
constexpr size_t WS_TOTAL = OFF_BAR + 16384;
static_assert(WS_TOTAL <= (size_t)256 * 1024 * 1024, "workspace too large");
static_assert((size_t)T * 1024 * 4 <= (size_t)1040 * 2 * 5 * 4096 * 2, "y alias");

struct Params {
  const float *x, *c, *ctx, *c_ctx, *w_mod, *b_mod, *w_in, *qg, *kg, *conv_w, *A_log, *dt_bias, *out_gain,
      *A_re, *A_im, *log_dt, *B_re, *B_im, *C_re, *C_im, *Dskip, *glu_w, *glu_b, *w_out, *ln_g, *ln_b;
  float* out;
  char* ws;
};

constexpr int SMEM_BYTES = 75 * 1024;

DI float bf2f(u16 v) { return __uint_as_float(((unsigned)v) << 16); }
DI unsigned pk2(float a, float b) {
  f2_t v = {a, b};
  bf2_t r = __builtin_convertvector(v, bf2_t);
  return __builtin_bit_cast(unsigned, r);
}
DI u16 f2bf(float a) { return (u16)(pk2(a, 0.f) & 0xffffu); }
DI float silu_f(float x) { return x / (1.f + __expf(-x)); }
DI float sigmoid_f(float x) { return 1.f / (1.f + __expf(-x)); }
template <int CTRL>
DI float dppf(float v) {
  return __builtin_bit_cast(float, __builtin_amdgcn_update_dpp(0, __builtin_bit_cast(int, v), CTRL, 0xf, 0xf, true));
}
DI float wave_sum(float v) {
  v += dppf<0xB1>(v);
  v += dppf<0x4E>(v);
  v += dppf<0x141>(v);
  v += dppf<0x140>(v);
  v += __shfl_xor(v, 16);
  v += __shfl_xor(v, 32);
  return v;
}
DI int otid() { int t = threadIdx.x; asm volatile("" : "+v"(t)); return t; }
DI float gelu_tanh(float x) {
  float u = 0.7978845608028654f * (x + 0.044715f * x * x * x);
  float t = 1.f - 2.f / (1.f + __expf(2.f * u));
  return 0.5f * x * (1.f + t);
}
DI bf16x8 mk8(uint2 lo, uint2 hi) {
  uint4 v = {lo.x, lo.y, hi.x, hi.y};
  return __builtin_bit_cast(bf16x8, v);
}
DI bf16x8 mk8u(unsigned a, unsigned b, unsigned c, unsigned d) {
  uint4 v = {a, b, c, d};
  return __builtin_bit_cast(bf16x8, v);
}


#define XB_TMO      128
#define XB_XCNT(j)  (256  + 64 * (j))
#define XB_XSUB(j)  (1280 + 64 * (j))
#define XB_XGEN(j)  (2304 + 64 * (j))
#define XB_TOP      3328
#define XB_TOPGEN   3392
#define XCD_BAR_WORDS 3456
#define XB_SPIN_CAP (1u << 18)
#define LAS __attribute__((address_space(3)))
DI unsigned xb_ld(unsigned* p) { return __hip_atomic_load(p, __ATOMIC_RELAXED, __HIP_MEMORY_SCOPE_AGENT); }
DI unsigned xb_add(unsigned* p, unsigned v) { return __hip_atomic_fetch_add(p, v, __ATOMIC_RELAXED, __HIP_MEMORY_SCOPE_AGENT); }
DI unsigned xb_xcc_id() { return (unsigned)__builtin_amdgcn_s_getreg((3 << 11) | 20) & 0xFu; }
#define XB_SPIN(cond, bar) do { unsigned _sp = 0; while (cond) { __builtin_amdgcn_s_sleep(1); \
    if ((++_sp & 255u) == 0u) { if (xb_ld(&(bar)[XB_TMO])) break; if (_sp > XB_SPIN_CAP) { atomicAdd(&(bar)[XB_TMO], 1u); break; } } } } while (0)
struct XcdBarrier { unsigned* bar; unsigned x; volatile LAS unsigned* st; };
DI XcdBarrier xcd_barrier_post(unsigned* bar, volatile LAS unsigned* st) {
  XcdBarrier b; b.bar = bar; b.x = xb_xcc_id(); b.st = st;
  if (threadIdx.x == 0) (void)xb_add(&bar[XB_XCNT(b.x)], 1u);
  return b;
}
DI void xcd_barrier_complete(unsigned* bar, unsigned x, unsigned& nloc, unsigned& nx) {
  const unsigned G = gridDim.x * gridDim.y * gridDim.z;
  unsigned sum, cnt, mine, sp = 0u;
  for (;;) {
    sum = 0u; cnt = 0u; mine = 0u;
#pragma unroll
    for (unsigned j = 0; j < 16; ++j) { const unsigned c = xb_ld(&bar[XB_XCNT(j)]); sum += c; cnt += (c > 0u) ? 1u : 0u; mine = (j == x) ? c : mine; }
    if (sum == G) break;
    __builtin_amdgcn_s_sleep(1);
    if ((++sp & 255u) == 0u) { if (xb_ld(&bar[XB_TMO])) break; if (sp > XB_SPIN_CAP) { atomicAdd(&bar[XB_TMO], 1u); break; } }
  }
  nloc = mine > 0u ? mine : 1u; nx = cnt > 0u ? cnt : 1u;
}
DI void xcd_barrier(const XcdBarrier& b) {
  asm volatile("s_waitcnt vmcnt(0)" ::: "memory");
  __syncthreads();
  if (threadIdx.x == 0) {
    unsigned* bar = b.bar;
    __builtin_amdgcn_s_waitcnt(0);
    unsigned nloc = b.st[0], nx = b.st[1];
    if (nloc == 0u) { xcd_barrier_complete(bar, b.x, nloc, nx); b.st[0] = nloc; b.st[1] = nx; }
    const unsigned old = xb_add(&bar[XB_XSUB(b.x)], 1u);
    const unsigned gen = old / nloc;
    if (old + 1u == (gen + 1u) * nloc) {
      __builtin_amdgcn_fence(__ATOMIC_RELEASE, "agent");
      asm volatile("s_waitcnt vmcnt(0)" ::: "memory");
      const unsigned og = xb_add(&bar[XB_TOP], 1u);
      const unsigned tg = og / nx;
      if (og + 1u == (tg + 1u) * nx) xb_add(&bar[XB_TOPGEN], 1u);
      else XB_SPIN(xb_ld(&bar[XB_TOPGEN]) == tg, bar);
      __builtin_amdgcn_fence(__ATOMIC_ACQUIRE, "agent");
      xb_add(&bar[XB_XGEN(b.x)], 1u);
      asm volatile("s_waitcnt vmcnt(0)" ::: "memory");
    } else {
      XB_SPIN(xb_ld(&bar[XB_XGEN(b.x)]) == gen, bar);
      __builtin_amdgcn_fence(__ATOMIC_ACQUIRE, "agent");
      asm volatile("s_waitcnt vmcnt(0)" ::: "memory");
    }
  }
  __syncthreads();
}

DI void transpose_item(const float* __restrict__ src, int src_ld, u16* __restrict__ dst, int dst_ld, int k0, int n0,
                       bool permute_in, char* smem) {
  float* tile = (float*)smem;
  const int tid = otid();
#pragma unroll
  for (int i = 0; i < 16; ++i) {
    int k = i * 4 + (tid >> 6), n = tid & 63;
    int nd = n0 + n, ns = nd;
    if (permute_in) {
      if (nd < 2304) ns = nd;
      else if (nd < 2816) ns = nd + 16;
      else if (nd < 2832) ns = nd - 512;
      else ns = -1;
    }
    float v = (ns >= 0) ? src[(size_t)(k0 + k) * src_ld + ns] : 0.f;
    tile[k * 65 + n] = v;
  }
  __syncthreads();
#pragma unroll 4
  for (int i = 0; i < 16; ++i) {
    int n = i * 4 + (tid >> 6), k = tid & 63;
    dst[(size_t)(n0 + n) * dst_ld + k0 + k] = f2bf(tile[k * 65 + n]);
  }
  __syncthreads();
}

DI void mod_item(const Params& p, int item, char* smem) {
  const int l = item / 96, grp = item % 96;
  float* ssc = (float*)smem;
  float* red = ssc + 2048;
  const int tid = otid();
  for (int i = tid; i < 1024; i += 256) {
    ssc[i] = silu_f(p.c[i]);
    ssc[1024 + i] = silu_f(p.c_ctx[i]);
  }
  __syncthreads();
  const int kq = tid >> 5, n = tid & 31, col = grp * 32 + n;
  const float* w = p.w_mod + (size_t)l * 1024 * 3072 + col;
  float a0 = 0.f, a1 = 0.f;
#pragma unroll 16
  for (int k = kq * 128; k < kq * 128 + 128; ++k) {
    float wv = w[(size_t)k * 3072];
    a0 += ssc[k] * wv;
    a1 += ssc[1024 + k] * wv;
  }
  red[(0 * 8 + kq) * 32 + n] = a0;
  red[(1 * 8 + kq) * 32 + n] = a1;
  __syncthreads();
  if (tid < 64) {
    int v = tid >> 5, nn = tid & 31;
    float s = 0.f;
    for (int q = 0; q < 8; ++q) s += red[(v * 8 + q) * 32 + nn];
    int cc = grp * 32 + nn;
    float* modv = (float*)(p.ws + OFF_MODV);
    modv[(l * 2 + v) * 3072 + cc] = s + p.b_mod[l * 3072 + cc];
  }
  __syncthreads();
}

DI void setup_phase(const Params& p, char* smem) {
  constexpr int N_A = 2 * 16 * 46, N_B = 2 * 16 * 16, N_C = 2 * 4 * 4, N_D = 192, N_E = 1;
  constexpr int NTOT = N_A + N_B + N_C + N_D + N_E;
  for (int item = blockIdx.x; item < NTOT; item += gridDim.x) {
    int it = item;
    if (it < N_A) {
      int l = it / (16 * 46), r = it % (16 * 46);
      int kt = r / 46, nt = r % 46;
      transpose_item(p.w_in + (size_t)l * 1024 * NIN, NIN, (u16*)(p.ws + OFF_WINT) + (size_t)l * NINP * 1024, 1024,
                     kt * 64, nt * 64, true, smem);
      continue;
    }
    it -= N_A;
    if (it < N_B) {
      int l = it / 256, r = it % 256;
      int kt = r / 16, nt = r % 16;
      transpose_item(p.w_out + (size_t)l * 1024 * 1024, 1024, (u16*)(p.ws + OFF_WOUTT) + (size_t)l * 1024 * 1024, 1024,
                     kt * 64, nt * 64, false, smem);
      continue;
    }
    it -= N_B;
    if (it < N_C) {
      int l = it / 16, r = it % 16;
      int kt = r / 4, nt = r % 4;
      transpose_item(p.glu_w + (size_t)l * 256 * 256, 256, (u16*)(p.ws + OFF_GLUWT) + (size_t)l * 256 * 256, 256,
                     kt * 64, nt * 64, false, smem);
      continue;
    }
    it -= N_C;
    if (it < N_D) { mod_item(p, it, smem); continue; }
    float* rope = (float*)(p.ws + OFF_ROPE);
    for (int e = otid(); e < 4096; e += 256) {
      int row = e >> 4, j = e & 15;
      float inv = powf(10000.f, -(float)j / 16.f);
      float ang = (float)row * inv;
      rope[e * 2] = cosf(ang);
      rope[e * 2 + 1] = sinf(ang);
    }
  }
}

DI void ln_mod_phase(const Params& p, const float* ctx_src, const float* lat_src, int l) {
  const int lane = otid() & 63, wave = otid() >> 6;
  const int nw = gridDim.x * 4;
  u16* h = (u16*)(p.ws + OFF_H);
  const float* modv = (const float*)(p.ws + OFF_MODV);
  for (int r = blockIdx.x * 4 + wave; r < T; r += nw) {
    const float* src = (r < NCTX) ? ctx_src + (size_t)r * DM : lat_src + (size_t)(r - NCTX) * DM;
    const float* mod = modv + (l * 2 + (r < NCTX ? 1 : 0)) * 3072;
    float4 v[4];
    float s = 0.f;
#pragma unroll
    for (int i = 0; i < 4; ++i) {
      v[i] = *(const float4*)(src + (i * 64 + lane) * 4);
      s += v[i].x + v[i].y + v[i].z + v[i].w;
    }
    float mu = wave_sum(s) * (1.f / DM);
    float q = 0.f;
#pragma unroll
    for (int i = 0; i < 4; ++i) {
      v[i].x -= mu; v[i].y -= mu; v[i].z -= mu; v[i].w -= mu;
      q += v[i].x * v[i].x + v[i].y * v[i].y + v[i].z * v[i].z + v[i].w * v[i].w;
    }
    float rstd = rsqrtf(wave_sum(q) * (1.f / DM) + EPS);
#pragma unroll
    for (int i = 0; i < 4; ++i) {
      int c0 = (i * 64 + lane) * 4;
      float4 sh = *(const float4*)(mod + c0);
      float4 sc = *(const float4*)(mod + 1024 + c0);
      float o0 = v[i].x * rstd * (1.f + sc.x) + sh.x;
      float o1 = v[i].y * rstd * (1.f + sc.y) + sh.y;
      float o2 = v[i].z * rstd * (1.f + sc.z) + sh.z;
      float o3 = v[i].w * rstd * (1.f + sc.w) + sh.w;
      uint2 pk = {pk2(o0, o1), pk2(o2, o3)};
      *(uint2*)(h + (size_t)r * DM + c0) = pk;
    }
  }
}

constexpr int G_LDA = 72;
DI void gemm_tile_compute(const u16* __restrict__ A, int lda, const u16* __restrict__ Bt, int ldb, int K, int m0, int n0,
                          char* smem) {
  u16* As = (u16*)smem;
  u16* Bs = As + 2 * 128 * G_LDA;
  const int tid = otid(), lane = tid & 63, wave = tid >> 6;
  const int wm = wave >> 1, wn = wave & 1;
  const int lr = lane & 31, lh = lane >> 5;
  f32x16 acc[2][2];
#pragma unroll
  for (int a = 0; a < 2; ++a)
#pragma unroll
    for (int b = 0; b < 2; ++b)
#pragma unroll
      for (int i = 0; i < 16; ++i) acc[a][b][i] = 0.f;

  const int KT = K / 64;
  uint4 ra0, ra1, ra2, ra3, rb0, rb1, rb2, rb3;
  const int srow = tid >> 3, sch = tid & 7;
  const u16* Ag = A + (size_t)(m0 + srow) * lda + sch * 8;
  const u16* Bg = Bt + (size_t)(n0 + srow) * ldb + sch * 8;
  const size_t a32 = (size_t)32 * lda, b32 = (size_t)32 * ldb;
#define G_LOAD(KT_)                                                                       \
  {                                                                                       \
    const u16* ag_ = Ag + (KT_) * 64;                                                     \
    const u16* bg_ = Bg + (KT_) * 64;                                                     \
    ra0 = *(const uint4*)(ag_);            rb0 = *(const uint4*)(bg_);                    \
    ra1 = *(const uint4*)(ag_ + a32);      rb1 = *(const uint4*)(bg_ + b32);              \
    ra2 = *(const uint4*)(ag_ + 2 * a32);  rb2 = *(const uint4*)(bg_ + 2 * b32);          \
    ra3 = *(const uint4*)(ag_ + 3 * a32);  rb3 = *(const uint4*)(bg_ + 3 * b32);          \
  }
#define G_STORE(BUF_)                                                                     \
  {                                                                                       \
    u16* as_ = As + ((BUF_) * 128 + srow) * G_LDA + sch * 8;                              \
    u16* bs_ = Bs + ((BUF_) * 128 + srow) * G_LDA + sch * 8;                              \
    *(uint4*)(as_) = ra0;                    *(uint4*)(bs_) = rb0;                        \
    *(uint4*)(as_ + 32 * G_LDA) = ra1;       *(uint4*)(bs_ + 32 * G_LDA) = rb1;           \
    *(uint4*)(as_ + 64 * G_LDA) = ra2;       *(uint4*)(bs_ + 64 * G_LDA) = rb2;           \
    *(uint4*)(as_ + 96 * G_LDA) = ra3;       *(uint4*)(bs_ + 96 * G_LDA) = rb3;           \
  }
  G_LOAD(0)
  G_STORE(0)
  __syncthreads();
  for (int kt = 0; kt < KT; ++kt) {
    const int buf = kt & 1;
    const int ktn = kt + 1 < KT ? kt + 1 : kt;
    G_LOAD(ktn)
    __builtin_amdgcn_sched_barrier(0);
    const u16* Ab = As + (buf * 128 + wm * 64 + lr) * G_LDA + lh * 8;
    const u16* Bb = Bs + (buf * 128 + wn * 64 + lr) * G_LDA + lh * 8;
    bf16x8 fa0[4], fa1[4], fb0[4], fb1[4];
#pragma unroll
    for (int ks = 0; ks < 4; ++ks) {
      fa0[ks] = *(const bf16x8*)(Ab + ks * 16);
      fa1[ks] = *(const bf16x8*)(Ab + 32 * G_LDA + ks * 16);
      fb0[ks] = *(const bf16x8*)(Bb + ks * 16);
      fb1[ks] = *(const bf16x8*)(Bb + 32 * G_LDA + ks * 16);
    }
    __builtin_amdgcn_sched_barrier(0);
#pragma unroll
    for (int ks = 0; ks < 4; ++ks) {
      acc[0][0] = MFMA32(fa0[ks], fb0[ks], acc[0][0]);
      acc[0][1] = MFMA32(fa0[ks], fb1[ks], acc[0][1]);
      acc[1][0] = MFMA32(fa1[ks], fb0[ks], acc[1][0]);
      acc[1][1] = MFMA32(fa1[ks], fb1[ks], acc[1][1]);
    }
    __builtin_amdgcn_sched_barrier(0);
    G_STORE(buf ^ 1)
    __syncthreads();
  }
  float* Cs = (float*)smem;
#pragma unroll
  for (int mi = 0; mi < 2; ++mi)
#pragma unroll
    for (int ni = 0; ni < 2; ++ni)
#pragma unroll
      for (int i = 0; i < 16; ++i) {
        int row = wm * 64 + mi * 32 + (i & 3) + 8 * (i >> 2) + 4 * lh;
        int col = wn * 64 + ni * 32 + lr;
        Cs[row * 132 + col] = acc[mi][ni][i];
      }
  __syncthreads();
}

template <bool OUT_BF16, bool SILU>
DI void epi_store(const float* Cs, void* dst, int ld, int m0, int coff, int ncols) {
  const int tid = otid();
  const int cpr = ncols >> 2;
  for (int idx = tid; idx < 128 * cpr; idx += 256) {
    int row = idx / cpr, c4 = idx % cpr;
    float4 v = *(const float4*)(Cs + row * 132 + 4 * c4);
    if (SILU) { v.x = silu_f(v.x); v.y = silu_f(v.y); v.z = silu_f(v.z); v.w = silu_f(v.w); }
    size_t o = (size_t)(m0 + row) * ld + coff + 4 * c4;
    if (OUT_BF16) *(uint2*)((u16*)dst + o) = make_uint2(pk2(v.x, v.y), pk2(v.z, v.w));
    else *(float4*)((float*)dst + o) = v;
  }
}

DI void epi_qk(const Params& p, const float* Cs, int l, int m0, int nt) {
  const int tid = otid();
  const int row = tid & 127, hh = tid >> 7;
  const int gr = m0 + row;
  const bool isk = (nt == 4);
  const float* gain = (isk ? p.kg : p.qg) + l * 64;
  float v[64];
  float ss = 0.f;
#pragma unroll
  for (int d4 = 0; d4 < 16; ++d4) {
    float4 t4 = *(const float4*)(Cs + row * 132 + hh * 64 + d4 * 4);
    v[4 * d4] = t4.x; v[4 * d4 + 1] = t4.y; v[4 * d4 + 2] = t4.z; v[4 * d4 + 3] = t4.w;
    ss += t4.x * t4.x + t4.y * t4.y + t4.z * t4.z + t4.w * t4.w;
  }
  float rinv = rsqrtf(ss * (1.f / 64.f) + EPS);
#pragma unroll
  for (int d = 0; d < 64; ++d) v[d] = v[d] * rinv * gain[d];
  if (gr >= NCTX) {
    const int t = gr - NCTX;
    const float* rope = (const float*)(p.ws + OFF_ROPE);
    const float* rr = rope + (t >> 6) * 32;
    const float* rc = rope + (t & 63) * 32;
#pragma unroll
    for (int j = 0; j < 16; ++j) {
      float c1 = rr[2 * j], s1 = rr[2 * j + 1];
      float a = v[j], b = v[j + 16];
      v[j] = a * c1 - b * s1;
      v[j + 16] = b * c1 + a * s1;
      float c2 = rc[2 * j], s2 = rc[2 * j + 1];
      float a2 = v[32 + j], b2 = v[48 + j];
      v[32 + j] = a2 * c2 - b2 * s2;
      v[48 + j] = b2 * c2 + a2 * s2;
    }
  }
  if (!isk) {
    constexpr float QS = 0.125f * 1.4426950408889634f;
#pragma unroll
    for (int d = 0; d < 64; ++d) v[d] *= QS;
  }
  u16* dst;
  if (isk) dst = (u16*)(p.ws + OFF_KB) + ((size_t)hh * T + gr) * 64;
  else dst = (u16*)(p.ws + OFF_QB) + ((size_t)(2 * nt + hh) * T + gr) * 64;
#pragma unroll
  for (int c = 0; c < 8; ++c) {
    uint4 o = {pk2(v[8 * c], v[8 * c + 1]), pk2(v[8 * c + 2], v[8 * c + 3]), pk2(v[8 * c + 4], v[8 * c + 5]),
               pk2(v[8 * c + 6], v[8 * c + 7])};
    *(uint4*)(dst + 8 * c) = o;
  }
}

DI void epi_v(const Params& p, const float* Cs, int m0) {
  const int tid = otid();
  const int c = tid & 127, half = tid >> 7;
  const int kvh = c >> 6, d = c & 63;
  u16* dst = (u16*)(p.ws + OFF_VT) + ((size_t)kvh * 64 + d) * T + m0 + half * 64;
#pragma unroll
  for (int g = 0; g < 8; ++g) {
    float v[8];
#pragma unroll
    for (int e = 0; e < 8; ++e) v[e] = Cs[(half * 64 + g * 8 + e) * 132 + c];
    uint4 o = {pk2(v[0], v[1]), pk2(v[2], v[3]), pk2(v[4], v[5]), pk2(v[6], v[7])};
    *(uint4*)(dst + g * 8) = o;
  }
}

DI void gemm_in_phase(const Params& p, int l, char* smem) {
  const u16* A = (const u16*)(p.ws + OFF_H);
  const u16* Bt = (const u16*)(p.ws + OFF_WINT) + (size_t)l * NINP * 1024;
  constexpr int MT = T / 128, NT = NINP / 128;
  const float* Cs = (const float*)smem;
  constexpr int NFULL = (MT / 8) * 8 * NT, MREM = MT % 8;
  for (int item = blockIdx.x; item < MT * NT; item += gridDim.x) {
    int mt, nt;
    if (item < NFULL) { const int xcd = item & 7, r = item >> 3; mt = (r / NT) * 8 + xcd; nt = r % NT; }
    else { const int j = item - NFULL; mt = (MT / 8) * 8 + j % MREM; nt = j / MREM; }
    const int m0 = mt * 128;
    gemm_tile_compute(A, 1024, Bt, 1024, 1024, m0, nt * 128, smem);
    if (nt <= 4) epi_qk(p, Cs, l, m0, nt);
    else if (nt == 5) epi_v(p, Cs, m0);
    else if (nt <= 9) epi_store<true, true>(Cs, p.ws + OFF_GATES, 1024, m0, (nt - 6) * 128, 128);
    else if (nt <= 15) epi_store<true, false>(Cs, p.ws + OFF_QKVB, 768, m0, (nt - 10) * 128, 128);
    else if (nt <= 17) epi_store<true, true>(Cs, p.ws + OFF_GATES, 1024, m0, 512 + (nt - 16) * 128, 128);
    else if (nt <= 19) epi_store<false, false>(Cs, p.ws + OFF_UC, 256, m0, (nt - 18) * 128, 128);
    else if (nt <= 21) epi_store<true, true>(Cs, p.ws + OFF_GATES, 1024, m0, 768 + (nt - 20) * 128, 128);
    else epi_store<false, false>(Cs, p.ws + OFF_BD, 16, m0, 0, 16);
    __syncthreads();
  }
}

DI void gemm_glu_phase(const Params& p, int l, char* smem) {
  const u16* A = (const u16*)(p.ws + OFF_QB);
  const u16* Bt = (const u16*)(p.ws + OFF_GLUWT) + (size_t)l * 256 * 256;
  const u16* gates = (const u16*)(p.ws + OFF_GATES);
  u16* mix = (u16*)(p.ws + OFF_H);
  const float* Cs = (const float*)smem;
  constexpr int MT = T / 128;
  for (int item = blockIdx.x; item < MT * 2; item += gridDim.x) {
    const int mt = item >> 1, nt = item & 1;
    const int m0 = mt * 128, n0 = nt * 128;
    gemm_tile_compute(A, 256, Bt, 256, 256, m0, n0, smem);
    for (int idx = otid(); idx < 128 * 64; idx += 256) {
      int row = idx >> 6, cp = idx & 63;
      int col = n0 + 2 * cp;
      size_t r = (size_t)(m0 + row);
      float a0 = Cs[row * 132 + 2 * cp] + p.glu_b[l * 256 + col];
      float a1 = Cs[row * 132 + 2 * cp + 1] + p.glu_b[l * 256 + col + 1];
      unsigned zz = *(const unsigned*)(A + r * 256 + col);
      unsigned gg = *(const unsigned*)(gates + r * 1024 + 768 + col);
      float z0 = bf2f((u16)(zz & 0xffff)), z1 = bf2f((u16)(zz >> 16));
      float g0 = bf2f((u16)(gg & 0xffff)), g1 = bf2f((u16)(gg >> 16));
      float o0 = z0 * sigmoid_f(a0) * g0, o1 = z1 * sigmoid_f(a1) * g1;
      *(unsigned*)(mix + r * 1024 + 768 + col) = pk2(o0, o1);
    }
    __syncthreads();
  }
}

DI void gemm_out_phase(const Params& p, int l, char* smem) {
  const u16* A = (const u16*)(p.ws + OFF_H);
  const u16* Bt = (const u16*)(p.ws + OFF_WOUTT) + (size_t)l * 1024 * 1024;
  const float* Cs = (const float*)smem;
  constexpr int MT = T / 128, NT = 8;
  const int mstart = (l == 1) ? 2 : 0;
  constexpr int NFULL = (MT / 8) * 8 * NT, MREM = MT % 8;
  const int nitems = (l == 1) ? NFULL : MT * NT;
  for (int item = blockIdx.x; item < nitems; item += gridDim.x) {
    int mt, nt;
    if (item < NFULL) { const int xcd = item & 7, r = item >> 3; mt = (r / NT) * 8 + xcd; nt = r % NT; }
    else { const int j = item - NFULL; mt = (MT / 8) * 8 + j % MREM; nt = j / MREM; }
    if (mt < mstart) mt += (MT / 8) * 8;
    gemm_tile_compute(A, 1024, Bt, 1024, 1024, mt * 128, nt * 128, smem);
    epi_store<false, false>(Cs, p.ws + OFF_DN, 1024, mt * 128, nt * 128, 128);
    __syncthreads();
  }
}

DI void dn_solve(const float* Lr, const float* sb, const float* gc, bool isv, const char* src, int stride_bytes, float* x) {
  int off = 0;
  const int hioff = isv ? 0 : 2;
  const unsigned lomask = isv ? 0u : 0xffffu;
  const float gsel = isv ? 0.f : 1.f;
#pragma unroll
  for (int li = 0; li < 64; ++li) {
    const unsigned hi = *(const u16*)(src + off + hioff);
    const unsigned lo = *(const u16*)(src + off);
    const float gcl = gc[li];
    float r = __uint_as_float((hi << 16) | (lo & lomask)) * __expf(gcl * gsel);
    off += stride_bytes;
    asm volatile("" : "+v"(off));
    float acc = r * sb[li];
#pragma unroll
    for (int lj4 = 0; lj4 < (li + 3) / 4; ++lj4) {
      float4 Lq = *(const float4*)(Lr + li * 64 + lj4 * 4);
      if (lj4 * 4 + 0 < li) acc -= Lq.x * x[lj4 * 4 + 0];
      if (lj4 * 4 + 1 < li) acc -= Lq.y * x[lj4 * 4 + 1];
      if (lj4 * 4 + 2 < li) acc -= Lq.z * x[lj4 * 4 + 2];
      if (lj4 * 4 + 3 < li) acc -= Lq.w * x[lj4 * 4 + 3];
    }
    x[li] = acc;
    if (li & 1) __builtin_amdgcn_sched_barrier(0);
  }
}

DI void dn_prep_item(const Params& p, int l, int unit, char* smem) {
  const int cid = unit >> 2, head = unit & 3;
  const int tt0 = cid * 64;
  const int seg_lo = cid < 4 ? 0 : NCTX, seg_hi = cid < 4 ? NCTX : T;
  float* sq = (float*)smem;
  float* sk = sq + 64 * 65;
  float* sL = sk + 64 * 65;
  float* sbeta = sL + 2 * 4096;
  float* sgc = sbeta + 128;
  float* sg = sgc + 128;
  u16* sv = (u16*)(sg + 128);
  const u16* z = (const u16*)(p.ws + OFF_QKVB);
  const float* bd = (const float*)(p.ws + OFF_BD);
  const float* cw = p.conv_w + l * 3 * 768;
  u16* dn = (u16*)(p.ws + OFF_DN) + (size_t)unit * 2 * 5 * 4096;
  u16* tmp = (u16*)(p.ws + OFF_H) + (size_t)blockIdx.x * 32768;
  float* glast = (float*)(p.ws + OFF_GLAST);
  const int tid = otid(), lane = tid & 63, wave = tid >> 6;

  {
    const int cq = head * 64 + lane, ck = 256 + head * 64 + lane;
    const float wq0 = cw[cq], wq1 = cw[768 + cq], wq2 = cw[1536 + cq];
    const float wk0 = cw[ck], wk1 = cw[768 + ck], wk2 = cw[1536 + ck];
#pragma unroll 8
    for (int i = wave; i < 64; i += 4) {
      const int tt = tt0 + i;
      float zq0 = 0.f, zq2 = 0.f, zk0 = 0.f, zk2 = 0.f;
      if (tt - 1 >= seg_lo) { zq0 = bf2f(z[(size_t)(tt - 1) * 768 + cq]); zk0 = bf2f(z[(size_t)(tt - 1) * 768 + ck]); }
      if (tt + 1 < seg_hi) { zq2 = bf2f(z[(size_t)(tt + 1) * 768 + cq]); zk2 = bf2f(z[(size_t)(tt + 1) * 768 + ck]); }
      float zq1 = bf2f(z[(size_t)tt * 768 + cq]), zk1 = bf2f(z[(size_t)tt * 768 + ck]);
      float vq = silu_f(wq0 * zq0 + wq1 * zq1 + wq2 * zq2);
      float vk = silu_f(wk0 * zk0 + wk1 * zk1 + wk2 * zk2);
      float s1 = wave_sum(vq * vq), s2 = wave_sum(vk * vk);
      sq[i * 65 + lane] = vq * rsqrtf(s1 + EPS) * 0.125f;
      sk[i * 65 + lane] = vk * rsqrtf(s2 + EPS);
    }
  }
  if (tid < 128) {
    const int dir = tid >> 6, i = tid & 63;
    const int tt = tt0 + i;
    const int li = dir ? 63 - i : i;
    float br = bd[(size_t)tt * 16 + dir * 4 + head];
    float ar = bd[(size_t)tt * 16 + 8 + dir * 4 + head];
    sbeta[dir * 64 + li] = 1.f / (1.f + expf(-br));
    float xx = ar + p.dt_bias[l * 8 + dir * 4 + head];
    float sp = fmaxf(xx, 0.f) + log1pf(expf(-fabsf(xx)));
    sg[dir * 64 + li] = -expf(p.A_log[l * 8 + dir * 4 + head]) * sp;
  }
  __syncthreads();
  if (tid == 0 || tid == 64) {
    const int dir = tid >> 6;
    float a = 0.f;
    for (int li = 0; li < 64; ++li) { a += sg[dir * 64 + li]; sgc[dir * 64 + li] = a; }
  }
  __syncthreads();

  {
    const int it = wave >> 1, jt = wave & 1;
    const int lr = lane & 31, lh = lane >> 5;
    f32x16 kk, qk;
#pragma unroll
    for (int r = 0; r < 16; ++r) { kk[r] = 0.f; qk[r] = 0.f; }
    const float* ki = sk + (32 * it + lr) * 65 + 8 * lh;
    const float* qi = sq + (32 * it + lr) * 65 + 8 * lh;
    const float* kj = sk + (32 * jt + lr) * 65 + 8 * lh;
#pragma unroll
    for (int ks = 0; ks < 4; ++ks) {
      bf16x8 fa = mk8u(pk2(ki[16 * ks], ki[16 * ks + 1]), pk2(ki[16 * ks + 2], ki[16 * ks + 3]), pk2(ki[16 * ks + 4], ki[16 * ks + 5]),
                       pk2(ki[16 * ks + 6], ki[16 * ks + 7]));
      bf16x8 fq = mk8u(pk2(qi[16 * ks], qi[16 * ks + 1]), pk2(qi[16 * ks + 2], qi[16 * ks + 3]), pk2(qi[16 * ks + 4], qi[16 * ks + 5]),
                       pk2(qi[16 * ks + 6], qi[16 * ks + 7]));
      bf16x8 fb = mk8u(pk2(kj[16 * ks], kj[16 * ks + 1]), pk2(kj[16 * ks + 2], kj[16 * ks + 3]), pk2(kj[16 * ks + 4], kj[16 * ks + 5]),
                       pk2(kj[16 * ks + 6], kj[16 * ks + 7]));
      kk = MFMA32(fa, fb, kk);
      qk = MFMA32(fq, fb, qk);
    }
    const int j = 32 * jt + lr;
#pragma unroll
    for (int dir = 0; dir < 2; ++dir) {
      u16* attn = tmp + dir * 16384;
      const int lj = dir ? 63 - j : j;
      const float gcj = sgc[dir * 64 + lj];
#pragma unroll
      for (int r = 0; r < 16; ++r) {
        const int i = 32 * it + (r & 3) + 8 * (r >> 2) + 4 * lh;
        const int li = dir ? 63 - i : i;
        const float dec = __expf(fminf(sgc[dir * 64 + li] - gcj, 0.f));
        const float Lv = (lj < li) ? sbeta[dir * 64 + li] * kk[r] * dec : 0.f;
        const float Av = (lj <= li) ? qk[r] * dec : 0.f;
        sL[dir * 4096 + li * 64 + lj] = Lv;
        attn[li * 64 + lj] = f2bf(Av);
      }
    }
  }
#pragma unroll
  for (int dir = 0; dir < 2; ++dir) {
    u16* kdT = tmp + dir * 16384 + 4096;
    {
      const int d = tid >> 2, lq = tid & 3;
      const float gl = sgc[dir * 64 + 63];
      unsigned o[8];
#pragma unroll
      for (int e = 0; e < 8; ++e) {
        const int li0 = lq * 16 + 2 * e, li1 = li0 + 1;
        const int i0 = dir ? 63 - li0 : li0, i1 = dir ? 63 - li1 : li1;
        float v0 = sk[i0 * 65 + d] * __expf(gl - sgc[dir * 64 + li0]);
        float v1 = sk[i1 * 65 + d] * __expf(gl - sgc[dir * 64 + li1]);
        o[e] = pk2(v0, v1);
      }
      *(uint4*)(kdT + d * 64 + lq * 16) = make_uint4(o[0], o[1], o[2], o[3]);
      *(uint4*)(kdT + d * 64 + lq * 16 + 8) = make_uint4(o[4], o[5], o[6], o[7]);
    }
    if (tid == 0) glast[unit * 2 + dir] = __expf(sgc[dir * 64 + 63]);
  }
  {
    const int cv = 512 + head * 64 + lane;
    const float w0 = cw[cv], w1 = cw[768 + cv], w2 = cw[1536 + cv];
#pragma unroll 8
    for (int i = wave; i < 64; i += 4) {
      const int tt = tt0 + i;
      float z0 = 0.f, z2 = 0.f;
      if (tt - 1 >= seg_lo) z0 = bf2f(z[(size_t)(tt - 1) * 768 + cv]);
      if (tt + 1 < seg_hi) z2 = bf2f(z[(size_t)(tt + 1) * 768 + cv]);
      float z1 = bf2f(z[(size_t)tt * 768 + cv]);
      sv[i * 72 + lane] = f2bf(silu_f(w0 * z0 + w1 * z1 + w2 * z2));
    }
  }
  __syncthreads();
  {
    const int dir = tid >> 7, col = tid & 127;
    const bool isv = col < 64;
    const int c6 = col & 63;
    float x[64];
    const char* src = isv ? (const char*)(sv + (dir ? 63 * 72 : 0) + c6) : (const char*)(sk + (dir ? 63 * 65 : 0) + c6);
    const int strideb = (isv ? 144 : 260) * (dir ? -1 : 1);
    dn_solve(sL + dir * 4096, sbeta + dir * 64, sgc + dir * 64, isv, src, strideb, x);
    u16* XT = tmp + dir * 16384 + 8192 + col * 64;
#pragma unroll
    for (int c = 0; c < 8; ++c)
      *(uint4*)(XT + 8 * c) = make_uint4(pk2(x[8 * c], x[8 * c + 1]), pk2(x[8 * c + 2], x[8 * c + 3]),
                                         pk2(x[8 * c + 4], x[8 * c + 5]), pk2(x[8 * c + 6], x[8 * c + 7]));
  }
  __threadfence_block();
  __syncthreads();
  {
    const int dir = wave >> 1, prod = wave & 1;
    const int lr = lane & 31, lh = lane >> 5;
    const u16* Aop = tmp + dir * 16384 + (prod ? 0 : 4096);
    const u16* XT = tmp + dir * 16384 + 8192;
    u16* dnd = dn + (size_t)dir * 5 * 4096;
    bf16x8 af[2][4];
#pragma unroll
    for (int mt = 0; mt < 2; ++mt)
#pragma unroll
      for (int ks = 0; ks < 4; ++ks) af[mt][ks] = *(const bf16x8*)(Aop + (mt * 32 + lr) * 64 + ks * 16 + lh * 8);
    {
      f32x16 acc[2][2];
#pragma unroll
      for (int a = 0; a < 2; ++a)
#pragma unroll
        for (int b = 0; b < 2; ++b)
#pragma unroll
          for (int i = 0; i < 16; ++i) acc[a][b][i] = 0.f;
#pragma unroll
      for (int nt = 0; nt < 2; ++nt)
#pragma unroll
        for (int ks = 0; ks < 4; ++ks) {
          bf16x8 b = *(const bf16x8*)(XT + (nt * 32 + lr) * 64 + ks * 16 + lh * 8);
          acc[0][nt] = MFMA32(af[0][ks], b, acc[0][nt]);
          acc[1][nt] = MFMA32(af[1][ks], b, acc[1][nt]);
        }
      u16* dst = dnd + (prod ? 3 : 1) * 4096;
#pragma unroll
      for (int mt = 0; mt < 2; ++mt)
#pragma unroll
        for (int nt = 0; nt < 2; ++nt)
#pragma unroll
          for (int g4 = 0; g4 < 4; ++g4) {
            uint2 o = {pk2(acc[mt][nt][4 * g4], acc[mt][nt][4 * g4 + 1]), pk2(acc[mt][nt][4 * g4 + 2], acc[mt][nt][4 * g4 + 3])};
            if (prod) {
              *(uint2*)(dst + (nt * 32 + lr) * 64 + mt * 32 + 8 * g4 + 4 * lh) = o;
            } else {
              const int dvv = nt * 32 + lr;
              const int mm = 2 * mt + (g4 >> 1), qq = 2 * (g4 & 1) + lh;
              *(uint2*)(dst + (((dvv >> 4) * 64 + qq * 16 + (dvv & 15)) * 4 + mm) * 4) = o;
            }
          }
    }
    {
      f32x16 acc[2][2];
#pragma unroll
      for (int a = 0; a < 2; ++a)
#pragma unroll
        for (int b = 0; b < 2; ++b)
#pragma unroll
          for (int i = 0; i < 16; ++i) acc[a][b][i] = 0.f;
#pragma unroll
      for (int mt = 0; mt < 2; ++mt)
#pragma unroll
        for (int ks = 0; ks < 4; ++ks) {
          bf16x8 a = *(const bf16x8*)(XT + (64 + mt * 32 + lr) * 64 + ks * 16 + lh * 8);
          acc[mt][0] = MFMA32(a, af[0][ks], acc[mt][0]);
          acc[mt][1] = MFMA32(a, af[1][ks], acc[mt][1]);
        }
      u16* dst = dnd + (prod ? 2 : 0) * 4096;
#pragma unroll
      for (int nt = 0; nt < 2; ++nt) {
        const int n = nt * 32 + lr;
        const int i = dir ? 63 - n : n;
        const float eg = __expf(sgc[dir * 64 + n]);
#pragma unroll
        for (int mt = 0; mt < 2; ++mt)
#pragma unroll
          for (int g4 = 0; g4 < 4; ++g4) {
            const int d0 = mt * 32 + 8 * g4 + 4 * lh;
            float v0 = acc[mt][nt][4 * g4], v1 = acc[mt][nt][4 * g4 + 1], v2 = acc[mt][nt][4 * g4 + 2], v3 = acc[mt][nt][4 * g4 + 3];
            if (prod) {
              v0 = sq[i * 65 + d0] * eg - v0;
              v1 = sq[i * 65 + d0 + 1] * eg - v1;
              v2 = sq[i * 65 + d0 + 2] * eg - v2;
              v3 = sq[i * 65 + d0 + 3] * eg - v3;
            }
            uint2 o = {pk2(v0, v1), pk2(v2, v3)};
            if (prod) {
              *(uint2*)(dst + n * 64 + d0) = o;
            } else {
              const int mm = n >> 4, cnn = n & 15, ss = mt, hif = g4 >> 1, qq = 2 * (g4 & 1) + lh;
              *(uint2*)(dst + ((mm * 2 + ss) * 64 + qq * 16 + cnn) * 8 + 4 * hif) = o;
            }
          }
      }
    }
  }
  __syncthreads();
}

DI void s5_coeffs(const Params& p, int l, int dir, int g, int pp, float& a_re, float& a_im, float* b_re, float* b_im) {
  const int gi = (l * 2 + dir) * 16 + g;
  const int idx = gi * 64 + pp;
  const float lr = p.A_re[idx], lim = p.A_im[idx];
  const float dt = expf(p.log_dt[gi]);
  const float mag = expf(lr * dt);
  const float ang = lim * dt;
  float sn, cs;
  sincosf(ang, &sn, &cs);
  a_re = mag * cs;
  a_im = mag * sn;
  const float nr = a_re - 1.f, ni = a_im;
  const float den = 1.f / (lr * lr + lim * lim);
  const float c_re = (nr * lr + ni * lim) * den;
  const float c_im = (ni * lr - nr * lim) * den;
  const float* Br = p.B_re + (size_t)idx * 16;
  const float* Bi = p.B_im + (size_t)idx * 16;
#pragma unroll
  for (int c = 0; c < 16; ++c) {
    float br = Br[c], bi = Bi[c];
    b_re[c] = c_re * br - c_im * bi;
    b_im[c] = c_re * bi + c_im * br;
  }
}


constexpr int S5_WAVE_LDS = 12800;
DI void s5_wave_sync() { asm volatile("s_waitcnt lgkmcnt(0)" ::: "memory"); }
DI void s5_bfrags(u16* sbw, const float* b_re, const float* b_im, int lane, bf16x8* bfrag) {
  *(uint4*)(sbw + lane * 32) = make_uint4(pk2(b_re[0], b_re[1]), pk2(b_re[2], b_re[3]), pk2(b_re[4], b_re[5]), pk2(b_re[6], b_re[7]));
  *(uint4*)(sbw + lane * 32 + 8) = make_uint4(pk2(b_re[8], b_re[9]), pk2(b_re[10], b_re[11]), pk2(b_re[12], b_re[13]), pk2(b_re[14], b_re[15]));
  *(uint4*)(sbw + lane * 32 + 16) = make_uint4(pk2(b_im[0], b_im[1]), pk2(b_im[2], b_im[3]), pk2(b_im[4], b_im[5]), pk2(b_im[6], b_im[7]));
  *(uint4*)(sbw + lane * 32 + 24) = make_uint4(pk2(b_im[8], b_im[9]), pk2(b_im[10], b_im[11]), pk2(b_im[12], b_im[13]), pk2(b_im[14], b_im[15]));
  s5_wave_sync();
  const int n = lane & 15, q4 = lane >> 4;
  const unsigned keep = (q4 < 2) ? 0xffffffffu : 0u;
#pragma unroll
  for (int nt = 0; nt < 8; ++nt) {
    const int state = 16 * (nt & 3) + n, part = nt >> 2;
    uint4 v = *(const uint4*)(sbw + state * 32 + part * 16 + 8 * (q4 & 1));
    bfrag[nt] = mk8u(v.x & keep, v.y & keep, v.z & keep, v.w & keep);
  }
}
DI void s5_bu_slab(const float* su, int wave, int dir, int s, int lane, const bf16x8* bfrag, u16* busw) {
  const int n = lane & 15, q4 = lane >> 4;
  const int li = 16 * s + n;
  const int i = dir ? 63 - li : li;
  const float* ur = su + i * 64 + wave * 16 + 8 * (q4 & 1);
  const float4 u0 = *(const float4*)ur, u1 = *(const float4*)(ur + 4);
  const unsigned keep = (q4 < 2) ? 0xffffffffu : 0u;
  const bf16x8 a = mk8u(pk2(u0.x, u0.y) & keep, pk2(u0.z, u0.w) & keep, pk2(u1.x, u1.y) & keep, pk2(u1.z, u1.w) & keep);
#pragma unroll
  for (int nt = 0; nt < 8; ++nt) {
    f32x4 acc = {0.f, 0.f, 0.f, 0.f};
    acc = MFMA16(a, bfrag[nt], acc);
    const int col = (nt >> 2) * 64 + 16 * (nt & 3) + n;
#pragma unroll
    for (int j = 0; j < 4; ++j) busw[(4 * q4 + j) * 136 + col] = f2bf(acc[j]);
  }
  s5_wave_sync();
}

DI void s5_a_item(const Params& p, int l, int item, char* smem) {
  const int quarter = item & 3, dir = (item >> 2) & 1, cid = item >> 3;
  const int tid = otid(), lane = tid & 63, wave = tid >> 6;
  const int g = quarter * 4 + wave;
  float* su = (float*)smem;
  const float* uC = (const float*)(p.ws + OFF_UC);
  for (int e = tid; e < 64 * 16; e += 256) {
    int i = e >> 4, c4 = e & 15;
    *(float4*)(su + i * 64 + c4 * 4) = *(const float4*)(uC + (size_t)(cid * 64 + i) * 256 + quarter * 64 + c4 * 4);
  }
  float a_re, a_im, b_re[16], b_im[16];
  s5_coeffs(p, l, dir, g, lane, a_re, a_im, b_re, b_im);
  u16* wl = (u16*)(smem + 16384 + wave * S5_WAVE_LDS);
  u16* busw = wl + 2176;
  u16* sbw = wl + 4352;
  bf16x8 bfrag[8];
  s5_bfrags(sbw, b_re, b_im, lane, bfrag);
  __syncthreads();
  float h_re = 0.f, h_im = 0.f;
  for (int s4 = 0; s4 < 4; ++s4) {
    s5_bu_slab(su, wave, dir, s4, lane, bfrag, busw);
#pragma unroll
    for (int r = 0; r < 16; ++r) {
      const float bu_re = bf2f(busw[r * 136 + lane]), bu_im = bf2f(busw[r * 136 + 64 + lane]);
      float nr = a_re * h_re - a_im * h_im + bu_re;
      float ni = a_re * h_im + a_im * h_re + bu_im;
      h_re = nr; h_im = ni;
    }
    s5_wave_sync();
  }
  float2* E = (float2*)(p.ws + OFF_S5E);
  E[((size_t)(cid * 2 + dir) * 16 + g) * 64 + lane] = make_float2(h_re, h_im);
  __syncthreads();
}

DI int chain_cid(int dir, int pos) { return dir == 0 ? pos : (pos < 4 ? 3 - pos : 263 - pos); }

DI void s5_carry(const Params& p, int l, int sblk) {
  const int id = sblk * 256 + otid();
  const int dir = id >> 10, g = (id >> 6) & 15, pp = id & 63;
  const int gi = (l * 2 + dir) * 16 + g;
  const float lr = p.A_re[gi * 64 + pp], lim = p.A_im[gi * 64 + pp];
  const float dt = expf(p.log_dt[gi]);
  const float mag = expf(lr * dt);
  float sn, cs;
  sincosf(lim * dt, &sn, &cs);
  float ar = mag * cs, ai = mag * sn;
#pragma unroll
  for (int i = 0; i < 6; ++i) { float nr = ar * ar - ai * ai, ni = 2.f * ar * ai; ar = nr; ai = ni; }
  const float2* E = (const float2*)(p.ws + OFF_S5E);
  float2* H = (float2*)(p.ws + OFF_S5H);
  float hr = 0.f, hi = 0.f;
  asm volatile("" : "+v"(hr), "+v"(hi));
  for (int pos0 = 0; pos0 < NCH; pos0 += 20) {
    float2 e[20];
    size_t o[20];
#pragma unroll
    for (int u = 0; u < 20; ++u) {
      int cid = chain_cid(dir, pos0 + u);
      o[u] = ((size_t)(cid * 2 + dir) * 16 + g) * 64 + pp;
      e[u] = E[o[u]];
    }
#pragma unroll
    for (int u = 0; u < 20; ++u) {
      H[o[u]] = make_float2(hr, hi);
      float nr = ar * hr - ai * hi + e[u].x;
      float ni = ar * hi + ai * hr + e[u].y;
      hr = nr; hi = ni;
    }
  }
}

DI void s5_c_item(const Params& p, int l, int item, char* smem) {
  const int quarter = item & 3, cid = item >> 2;
  const int tid = otid(), lane = tid & 63, wave = tid >> 6;
  const int g = quarter * 4 + wave;
  float* su = (float*)smem;
  u16* hs = (u16*)(smem + 16384 + wave * S5_WAVE_LDS);
  u16* busw = hs + 2176;
  u16* sbw = hs + 4352;
  const float* uC = (const float*)(p.ws + OFF_UC);
  const float2* Hin = (const float2*)(p.ws + OFF_S5H);
  u16* zg = (u16*)(p.ws + OFF_QB);
  for (int e = tid; e < 64 * 16; e += 256) {
    int i = e >> 4, c4 = e & 15;
    *(float4*)(su + i * 64 + c4 * 4) = *(const float4*)(uC + (size_t)(cid * 64 + i) * 256 + quarter * 64 + c4 * 4);
  }
  __syncthreads();
  const int cc = lane & 15, q4 = lane >> 4;
  f32x4 yacc[4];
#pragma unroll
  for (int t = 0; t < 4; ++t) yacc[t] = (f32x4){0.f, 0.f, 0.f, 0.f};
#pragma unroll
  for (int dir = 0; dir < 2; ++dir) {
    float a_re, a_im, b_re[16], b_im[16];
    s5_coeffs(p, l, dir, g, lane, a_re, a_im, b_re, b_im);
    bf16x8 cf[4];
    {
      const size_t cb = ((size_t)((l * 2 + dir) * 16 + g) * 16 + cc) * 64;
#pragma unroll
      for (int s = 0; s < 4; ++s) {
        const float* src = (s < 2 ? p.C_re : p.C_im) + cb + 32 * (s & 1) + 8 * q4;
        const float sgn = (s < 2) ? 1.f : -1.f;
        float4 v0 = *(const float4*)src, v1 = *(const float4*)(src + 4);
        cf[s] = mk8u(pk2(sgn * v0.x, sgn * v0.y), pk2(sgn * v0.z, sgn * v0.w), pk2(sgn * v1.x, sgn * v1.y),
                     pk2(sgn * v1.z, sgn * v1.w));
      }
    }
    bf16x8 bfrag[8];
    s5_bfrags(sbw, b_re, b_im, lane, bfrag);
    float2 h0 = Hin[((size_t)(cid * 2 + dir) * 16 + g) * 64 + lane];
    float h_re = h0.x, h_im = h0.y;
#pragma unroll
    for (int s = 0; s < 4; ++s) {
      s5_bu_slab(su, wave, dir, s, lane, bfrag, busw);
#pragma unroll
      for (int r = 0; r < 16; ++r) {
        const float bu_re = bf2f(busw[r * 136 + lane]), bu_im = bf2f(busw[r * 136 + 64 + lane]);
        float nr = a_re * h_re - a_im * h_im + bu_re;
        float ni = a_re * h_im + a_im * h_re + bu_im;
        h_re = nr; h_im = ni;
        const int rr = dir ? 15 - r : r;
        hs[rr * 136 + lane] = f2bf(h_re);
        hs[rr * 136 + 64 + lane] = f2bf(h_im);
      }
      asm volatile("s_waitcnt lgkmcnt(0)" ::: "memory");
      const int tile = dir ? 3 - s : s;
#pragma unroll
      for (int ks = 0; ks < 4; ++ks) {
        bf16x8 a = *(const bf16x8*)(hs + cc * 136 + 32 * ks + 8 * q4);
        yacc[tile] = MFMA16(a, cf[ks], yacc[tile]);
      }
      asm volatile("s_waitcnt lgkmcnt(0)" ::: "memory");
    }
  }
  const int ch = g * 16 + cc;
  const float dsk = p.Dskip[l * 256 + ch];
#pragma unroll
  for (int tile = 0; tile < 4; ++tile)
#pragma unroll
    for (int j = 0; j < 4; ++j) {
      const int t = 16 * tile + 4 * q4 + j;
      float y = yacc[tile][j] + su[t * 64 + wave * 16 + cc] * dsk;
      zg[(size_t)(cid * 64 + t) * 256 + ch] = f2bf(gelu_tanh(y));
    }
  __syncthreads();
}

DI void dn_out_item(const Params& p, int l, int unit, char* smem) {
  const int cid = unit >> 2, head = unit & 3;
  const int tid = otid(), lane = tid & 63, wave = tid >> 6;
  const int lr = lane & 31, lh = lane >> 5;
  float* so = (float*)smem;
  const u16* gates = (const u16*)(p.ws + OFF_GATES);
  u16* mix = (u16*)(p.ws + OFF_H);
  const int dir = wave >> 1, mt = wave & 1;
  const u16* dnd = (const u16*)(p.ws + OFF_DN) + ((size_t)unit * 2 + dir) * 5 * 4096;
  const u16* Pm = dnd + 2 * 4096, *RT = dnd + 3 * 4096, *ST = dnd + 4 * 4096;
  f32x16 acc[2];
#pragma unroll
  for (int nt = 0; nt < 2; ++nt)
#pragma unroll
    for (int i = 0; i < 16; ++i) acc[nt][i] = 0.f;
#pragma unroll
  for (int ks = 0; ks < 4; ++ks) {
    bf16x8 a = *(const bf16x8*)(Pm + (mt * 32 + lr) * 64 + ks * 16 + lh * 8);
#pragma unroll
    for (int nt = 0; nt < 2; ++nt) {
      bf16x8 b = *(const bf16x8*)(ST + (nt * 32 + lr) * 64 + ks * 16 + lh * 8);
      acc[nt] = MFMA32(a, b, acc[nt]);
    }
  }
#pragma unroll
  for (int nt = 0; nt < 2; ++nt)
#pragma unroll
    for (int g4 = 0; g4 < 4; ++g4) {
      uint2 rr = *(const uint2*)(RT + (nt * 32 + lr) * 64 + mt * 32 + 8 * g4 + 4 * lh);
      acc[nt][4 * g4 + 0] += bf2f((u16)(rr.x & 0xffff));
      acc[nt][4 * g4 + 1] += bf2f((u16)(rr.x >> 16));
      acc[nt][4 * g4 + 2] += bf2f((u16)(rr.y & 0xffff));
      acc[nt][4 * g4 + 3] += bf2f((u16)(rr.y >> 16));
    }
  if (dir == 0) {
#pragma unroll
    for (int nt = 0; nt < 2; ++nt)
#pragma unroll
      for (int i = 0; i < 16; ++i) {
        const int li = mt * 32 + (i & 3) + 8 * (i >> 2) + 4 * lh;
        so[li * 65 + nt * 32 + lr] = acc[nt][i];
      }
  }
  __syncthreads();
  if (dir == 1) {
#pragma unroll
    for (int nt = 0; nt < 2; ++nt)
#pragma unroll
      for (int i = 0; i < 16; ++i) {
        const int li = mt * 32 + (i & 3) + 8 * (i >> 2) + 4 * lh;
        so[(63 - li) * 65 + nt * 32 + lr] += acc[nt][i];
      }
  }
  __syncthreads();
  const float gain = p.out_gain[l * 64 + lane];
#pragma unroll
  for (int i0 = 0; i0 < 16; ++i0) {
    const int i = wave + 4 * i0;
    const size_t tt = (size_t)cid * 64 + i;
    const int c = head * 64 + lane;
    float o = so[i * 65 + lane];
    float ms = wave_sum(o * o) * (1.f / 64.f);
    float v = o * rsqrtf(ms + EPS) * gain * bf2f(gates[tt * 1024 + 512 + c]);
    mix[tt * 1024 + 512 + c] = f2bf(v);
  }
  __syncthreads();
}

#define SCAN_LOAD(U, POS)                                                                      \
  {                                                                                            \
    const int cid_ = chain_cid(dir, (POS));                                                    \
    const u16* base_ = dnb + ((size_t)(cid_ * 4 + head) * 2 + dir) * 5 * 4096;                 \
    _Pragma("unroll") for (int m = 0; m < 4; ++m) {                                            \
      _Pragma("unroll") for (int s2 = 0; s2 < 2; ++s2) {                                       \
        const uint4 t_ = *(const uint4*)(base_ + ((m * 2 + s2) * 64 + lane) * 8);              \
        mlo##U[m][s2] = make_uint2(t_.x, t_.y);                                                \
        mhi##U[m][s2] = make_uint2(t_.z, t_.w);                                                \
      }                                                                                        \
    }                                                                                          \
    {                                                                                          \
      const uint4 t0_ = *(const uint4*)(base_ + 4096 + (cgp * 64 + lane) * 16);                \
      const uint4 t1_ = *(const uint4*)(base_ + 4096 + (cgp * 64 + lane) * 16 + 8);            \
      ntv##U[0] = make_uint2(t0_.x, t0_.y); ntv##U[1] = make_uint2(t0_.z, t0_.w);              \
      ntv##U[2] = make_uint2(t1_.x, t1_.y); ntv##U[3] = make_uint2(t1_.z, t1_.w);              \
    }                                                                                          \
    gl##U = glast[(cid_ * 4 + head) * 2 + dir];                                                \
  }
#define SCAN_COMPUTE(U, POS)                                                                   \
  {                                                                                            \
    const int cid_ = chain_cid(dir, (POS));                                                    \
    u16* STp_ = dnb + (((size_t)(cid_ * 4 + head) * 2 + dir) * 5 + 4) * 4096 + dv * 64 + 4 * q4; \
    unsigned pk_[4][2];                                                                        \
    _Pragma("unroll") for (int m = 0; m < 4; ++m) {                                            \
      pk_[m][0] = pk2(S[m][0], S[m][1]);                                                       \
      pk_[m][1] = pk2(S[m][2], S[m][3]);                                                       \
      *(uint2*)(STp_ + 16 * m) = make_uint2(pk_[m][0], pk_[m][1]);                             \
    }                                                                                          \
    bf16x8 sb0_ = mk8u(pk_[0][0], pk_[0][1], pk_[1][0], pk_[1][1]);                            \
    bf16x8 sb1_ = mk8u(pk_[2][0], pk_[2][1], pk_[3][0], pk_[3][1]);                            \
    _Pragma("unroll") for (int m = 0; m < 4; ++m) {                                            \
      f32x4 acc_ = {0.f, 0.f, 0.f, 0.f};                                                       \
      acc_ = MFMA16(mk8(mlo##U[m][0], mhi##U[m][0]), sb0_, acc_);                              \
      acc_ = MFMA16(mk8(mlo##U[m][1], mhi##U[m][1]), sb1_, acc_);                              \
      S[m][0] = gl##U * S[m][0] - acc_[0] + bf2f((u16)(ntv##U[m].x & 0xffff));                 \
      S[m][1] = gl##U * S[m][1] - acc_[1] + bf2f((u16)(ntv##U[m].x >> 16));                    \
      S[m][2] = gl##U * S[m][2] - acc_[2] + bf2f((u16)(ntv##U[m].y & 0xffff));                 \
      S[m][3] = gl##U * S[m][3] - acc_[3] + bf2f((u16)(ntv##U[m].y >> 16));                    \
    }                                                                                          \
  }
DI void dn_scan_wave(const Params& p, int task) {
  const int head = task & 3, dir = (task >> 2) & 1, cgp = task >> 3;
  const int lane = otid() & 63;
  const int cn = lane & 15, q4 = lane >> 4;
  const int dv = cgp * 16 + cn;
  u16* dnb = (u16*)(p.ws + OFF_DN);
  const float* glast = (const float*)(p.ws + OFF_GLAST);
  f32x4 S[4];
#pragma unroll
  for (int m = 0; m < 4; ++m) S[m] = (f32x4){0.f, 0.f, 0.f, 0.f};
  uint2 mlo0[4][2], mhi0[4][2], ntv0[4]; float gl0;
  uint2 mlo1[4][2], mhi1[4][2], ntv1[4]; float gl1;
  uint2 mlo2[4][2], mhi2[4][2], ntv2[4]; float gl2;
  uint2 mlo3[4][2], mhi3[4][2], ntv3[4]; float gl3;
  SCAN_LOAD(0, 0) SCAN_LOAD(1, 1) SCAN_LOAD(2, 2) SCAN_LOAD(3, 3)
  for (int pos0 = 0; pos0 < NCH; pos0 += 4) {
    const bool more = pos0 + 4 < NCH;
    SCAN_COMPUTE(0, pos0) if (more) SCAN_LOAD(0, pos0 + 4)
    SCAN_COMPUTE(1, pos0 + 1) if (more) SCAN_LOAD(1, pos0 + 5)
    SCAN_COMPUTE(2, pos0 + 2) if (more) SCAN_LOAD(2, pos0 + 6)
    SCAN_COMPUTE(3, pos0 + 3) if (more) SCAN_LOAD(3, pos0 + 7)
  }
}

constexpr int A_LD = 72;
constexpr int V_LD = 136;
DI void attn_item(const Params& p, int item, char* smem) {
  int head, q0, ntiles;
  if (item < 512) { head = item & 7; q0 = NCTX + (item >> 3) * 256; ntiles = NCH; }
  else { head = item - 512; q0 = 0; ntiles = 4; }
  const int kvh = head >> 2;
  const int tid = otid(), lane = tid & 63, wave = tid >> 6;
  const int lr = lane & 31, lh = lane >> 5;
  const u16* Qb = (const u16*)(p.ws + OFF_QB) + (size_t)head * T * 64;
  const u16* Kb = (const u16*)(p.ws + OFF_KB) + (size_t)kvh * T * 64;
  const u16* Vt = (const u16*)(p.ws + OFF_VT) + (size_t)kvh * 64 * T;
  u16* Ks = (u16*)smem;
  u16* Vs = Ks + 2 * 128 * A_LD;
  bf16x8 qf[2][4];
#pragma unroll
  for (int qt = 0; qt < 2; ++qt)
#pragma unroll
    for (int ks = 0; ks < 4; ++ks)
      qf[qt][ks] = *(const bf16x8*)(Qb + (size_t)(q0 + wave * 64 + qt * 32 + lr) * 64 + ks * 16 + lh * 8);

  f32x16 ot[2][2];
#pragma unroll
  for (int a = 0; a < 2; ++a)
#pragma unroll
    for (int b = 0; b < 2; ++b)
#pragma unroll
      for (int i = 0; i < 16; ++i) ot[a][b][i] = 0.f;
  float lrun[2] = {0.f, 0.f};

  uint4 rk0, rk1, rv0, rv1;
  const int srow = tid >> 3, sch = tid & 7;
  const u16* Kg = Kb + (size_t)srow * 64 + sch * 8;
  const u16* Vg = Vt + (size_t)srow * T + sch * 8;
#define A_LOAD(J_)                                                               \
  {                                                                              \
    const u16* kg_ = Kg + (size_t)(J_) * 4096;                                   \
    const u16* vg_ = Vg + (size_t)(J_) * 64;                                     \
    rk0 = *(const uint4*)(kg_);  rk1 = *(const uint4*)(kg_ + 32 * 64);           \
    rv0 = *(const uint4*)(vg_);  rv1 = *(const uint4*)(vg_ + (size_t)32 * T);    \
  }
#define A_STORE(BUF_, HALF_)                                                     \
  {                                                                              \
    u16* ks_ = Ks + ((BUF_) * 128 + (HALF_) * 64 + srow) * A_LD + sch * 8;       \
    u16* vs_ = Vs + ((BUF_) * 64 + srow) * V_LD + (HALF_) * 64 + sch * 8;        \
    *(uint4*)(ks_) = rk0;  *(uint4*)(ks_ + 32 * A_LD) = rk1;                     \
    *(uint4*)(vs_) = rv0;  *(uint4*)(vs_ + 32 * V_LD) = rv1;                     \
  }
  A_LOAD(0)
  A_STORE(0, 0)
  A_LOAD(1)
  A_STORE(0, 1)
  __syncthreads();
  const int npairs = ntiles >> 1;
  for (int jj = 0; jj < npairs; ++jj) {
    const int buf = jj & 1;
    const int jnext = (jj + 1 < npairs ? jj + 1 : jj) * 2;
#pragma unroll 1
    for (int half = 0; half < 2; ++half) {
    A_LOAD(jnext + half)
    __builtin_amdgcn_sched_barrier(0);
    const u16* Kt = Ks + (buf * 128 + half * 64) * A_LD;
    const u16* Vtile = Vs + buf * 64 * V_LD + half * 64;
    f32x16 st[2][2];
#pragma unroll
    for (int a = 0; a < 2; ++a)
#pragma unroll
      for (int b = 0; b < 2; ++b)
#pragma unroll
        for (int i = 0; i < 16; ++i) st[a][b][i] = 0.f;
    {
      bf16x8 kf[2][4];
#pragma unroll
      for (int kt = 0; kt < 2; ++kt)
#pragma unroll
        for (int ks = 0; ks < 4; ++ks) kf[kt][ks] = *(const bf16x8*)(Kt + (kt * 32 + lr) * A_LD + ks * 16 + lh * 8);
      __builtin_amdgcn_sched_barrier(0);
#pragma unroll
      for (int kt = 0; kt < 2; ++kt)
#pragma unroll
        for (int ks = 0; ks < 4; ++ks) {
          st[kt][0] = MFMA32(kf[kt][ks], qf[0][ks], st[kt][0]);
          st[kt][1] = MFMA32(kf[kt][ks], qf[1][ks], st[kt][1]);
        }
    }
#pragma unroll
    for (int kt = 0; kt < 2; ++kt) {
#pragma unroll
      for (int qt = 0; qt < 2; ++qt) {
        float ls0 = 0.f, ls1 = 0.f;
#pragma unroll
        for (int i = 0; i < 16; i += 2) {
          float p0 = __builtin_amdgcn_exp2f(st[kt][qt][i]);
          float p1 = __builtin_amdgcn_exp2f(st[kt][qt][i + 1]);
          st[kt][qt][i] = p0;
          st[kt][qt][i + 1] = p1;
          ls0 += p0;
          ls1 += p1;
        }
        lrun[qt] += ls0 + ls1;
      }
#pragma unroll
      for (int ss = 0; ss < 2; ++ss) {
        bf16x8 pb[2];
#pragma unroll
        for (int qt = 0; qt < 2; ++qt)
          pb[qt] = mk8u(pk2(st[kt][qt][8 * ss + 0], st[kt][qt][8 * ss + 1]), pk2(st[kt][qt][8 * ss + 2], st[kt][qt][8 * ss + 3]),
                        pk2(st[kt][qt][8 * ss + 4], st[kt][qt][8 * ss + 5]), pk2(st[kt][qt][8 * ss + 6], st[kt][qt][8 * ss + 7]));
#pragma unroll
        for (int dt = 0; dt < 2; ++dt) {
          const u16* pr = Vtile + (dt * 32 + lr) * V_LD + 32 * kt + 16 * ss + 4 * lh;
          uint2 lo = *(const uint2*)pr;
          uint2 hi = *(const uint2*)(pr + 8);
          bf16x8 a = mk8(lo, hi);
#pragma unroll
          for (int qt = 0; qt < 2; ++qt) ot[dt][qt] = MFMA32(a, pb[qt], ot[dt][qt]);
        }
      }
    }
    __builtin_amdgcn_sched_barrier(0);
    A_STORE(buf ^ 1, half)
    }
    __syncthreads();
  }
  const u16* gates = (const u16*)(p.ws + OFF_GATES);
  u16* mix = (u16*)(p.ws + OFF_H);
#pragma unroll
  for (int qt = 0; qt < 2; ++qt) {
    const float lt = lrun[qt] + __shfl_xor(lrun[qt], 32);
    const float inv = 1.f / lt;
    const size_t row = (size_t)(q0 + wave * 64 + qt * 32 + lr);
#pragma unroll
    for (int dt = 0; dt < 2; ++dt)
#pragma unroll
      for (int g4 = 0; g4 < 4; ++g4) {
        const int d0 = 32 * dt + 8 * g4 + 4 * lh;
        uint2 gg = *(const uint2*)(gates + row * 1024 + head * 64 + d0);
        float o0 = ot[dt][qt][4 * g4 + 0] * inv * bf2f((u16)(gg.x & 0xffff));
        float o1 = ot[dt][qt][4 * g4 + 1] * inv * bf2f((u16)(gg.x >> 16));
        float o2 = ot[dt][qt][4 * g4 + 2] * inv * bf2f((u16)(gg.y & 0xffff));
        float o3 = ot[dt][qt][4 * g4 + 3] * inv * bf2f((u16)(gg.y >> 16));
        uint2 o = {pk2(o0, o1), pk2(o2, o3)};
        *(uint2*)(mix + row * 1024 + head * 64 + d0) = o;
      }
  }
}

DI void final_ln_phase(const Params& p, int l, const float* ctx_src, const float* lat_src) {
  const int lane = otid() & 63, wave = otid() >> 6;
  const int nw = gridDim.x * 4;
  const float* y = (const float*)(p.ws + OFF_DN);
  const float* modv = (const float*)(p.ws + OFF_MODV);
  float* ctx1 = (float*)(p.ws + OFF_CTX1);
  u16* h = (u16*)(p.ws + OFF_H);
  const int rstart = (l == 1) ? NCTX : 0;
  for (int r = rstart + blockIdx.x * 4 + wave; r < T; r += nw) {
    const bool isc = r < NCTX;
    const float* src = isc ? ctx_src + (size_t)r * DM : lat_src + (size_t)(r - NCTX) * DM;
    float* dst = isc ? ctx1 + (size_t)r * DM : p.out + (size_t)(r - NCTX) * DM;
    const float* mod = modv + (l * 2 + (isc ? 1 : 0)) * 3072;
    float4 v[4];
    float s = 0.f;
#pragma unroll
    for (int i = 0; i < 4; ++i) {
      int c0 = (i * 64 + lane) * 4;
      float4 xv = *(const float4*)(src + c0);
      float4 yv = *(const float4*)(y + (size_t)r * DM + c0);
      float4 gv = *(const float4*)(mod + 2048 + c0);
      v[i].x = DN_ALPHA * xv.x + gv.x * yv.x;
      v[i].y = DN_ALPHA * xv.y + gv.y * yv.y;
      v[i].z = DN_ALPHA * xv.z + gv.z * yv.z;
      v[i].w = DN_ALPHA * xv.w + gv.w * yv.w;
      s += v[i].x + v[i].y + v[i].z + v[i].w;
    }
    float mu = wave_sum(s) * (1.f / DM);
    float q = 0.f;
#pragma unroll
    for (int i = 0; i < 4; ++i) {
      v[i].x -= mu; v[i].y -= mu; v[i].z -= mu; v[i].w -= mu;
      q += v[i].x * v[i].x + v[i].y * v[i].y + v[i].z * v[i].z + v[i].w * v[i].w;
    }
    float rstd = rsqrtf(wave_sum(q) * (1.f / DM) + EPS);
    float s2 = 0.f;
#pragma unroll
    for (int i = 0; i < 4; ++i) {
      int c0 = (i * 64 + lane) * 4;
      float4 g = *(const float4*)(p.ln_g + l * DM + c0);
      float4 b = *(const float4*)(p.ln_b + l * DM + c0);
      v[i].x = v[i].x * rstd * g.x + b.x;
      v[i].y = v[i].y * rstd * g.y + b.y;
      v[i].z = v[i].z * rstd * g.z + b.z;
      v[i].w = v[i].w * rstd * g.w + b.w;
      *(float4*)(dst + c0) = v[i];
      s2 += v[i].x + v[i].y + v[i].z + v[i].w;
    }
    if (l == 0) {
      const float* mod1 = modv + (2 + (isc ? 1 : 0)) * 3072;
      float mu2 = wave_sum(s2) * (1.f / DM);
      float q2 = 0.f;
#pragma unroll
      for (int i = 0; i < 4; ++i) {
        v[i].x -= mu2; v[i].y -= mu2; v[i].z -= mu2; v[i].w -= mu2;
        q2 += v[i].x * v[i].x + v[i].y * v[i].y + v[i].z * v[i].z + v[i].w * v[i].w;
      }
      float rstd2 = rsqrtf(wave_sum(q2) * (1.f / DM) + EPS);
#pragma unroll
      for (int i = 0; i < 4; ++i) {
        int c0 = (i * 64 + lane) * 4;
        float4 sh = *(const float4*)(mod1 + c0);
        float4 sc = *(const float4*)(mod1 + 1024 + c0);
        float o0 = v[i].x * rstd2 * (1.f + sc.x) + sh.x;
        float o1 = v[i].y * rstd2 * (1.f + sc.y) + sh.y;
        float o2 = v[i].z * rstd2 * (1.f + sc.z) + sh.z;
        float o3 = v[i].w * rstd2 * (1.f + sc.w) + sh.w;
        uint2 pk = {pk2(o0, o1), pk2(o2, o3)};
        *(uint2*)(h + (size_t)r * DM + c0) = pk;
      }
    }
  }
}

#ifndef REP_ATTN
#define REP_ATTN 1
#endif
#ifndef REP_SCAN
#define REP_SCAN 1
#endif
#ifndef REP_GEMM
#define REP_GEMM 1
#endif
#ifndef REP_PREP
#define REP_PREP 1
#endif
#ifndef REP_P5
#define REP_P5 1
#endif
typedef const __attribute__((address_space(4))) Params* KParamsPtr;
DI const Params& kp() {
  KParamsPtr q = (KParamsPtr)__builtin_amdgcn_kernarg_segment_ptr();
  asm volatile("" : "+s"(q));
  return *(const Params*)q;
}
__global__ void __launch_bounds__(256, 2) fwd_megakernel(Params pin) {
  cg::grid_group grid = cg::this_grid();
  __shared__ __attribute__((aligned(16))) char smem[SMEM_BYTES];
  const int nb = gridDim.x;
  __shared__ uint4 xb_words;
  if (threadIdx.x == 0) xb_words = make_uint4(0u, 0u, 0u, 0u);
  __syncthreads();
  (void)xcd_barrier_post((unsigned*)(kp().ws + OFF_BAR), (volatile LAS unsigned*)&xb_words);
#define GRID_BARRIER() do { XcdBarrier xb_; xb_.bar = (unsigned*)(kp().ws + OFF_BAR); xb_.x = xb_xcc_id(); xb_.st = (volatile LAS unsigned*)&xb_words; xcd_barrier(xb_); } while (0)

  if (kp().ws == nullptr) grid.sync();
  setup_phase(kp(), smem);
  GRID_BARRIER();
  { const Params& p = kp(); ln_mod_phase(p, p.ctx, p.x, 0); }
  GRID_BARRIER();

  for (int l = 0; l < 2; ++l) {
    for (int rep = 0; rep < REP_GEMM; ++rep) gemm_in_phase(kp(), l, smem);
    GRID_BARRIER();
    for (int rep = 0; rep < REP_PREP; ++rep)
    for (int item = blockIdx.x; item < 1040 + 2080; item += nb) {
      if (item < 1040) dn_prep_item(kp(), l, item, smem);
      else s5_a_item(kp(), l, item - 1040, smem);
    }
    GRID_BARRIER();
    for (int rep = 0; rep < REP_SCAN; ++rep)
    for (int item = blockIdx.x; item < 40; item += nb) {
      if (item < 32) { if ((otid() >> 6) == 0) dn_scan_wave(kp(), item); }
      else s5_carry(kp(), l, item - 32);
    }
    GRID_BARRIER();
    {
      const int nattn = (l == 1) ? 512 : 520;
      for (int rep = 0; rep < REP_ATTN; ++rep)
        for (int item = blockIdx.x; item < nattn; item += nb) attn_item(kp(), item, smem);
    }
    GRID_BARRIER();
    {
      const int skip = (l == 1) ? 16 : 0;
      const int nper = 1040 - skip;
      for (int rep = 0; rep < REP_P5; ++rep)
      for (int item = blockIdx.x; item < 2 * nper; item += nb) {
        if (item < nper) s5_c_item(kp(), l, item + skip, smem);
        else dn_out_item(kp(), l, item - nper + skip, smem);
      }
    }
    GRID_BARRIER();
    gemm_glu_phase(kp(), l, smem);
    GRID_BARRIER();
    gemm_out_phase(kp(), l, smem);
    GRID_BARRIER();
    {
      const Params& p = kp();
      if (l == 0) final_ln_phase(p, 0, p.ctx, p.x);
      else final_ln_phase(p, 1, (const float*)(p.ws + OFF_CTX1), p.out);
    }
    if (l == 0) GRID_BARRIER();
  }
}

extern "C" void kernel_launch(void* const* d_in, const int* in_sizes, int n_in, void* d_out, int out_size, void* d_ws,
                              size_t ws_size, hipStream_t stream) {
  static int grid_blocks = 0;
  if (!grid_blocks) {
    int dev = 0, cus = 0, per_cu = 0;
    hipGetDevice(&dev);
    hipDeviceGetAttribute(&cus, hipDeviceAttributeMultiprocessorCount, dev);
    hipOccupancyMaxActiveBlocksPerMultiprocessor(&per_cu, fwd_megakernel, 256, 0);
    if (per_cu > 2) per_cu = 2;
    if (per_cu < 1) per_cu = 1;
    grid_blocks = cus * per_cu;
  }
  Params p{};
  const float** pp = (const float**)&p;
  for (int i = 0; i < 26; ++i) pp[i] = (const float*)d_in[i];
  p.out = (float*)d_out;
  p.ws = (char*)d_ws;
  void* args[] = {&p};
  (void)hipMemsetAsync((char*)d_ws + OFF_BAR, 0, XCD_BAR_WORDS * 4, stream);
  hipError_t e = hipLaunchCooperativeKernel((void*)fwd_megakernel, dim3(grid_blocks), dim3(256), args, 0, stream);
  if (e != hipSuccess) fprintf(stderr, "cooperative launch failed: %s (grid %d)\n", hipGetErrorString(e), grid_blocks);
}
```

```cpp
#include <hip/hip_runtime.h>
#include <hip/hip_cooperative_groups.h>
#include <cstdio>
namespace cg = cooperative_groups;

#define DI __device__ __forceinline__
typedef unsigned short u16;
using bf16x8 = __attribute__((ext_vector_type(8))) short;
using f32x16 = __attribute__((ext_vector_type(16))) float;
using f32x4 = __attribute__((ext_vector_type(4))) float;
typedef __bf16 bf2_t __attribute__((ext_vector_type(2)));
typedef float f2_t __attribute__((ext_vector_type(2)));

#define MFMA32(a, b, c) __builtin_amdgcn_mfma_f32_32x32x16_bf16((a), (b), (c), 0, 0, 0)
#define MFMA16(a, b, c) __builtin_amdgcn_mfma_f32_16x16x32_bf16((a), (b), (c), 0, 0, 0)

constexpr int T = 16640;
constexpr int NCTX = 256;
constexpr int DM = 1024;
constexpr int NIN = 2832;
constexpr int NINP = 2944;
constexpr int NCH = 260;
constexpr float EPS = 1e-6f;
constexpr float DN_ALPHA = 1.4142135623730951f;

constexpr size_t al256(size_t x) { return (x + 255) & ~(size_t)255; }
constexpr size_t OFF_WINT = 0;
constexpr size_t OFF_WOUTT = OFF_WINT + al256((size_t)2 * NINP * 1024 * 2);
constexpr size_t OFF_GLUWT = OFF_WOUTT + al256((size_t)2 * 1024 * 1024 * 2);
constexpr size_t OFF_MODV = OFF_GLUWT + al256((size_t)2 * 256 * 256 * 2);
constexpr size_t OFF_ROPE = OFF_MODV + al256((size_t)2 * 2 * 3072 * 4);
constexpr size_t OFF_H = OFF_ROPE + al256((size_t)256 * 16 * 2 * 4);
constexpr size_t OFF_QB = OFF_H + al256((size_t)T * 1024 * 2);
constexpr size_t OFF_KB = OFF_QB + al256((size_t)8 * T * 64 * 2);
constexpr size_t OFF_VT = OFF_KB + al256((size_t)2 * T * 64 * 2);
constexpr size_t OFF_GATES = OFF_VT + al256((size_t)2 * T * 64 * 2);
constexpr size_t OFF_QKVB = OFF_GATES + al256((size_t)T * 1024 * 2);
constexpr size_t OFF_UC = OFF_QKVB + al256((size_t)T * 768 * 2);
constexpr size_t OFF_BD = OFF_UC + al256((size_t)T * 256 * 4);
constexpr size_t OFF_DN = OFF_BD + al256((size_t)T * 16 * 4);
constexpr size_t OFF_GLAST = OFF_DN + al256((size_t)1040 * 2 * 5 * 4096 * 2);
constexpr size_t OFF_S5E = OFF_GLAST + al256((size_t)1040 * 2 * 4);
constexpr size_t OFF_S5H = OFF_S5E + al256((size_t)NCH * 2 * 16 * 64 * 2 * 4);
constexpr size_t OFF_CTX1 = OFF_S5H + al256((size_t)NCH * 2 * 16 * 64 * 2 * 4);
constexpr size_t OFF_BAR = OFF_CTX1 + al256((size_t)256 * 1024 * 4);
constexpr size_t WS_TOTAL = OFF_BAR + 16384;
static_assert(WS_TOTAL <= (size_t)256 * 1024 * 1024, "workspace too large");
static_assert((size_t)T * 1024 * 4 <= (size_t)1040 * 2 * 5 * 4096 * 2, "y alias");

struct Params {
  const float *x, *c, *ctx, *c_ctx, *w_mod, *b_mod, *w_in, *qg, *kg, *conv_w, *A_log, *dt_bias, *out_gain,
      *A_re, *A_im, *log_dt, *B_re, *B_im, *C_re, *C_im, *Dskip, *glu_w, *glu_b, *w_out, *ln_g, *ln_b;
  float* out;
  char* ws;
};

constexpr int SMEM_BYTES = 75 * 1024;

DI float bf2f(u16 v) { return __uint_as_float(((unsigned)v) << 16); }
DI unsigned pk2(float a, float b) {
  f2_t v = {a, b};
  bf2_t r = __builtin_convertvector(v, bf2_t);
  return __builtin_bit_cast(unsigned, r);
}
DI u16 f2bf(float a) { return (u16)(pk2(a, 0.f) & 0xffffu); }
DI float silu_f(float x) { return x / (1.f + __expf(-x)); }
DI float sigmoid_f(float x) { return 1.f / (1.f + __expf(-x)); }
template <int CTRL>
DI float dppf(float v) {
  return __builtin_bit_cast(float, __builtin_amdgcn_update_dpp(0, __builtin_bit_cast(int, v), CTRL, 0xf, 0xf, true));
}
DI float wave_sum(float v) {
  v += dppf<0xB1>(v);
  v += dppf<0x4E>(v);
  v += dppf<0x141>(v);
  v += dppf<0x140>(v);
  v += __shfl_xor(v, 16);
  v += __shfl_xor(v, 32);
  return v;
}
DI int otid() { int t = threadIdx.x; asm volatile("" : "+v"(t)); return t; }
DI float gelu_tanh(float x) {
  float u = 0.7978845608028654f * (x + 0.044715f * x * x * x);
  float t = 1.f - 2.f / (1.f + __expf(2.f * u));
  return 0.5f * x * (1.f + t);
}
DI bf16x8 mk8(uint2 lo, uint2 hi) {
  uint4 v = {lo.x, lo.y, hi.x, hi.y};
  return __builtin_bit_cast(bf16x8, v);
}
DI bf16x8 mk8u(unsigned a, unsigned b, unsigned c, unsigned d) {
  uint4 v = {a, b, c, d};
  return __builtin_bit_cast(bf16x8, v);
}


#define XB_TMO      128
#define XB_XCNT(j)  (256  + 64 * (j))
#define XB_XSUB(j)  (1280 + 64 * (j))
#define XB_XGEN(j)  (2304 + 64 * (j))
#define XB_TOP      3328
#define XB_TOPGEN   3392
#define XCD_BAR_WORDS 3456
#define XB_SPIN_CAP (1u << 18)
#define LAS __attribute__((address_space(3)))
DI unsigned xb_ld(unsigned* p) { return __hip_atomic_load(p, __ATOMIC_RELAXED, __HIP_MEMORY_SCOPE_AGENT); }
DI unsigned xb_add(unsigned* p, unsigned v) { return __hip_atomic_fetch_add(p, v, __ATOMIC_RELAXED, __HIP_MEMORY_SCOPE_AGENT); }
DI unsigned xb_xcc_id() { return (unsigned)__builtin_amdgcn_s_getreg((3 << 11) | 20) & 0xFu; }
#define XB_SPIN(cond, bar) do { unsigned _sp = 0; while (cond) { __builtin_amdgcn_s_sleep(1); \
    if ((++_sp & 255u) == 0u) { if (xb_ld(&(bar)[XB_TMO])) break; if (_sp > XB_SPIN_CAP) { atomicAdd(&(bar)[XB_TMO], 1u); break; } } } } while (0)
struct XcdBarrier { unsigned* bar; unsigned x; volatile LAS unsigned* st; };
DI XcdBarrier xcd_barrier_post(unsigned* bar, volatile LAS unsigned* st) {
  XcdBarrier b; b.bar = bar; b.x = xb_xcc_id(); b.st = st;
  if (threadIdx.x == 0) (void)xb_add(&bar[XB_XCNT(b.x)], 1u);
  return b;
}
DI void xcd_barrier_complete(unsigned* bar, unsigned x, unsigned& nloc, unsigned& nx) {
  const unsigned G = gridDim.x * gridDim.y * gridDim.z;
  unsigned sum, cnt, mine, sp = 0u;
  for (;;) {
    sum = 0u; cnt = 0u; mine = 0u;
#pragma unroll
    for (unsigned j = 0; j < 16; ++j) { const unsigned c = xb_ld(&bar[XB_XCNT(j)]); sum += c; cnt += (c > 0u) ? 1u : 0u; mine = (j == x) ? c : mine; }
    if (sum == G) break;
    __builtin_amdgcn_s_sleep(1);
    if ((++sp & 255u) == 0u) { if (xb_ld(&bar[XB_TMO])) break; if (sp > XB_SPIN_CAP) { atomicAdd(&bar[XB_TMO], 1u); break; } }
  }
  nloc = mine > 0u ? mine : 1u; nx = cnt > 0u ? cnt : 1u;
}
DI void xcd_barrier(const XcdBarrier& b) {
  asm volatile("s_waitcnt vmcnt(0)" ::: "memory");
  __syncthreads();
  if (threadIdx.x == 0) {
    unsigned* bar = b.bar;
    __builtin_amdgcn_s_waitcnt(0);
    unsigned nloc = b.st[0], nx = b.st[1];
    if (nloc == 0u) { xcd_barrier_complete(bar, b.x, nloc, nx); b.st[0] = nloc; b.st[1] = nx; }
    const unsigned old = xb_add(&bar[XB_XSUB(b.x)], 1u);
    const unsigned gen = old / nloc;
    if (old + 1u == (gen + 1u) * nloc) {
      __builtin_amdgcn_fence(__ATOMIC_RELEASE, "agent");
      asm volatile("s_waitcnt vmcnt(0)" ::: "memory");
      const unsigned og = xb_add(&bar[XB_TOP], 1u);
      const unsigned tg = og / nx;
      if (og + 1u == (tg + 1u) * nx) xb_add(&bar[XB_TOPGEN], 1u);
      else XB_SPIN(xb_ld(&bar[XB_TOPGEN]) == tg, bar);
      __builtin_amdgcn_fence(__ATOMIC_ACQUIRE, "agent");
      xb_add(&bar[XB_XGEN(b.x)], 1u);
      asm volatile("s_waitcnt vmcnt(0)" ::: "memory");
    } else {
      XB_SPIN(xb_ld(&bar[XB_XGEN(b.x)]) == gen, bar);
      __builtin_amdgcn_fence(__ATOMIC_ACQUIRE, "agent");
      asm volatile("s_waitcnt vmcnt(0)" ::: "memory");
    }
  }
  __syncthreads();
}

DI void transpose_item(const float* __restrict__ src, int src_ld, u16* __restrict__ dst, int dst_ld, int k0, int n0,
                       bool permute_in, char* smem) {
  float* tile = (float*)smem;
  const int tid = otid();
#pragma unroll
  for (int i = 0; i < 16; ++i) {
    int k = i * 4 + (tid >> 6), n = tid & 63;
    int nd = n0 + n, ns = nd;
    if (permute_in) {
      if (nd < 2304) ns = nd;
      else if (nd < 2816) ns = nd + 16;
      else if (nd < 2832) ns = nd - 512;
      else ns = -1;
    }
    float v = (ns >= 0) ? src[(size_t)(k0 + k) * src_ld + ns] : 0.f;
    tile[k * 65 + n] = v;
  }
  __syncthreads();
#pragma unroll 4
  for (int i = 0; i < 16; ++i) {
    int n = i * 4 + (tid >> 6), k = tid & 63;
    dst[(size_t)(n0 + n) * dst_ld + k0 + k] = f2bf(tile[k * 65 + n]);
  }
  __syncthreads();
}

DI void mod_item(const Params& p, int item, char* smem) {
  const int l = item / 96, grp = item % 96;
  float* ssc = (float*)smem;
  float* red = ssc + 2048;
  const int tid = otid();
  for (int i = tid; i < 1024; i += 256) {
    ssc[i] = silu_f(p.c[i]);
    ssc[1024 + i] = silu_f(p.c_ctx[i]);
  }
  __syncthreads();
  const int kq = tid >> 5, n = tid & 31, col = grp * 32 + n;
  const float* w = p.w_mod + (size_t)l * 1024 * 3072 + col;
  float a0 = 0.f, a1 = 0.f;
#pragma unroll 16
  for (int k = kq * 128; k < kq * 128 + 128; ++k) {
    float wv = w[(size_t)k * 3072];
    a0 += ssc[k] * wv;
    a1 += ssc[1024 + k] * wv;
  }
  red[(0 * 8 + kq) * 32 + n] = a0;
  red[(1 * 8 + kq) * 32 + n] = a1;
  __syncthreads();
  if (tid < 64) {
    int v = tid >> 5, nn = tid & 31;
    float s = 0.f;
    for (int q = 0; q < 8; ++q) s += red[(v * 8 + q) * 32 + nn];
    int cc = grp * 32 + nn;
    float* modv = (float*)(p.ws + OFF_MODV);
    modv[(l * 2 + v) * 3072 + cc] = s + p.b_mod[l * 3072 + cc];
  }
  __syncthreads();
}

DI void setup_phase(const Params& p, char* smem) {
  constexpr int N_A = 2 * 16 * 46, N_B = 2 * 16 * 16, N_C = 2 * 4 * 4, N_D = 192, N_E = 1;
  constexpr int NTOT = N_A + N_B + N_C + N_D + N_E;
  for (int item = blockIdx.x; item < NTOT; item += gridDim.x) {
    int it = item;
    if (it < N_A) {
      int l = it / (16 * 46), r = it % (16 * 46);
      int kt = r / 46, nt = r % 46;
      transpose_item(p.w_in + (size_t)l * 1024 * NIN, NIN, (u16*)(p.ws + OFF_WINT) + (size_t)l * NINP * 1024, 1024,
                     kt * 64, nt * 64, true, smem);
      continue;
    }
    it -= N_A;
    if (it < N_B) {
      int l = it / 256, r = it % 256;
      int kt = r / 16, nt = r % 16;
      transpose_item(p.w_out + (size_t)l * 1024 * 1024, 1024, (u16*)(p.ws + OFF_WOUTT) + (size_t)l * 1024 * 1024, 1024,
                     kt * 64, nt * 64, false, smem);
      continue;
    }
    it -= N_B;
    if (it < N_C) {
      int l = it / 16, r = it % 16;
      int kt = r / 4, nt = r % 4;
      transpose_item(p.glu_w + (size_t)l * 256 * 256, 256, (u16*)(p.ws + OFF_GLUWT) + (size_t)l * 256 * 256, 256,
                     kt * 64, nt * 64, false, smem);
      continue;
    }
    it -= N_C;
    if (it < N_D) { mod_item(p, it, smem); continue; }
    float* rope = (float*)(p.ws + OFF_ROPE);
    for (int e = otid(); e < 4096; e += 256) {
      int row = e >> 4, j = e & 15;
      float inv = powf(10000.f, -(float)j / 16.f);
      float ang = (float)row * inv;
      rope[e * 2] = cosf(ang);
      rope[e * 2 + 1] = sinf(ang);
    }
  }
}

DI void ln_mod_phase(const Params& p, const float* ctx_src, const float* lat_src, int l) {
  const int lane = otid() & 63, wave = otid() >> 6;
  const int nw = gridDim.x * 4;
  u16* h = (u16*)(p.ws + OFF_H);
  const float* modv = (const float*)(p.ws + OFF_MODV);
  for (int r = blockIdx.x * 4 + wave; r < T; r += nw) {
    const float* src = (r < NCTX) ? ctx_src + (size_t)r * DM : lat_src + (size_t)(r - NCTX) * DM;
    const float* mod = modv + (l * 2 + (r < NCTX ? 1 : 0)) * 3072;
    float4 v[4];
    float s = 0.f;
#pragma unroll
    for (int i = 0; i < 4; ++i) {
      v[i] = *(const float4*)(src + (i * 64 + lane) * 4);
      s += v[i].x + v[i].y + v[i].z + v[i].w;
    }
    float mu = wave_sum(s) * (1.f / DM);
    float q = 0.f;
#pragma unroll
    for (int i = 0; i < 4; ++i) {
      v[i].x -= mu; v[i].y -= mu; v[i].z -= mu; v[i].w -= mu;
      q += v[i].x * v[i].x + v[i].y * v[i].y + v[i].z * v[i].z + v[i].w * v[i].w;
    }
    float rstd = rsqrtf(wave_sum(q) * (1.f / DM) + EPS);
#pragma unroll
    for (int i = 0; i < 4; ++i) {
      int c0 = (i * 64 + lane) * 4;
      float4 sh = *(const float4*)(mod + c0);
      float4 sc = *(const float4*)(mod + 1024 + c0);
      float o0 = v[i].x * rstd * (1.f + sc.x) + sh.x;
      float o1 = v[i].y * rstd * (1.f + sc.y) + sh.y;
      float o2 = v[i].z * rstd * (1.f + sc.z) + sh.z;
      float o3 = v[i].w * rstd * (1.f + sc.w) + sh.w;
      uint2 pk = {pk2(o0, o1), pk2(o2, o3)};
      *(uint2*)(h + (size_t)r * DM + c0) = pk;
    }
  }
}

constexpr int G_LDA = 72;
DI void gemm_tile_compute(const u16* __restrict__ A, int lda, const u16* __restrict__ Bt, int ldb, int K, int m0, int n0,
                          char* smem) {
  u16* As = (u16*)smem;
  u16* Bs = As + 2 * 128 * G_LDA;
  const int tid = otid(), lane = tid & 63, wave = tid >> 6;
  const int wm = wave >> 1, wn = wave & 1;
  const int lr = lane & 31, lh = lane >> 5;
  f32x16 acc[2][2];
#pragma unroll
  for (int a = 0; a < 2; ++a)
#pragma unroll
    for (int b = 0; b < 2; ++b)
#pragma unroll
      for (int i = 0; i < 16; ++i) acc[a][b][i] = 0.f;

  const int KT = K / 64;
  uint4 ra0, ra1, ra2, ra3, rb0, rb1, rb2, rb3;
  const int srow = tid >> 3, sch = tid & 7;
  const u16* Ag = A + (size_t)(m0 + srow) * lda + sch * 8;
  const u16* Bg = Bt + (size_t)(n0 + srow) * ldb + sch * 8;
  const size_t a32 = (size_t)32 * lda, b32 = (size_t)32 * ldb;
#define G_LOAD(KT_)                                                                       \
  {                                                                                       \
    const u16* ag_ = Ag + (KT_) * 64;                                                     \
    const u16* bg_ = Bg + (KT_) * 64;                                                     \
    ra0 = *(const uint4*)(ag_);            rb0 = *(const uint4*)(bg_);                    \
    ra1 = *(const uint4*)(ag_ + a32);      rb1 = *(const uint4*)(bg_ + b32);              \
    ra2 = *(const uint4*)(ag_ + 2 * a32);  rb2 = *(const uint4*)(bg_ + 2 * b32);          \
    ra3 = *(const uint4*)(ag_ + 3 * a32);  rb3 = *(const uint4*)(bg_ + 3 * b32);          \
  }
#define G_STORE(BUF_)                                                                     \
  {                                                                                       \
    u16* as_ = As + ((BUF_) * 128 + srow) * G_LDA + sch * 8;                              \
    u16* bs_ = Bs + ((BUF_) * 128 + srow) * G_LDA + sch * 8;                              \
    *(uint4*)(as_) = ra0;                    *(uint4*)(bs_) = rb0;                        \
    *(uint4*)(as_ + 32 * G_LDA) = ra1;       *(uint4*)(bs_ + 32 * G_LDA) = rb1;           \
    *(uint4*)(as_ + 64 * G_LDA) = ra2;       *(uint4*)(bs_ + 64 * G_LDA) = rb2;           \
    *(uint4*)(as_ + 96 * G_LDA) = ra3;       *(uint4*)(bs_ + 96 * G_LDA) = rb3;           \
  }
  G_LOAD(0)
  G_STORE(0)
  __syncthreads();
  for (int kt = 0; kt < KT; ++kt) {
    const int buf = kt & 1;
    const int ktn = kt + 1 < KT ? kt + 1 : kt;
    G_LOAD(ktn)
    __builtin_amdgcn_sched_barrier(0);
    const u16* Ab = As + (buf * 128 + wm * 64 + lr) * G_LDA + lh * 8;
    const u16* Bb = Bs + (buf * 128 + wn * 64 + lr) * G_LDA + lh * 8;
    bf16x8 fa0[4], fa1[4], fb0[4], fb1[4];
#pragma unroll
    for (int ks = 0; ks < 4; ++ks) {
      fa0[ks] = *(const bf16x8*)(Ab + ks * 16);
      fa1[ks] = *(const bf16x8*)(Ab + 32 * G_LDA + ks * 16);
      fb0[ks] = *(const bf16x8*)(Bb + ks * 16);
      fb1[ks] = *(const bf16x8*)(Bb + 32 * G_LDA + ks * 16);
    }
    __builtin_amdgcn_sched_barrier(0);
#pragma unroll
    for (int ks = 0; ks < 4; ++ks) {
      acc[0][0] = MFMA32(fa0[ks], fb0[ks], acc[0][0]);
      acc[0][1] = MFMA32(fa0[ks], fb1[ks], acc[0][1]);
      acc[1][0] = MFMA32(fa1[ks], fb0[ks], acc[1][0]);
      acc[1][1] = MFMA32(fa1[ks], fb1[ks], acc[1][1]);
    }
    __builtin_amdgcn_sched_barrier(0);
    G_STORE(buf ^ 1)
    __syncthreads();
  }
  float* Cs = (float*)smem;
#pragma unroll
  for (int mi = 0; mi < 2; ++mi)
#pragma unroll
    for (int ni = 0; ni < 2; ++ni)
#pragma unroll
      for (int i = 0; i < 16; ++i) {
        int row = wm * 64 + mi * 32 + (i & 3) + 8 * (i >> 2) + 4 * lh;
        int col = wn * 64 + ni * 32 + lr;
        Cs[row * 132 + col] = acc[mi][ni][i];
      }
  __syncthreads();
}

template <bool OUT_BF16, bool SILU>
DI void epi_store(const float* Cs, void* dst, int ld, int m0, int coff, int ncols) {
  const int tid = otid();
  const int cpr = ncols >> 2;
  for (int idx = tid; idx < 128 * cpr; idx += 256) {
    int row = idx / cpr, c4 = idx % cpr;
    float4 v = *(const float4*)(Cs + row * 132 + 4 * c4);
    if (SILU) { v.x = silu_f(v.x); v.y = silu_f(v.y); v.z = silu_f(v.z); v.w = silu_f(v.w); }
    size_t o = (size_t)(m0 + row) * ld + coff + 4 * c4;
    if (OUT_BF16) *(uint2*)((u16*)dst + o) = make_uint2(pk2(v.x, v.y), pk2(v.z, v.w));
    else *(float4*)((float*)dst + o) = v;
  }
}

DI void epi_qk(const Params& p, const float* Cs, int l, int m0, int nt) {
  const int tid = otid();
  const int row = tid & 127, hh = tid >> 7;
  const int gr = m0 + row;
  const bool isk = (nt == 4);
  const float* gain = (isk ? p.kg : p.qg) + l * 64;
  float v[64];
  float ss = 0.f;
#pragma unroll
  for (int d4 = 0; d4 < 16; ++d4) {
    float4 t4 = *(const float4*)(Cs + row * 132 + hh * 64 + d4 * 4);
    v[4 * d4] = t4.x; v[4 * d4 + 1] = t4.y; v[4 * d4 + 2] = t4.z; v[4 * d4 + 3] = t4.w;
    ss += t4.x * t4.x + t4.y * t4.y + t4.z * t4.z + t4.w * t4.w;
  }
  float rinv = rsqrtf(ss * (1.f / 64.f) + EPS);
#pragma unroll
  for (int d = 0; d < 64; ++d) v[d] = v[d] * rinv * gain[d];
  if (gr >= NCTX) {
    const int t = gr - NCTX;
    const float* rope = (const float*)(p.ws + OFF_ROPE);
    const float* rr = rope + (t >> 6) * 32;
    const float* rc = rope + (t & 63) * 32;
#pragma unroll
    for (int j = 0; j < 16; ++j) {
      float c1 = rr[2 * j], s1 = rr[2 * j + 1];
      float a = v[j], b = v[j + 16];
      v[j] = a * c1 - b * s1;
      v[j + 16] = b * c1 + a * s1;
      float c2 = rc[2 * j], s2 = rc[2 * j + 1];
      float a2 = v[32 + j], b2 = v[48 + j];
      v[32 + j] = a2 * c2 - b2 * s2;
      v[48 + j] = b2 * c2 + a2 * s2;
    }
  }
  if (!isk) {
    constexpr float QS = 0.125f * 1.4426950408889634f;
#pragma unroll
    for (int d = 0; d < 64; ++d) v[d] *= QS;
  }
  u16* dst;
  if (isk) dst = (u16*)(p.ws + OFF_KB) + ((size_t)hh * T + gr) * 64;
  else dst = (u16*)(p.ws + OFF_QB) + ((size_t)(2 * nt + hh) * T + gr) * 64;
#pragma unroll
  for (int c = 0; c < 8; ++c) {
    uint4 o = {pk2(v[8 * c], v[8 * c + 1]), pk2(v[8 * c + 2], v[8 * c + 3]), pk2(v[8 * c + 4], v[8 * c + 5]),
               pk2(v[8 * c + 6], v[8 * c + 7])};
    *(uint4*)(dst + 8 * c) = o;
  }
}

DI void epi_v(const Params& p, const float* Cs, int m0) {
  const int tid = otid();
  const int c = tid & 127, half = tid >> 7;
  const int kvh = c >> 6, d = c & 63;
  u16* dst = (u16*)(p.ws + OFF_VT) + ((size_t)kvh * 64 + d) * T + m0 + half * 64;
#pragma unroll
  for (int g = 0; g < 8; ++g) {
    float v[8];
#pragma unroll
    for (int e = 0; e < 8; ++e) v[e] = Cs[(half * 64 + g * 8 + e) * 132 + c];
    uint4 o = {pk2(v[0], v[1]), pk2(v[2], v[3]), pk2(v[4], v[5]), pk2(v[6], v[7])};
    *(uint4*)(dst + g * 8) = o;
  }
}

DI void gemm_in_phase(const Params& p, int l, char* smem) {
  const u16* A = (const u16*)(p.ws + OFF_H);
  const u16* Bt = (const u16*)(p.ws + OFF_WINT) + (size_t)l * NINP * 1024;
  constexpr int MT = T / 128, NT = NINP / 128;
  const float* Cs = (const float*)smem;
  constexpr int NFULL = (MT / 8) * 8 * NT, MREM = MT % 8;
  for (int item = blockIdx.x; item < MT * NT; item += gridDim.x) {
    int mt, nt;
    if (item < NFULL) { const int xcd = item & 7, r = item >> 3; mt = (r / NT) * 8 + xcd; nt = r % NT; }
    else { const int j = item - NFULL; mt = (MT / 8) * 8 + j % MREM; nt = j / MREM; }
    const int m0 = mt * 128;
    gemm_tile_compute(A, 1024, Bt, 1024, 1024, m0, nt * 128, smem);
    if (nt <= 4) epi_qk(p, Cs, l, m0, nt);
    else if (nt == 5) epi_v(p, Cs, m0);
    else if (nt <= 9) epi_store<true, true>(Cs, p.ws + OFF_GATES, 1024, m0, (nt - 6) * 128, 128);
    else if (nt <= 15) epi_store<true, false>(Cs, p.ws + OFF_QKVB, 768, m0, (nt - 10) * 128, 128);
    else if (nt <= 17) epi_store<true, true>(Cs, p.ws + OFF_GATES, 1024, m0, 512 + (nt - 16) * 128, 128);
    else if (nt <= 19) epi_store<false, false>(Cs, p.ws + OFF_UC, 256, m0, (nt - 18) * 128, 128);
    else if (nt <= 21) epi_store<true, true>(Cs, p.ws + OFF_GATES, 1024, m0, 768 + (nt - 20) * 128, 128);
    else epi_store<false, false>(Cs, p.ws + OFF_BD, 16, m0, 0, 16);
    __syncthreads();
  }
}

DI void gemm_glu_phase(const Params& p, int l, char* smem) {
  const u16* A = (const u16*)(p.ws + OFF_QB);
  const u16* Bt = (const u16*)(p.ws + OFF_GLUWT) + (size_t)l * 256 * 256;
  const u16* gates = (const u16*)(p.ws + OFF_GATES);
  u16* mix = (u16*)(p.ws + OFF_H);
  const float* Cs = (const float*)smem;
  constexpr int MT = T / 128;
  for (int item = blockIdx.x; item < MT * 2; item += gridDim.x) {
    const int mt = item >> 1, nt = item & 1;
    const int m0 = mt * 128, n0 = nt * 128;
    gemm_tile_compute(A, 256, Bt, 256, 256, m0, n0, smem);
    for (int idx = otid(); idx < 128 * 64; idx += 256) {
      int row = idx >> 6, cp = idx & 63;
      int col = n0 + 2 * cp;
      size_t r = (size_t)(m0 + row);
      float a0 = Cs[row * 132 + 2 * cp] + p.glu_b[l * 256 + col];
      float a1 = Cs[row * 132 + 2 * cp + 1] + p.glu_b[l * 256 + col + 1];
      unsigned zz = *(const unsigned*)(A + r * 256 + col);
      unsigned gg = *(const unsigned*)(gates + r * 1024 + 768 + col);
      float z0 = bf2f((u16)(zz & 0xffff)), z1 = bf2f((u16)(zz >> 16));
      float g0 = bf2f((u16)(gg & 0xffff)), g1 = bf2f((u16)(gg >> 16));
      float o0 = z0 * sigmoid_f(a0) * g0, o1 = z1 * sigmoid_f(a1) * g1;
      *(unsigned*)(mix + r * 1024 + 768 + col) = pk2(o0, o1);
    }
    __syncthreads();
  }
}

DI void gemm_out_phase(const Params& p, int l, char* smem) {
  const u16* A = (const u16*)(p.ws + OFF_H);
  const u16* Bt = (const u16*)(p.ws + OFF_WOUTT) + (size_t)l * 1024 * 1024;
  const float* Cs = (const float*)smem;
  constexpr int MT = T / 128, NT = 8;
  const int mstart = (l == 1) ? 2 : 0;
  constexpr int NFULL = (MT / 8) * 8 * NT, MREM = MT % 8;
  const int nitems = (l == 1) ? NFULL : MT * NT;
  for (int item = blockIdx.x; item < nitems; item += gridDim.x) {
    int mt, nt;
    if (item < NFULL) { const int xcd = item & 7, r = item >> 3; mt = (r / NT) * 8 + xcd; nt = r % NT; }
    else { const int j = item - NFULL; mt = (MT / 8) * 8 + j % MREM; nt = j / MREM; }
    if (mt < mstart) mt += (MT / 8) * 8;
    gemm_tile_compute(A, 1024, Bt, 1024, 1024, mt * 128, nt * 128, smem);
    epi_store<false, false>(Cs, p.ws + OFF_DN, 1024, mt * 128, nt * 128, 128);
    __syncthreads();
  }
}

DI void dn_solve(const float* Lr, const float* sb, const float* gc, bool isv, const char* src, int stride_bytes, float* x) {
  int off = 0;
  const int hioff = isv ? 0 : 2;
  const unsigned lomask = isv ? 0u : 0xffffu;
  const float gsel = isv ? 0.f : 1.f;
#pragma unroll
  for (int li = 0; li < 64; ++li) {
    const unsigned hi = *(const u16*)(src + off + hioff);
    const unsigned lo = *(const u16*)(src + off);
    const float gcl = gc[li];
    float r = __uint_as_float((hi << 16) | (lo & lomask)) * __expf(gcl * gsel);
    off += stride_bytes;
    asm volatile("" : "+v"(off));
    float acc = r * sb[li];
#pragma unroll
    for (int lj4 = 0; lj4 < (li + 3) / 4; ++lj4) {
      float4 Lq = *(const float4*)(Lr + li * 64 + lj4 * 4);
      if (lj4 * 4 + 0 < li) acc -= Lq.x * x[lj4 * 4 + 0];
      if (lj4 * 4 + 1 < li) acc -= Lq.y * x[lj4 * 4 + 1];
      if (lj4 * 4 + 2 < li) acc -= Lq.z * x[lj4 * 4 + 2];
      if (lj4 * 4 + 3 < li) acc -= Lq.w * x[lj4 * 4 + 3];
    }
    x[li] = acc;
    if (li & 1) __builtin_amdgcn_sched_barrier(0);
  }
}

DI void dn_prep_item(const Params& p, int l, int unit, char* smem) {
  const int cid = unit >> 2, head = unit & 3;
  const int tt0 = cid * 64;
  const int seg_lo = cid < 4 ? 0 : NCTX, seg_hi = cid < 4 ? NCTX : T;
  float* sq = (float*)smem;
  float* sk = sq + 64 * 65;
  float* sL = sk + 64 * 65;
  float* sbeta = sL + 2 * 4096;
  float* sgc = sbeta + 128;
  float* sg = sgc + 128;
  u16* sv = (u16*)(sg + 128);
  const u16* z = (const u16*)(p.ws + OFF_QKVB);
  const float* bd = (const float*)(p.ws + OFF_BD);
  const float* cw = p.conv_w + l * 3 * 768;
  u16* dn = (u16*)(p.ws + OFF_DN) + (size_t)unit * 2 * 5 * 4096;
  u16* tmp = (u16*)(p.ws + OFF_H) + (size_t)blockIdx.x * 32768;
  float* glast = (float*)(p.ws + OFF_GLAST);
  const int tid = otid(), lane = tid & 63, wave = tid >> 6;

  {
    const int cq = head * 64 + lane, ck = 256 + head * 64 + lane;
    const float wq0 = cw[cq], wq1 = cw[768 + cq], wq2 = cw[1536 + cq];
    const float wk0 = cw[ck], wk1 = cw[768 + ck], wk2 = cw[1536 + ck];
#pragma unroll 8
    for (int i = wave; i < 64; i += 4) {
      const int tt = tt0 + i;
      float zq0 = 0.f, zq2 = 0.f, zk0 = 0.f, zk2 = 0.f;
      if (tt - 1 >= seg_lo) { zq0 = bf2f(z[(size_t)(tt - 1) * 768 + cq]); zk0 = bf2f(z[(size_t)(tt - 1) * 768 + ck]); }
      if (tt + 1 < seg_hi) { zq2 = bf2f(z[(size_t)(tt + 1) * 768 + cq]); zk2 = bf2f(z[(size_t)(tt + 1) * 768 + ck]); }
      float zq1 = bf2f(z[(size_t)tt * 768 + cq]), zk1 = bf2f(z[(size_t)tt * 768 + ck]);
      float vq = silu_f(wq0 * zq0 + wq1 * zq1 + wq2 * zq2);
      float vk = silu_f(wk0 * zk0 + wk1 * zk1 + wk2 * zk2);
      float s1 = wave_sum(vq * vq), s2 = wave_sum(vk * vk);
      sq[i * 65 + lane] = vq * rsqrtf(s1 + EPS) * 0.125f;
      sk[i * 65 + lane] = vk * rsqrtf(s2 + EPS);
    }
  }
  if (tid < 128) {
    const int dir = tid >> 6, i = tid & 63;
    const int tt = tt0 + i;
    const int li = dir ? 63 - i : i;
    float br = bd[(size_t)tt * 16 + dir * 4 + head];
    float ar = bd[(size_t)tt * 16 + 8 + dir * 4 + head];
    sbeta[dir * 64 + li] = 1.f / (1.f + expf(-br));
    float xx = ar + p.dt_bias[l * 8 + dir * 4 + head];
    float sp = fmaxf(xx, 0.f) + log1pf(expf(-fabsf(xx)));
    sg[dir * 64 + li] = -expf(p.A_log[l * 8 + dir * 4 + head]) * sp;
  }
  __syncthreads();
  if (tid == 0 || tid == 64) {
    const int dir = tid >> 6;
    float a = 0.f;
    for (int li = 0; li < 64; ++li) { a += sg[dir * 64 + li]; sgc[dir * 64 + li] = a; }
  }
  __syncthreads();

  {
    const int it = wave >> 1, jt = wave & 1;
    const int lr = lane & 31, lh = lane >> 5;
    f32x16 kk, qk;
#pragma unroll
    for (int r = 0; r < 16; ++r) { kk[r] = 0.f; qk[r] = 0.f; }
    const float* ki = sk + (32 * it + lr) * 65 + 8 * lh;
    const float* qi = sq + (32 * it + lr) * 65 + 8 * lh;
    const float* kj = sk + (32 * jt + lr) * 65 + 8 * lh;
#pragma unroll
    for (int ks = 0; ks < 4; ++ks) {
      bf16x8 fa = mk8u(pk2(ki[16 * ks], ki[16 * ks + 1]), pk2(ki[16 * ks + 2], ki[16 * ks + 3]), pk2(ki[16 * ks + 4], ki[16 * ks + 5]),
                       pk2(ki[16 * ks + 6], ki[16 * ks + 7]));
      bf16x8 fq = mk8u(pk2(qi[16 * ks], qi[16 * ks + 1]), pk2(qi[16 * ks + 2], qi[16 * ks + 3]), pk2(qi[16 * ks + 4], qi[16 * ks + 5]),
                       pk2(qi[16 * ks + 6], qi[16 * ks + 7]));
      bf16x8 fb = mk8u(pk2(kj[16 * ks], kj[16 * ks + 1]), pk2(kj[16 * ks + 2], kj[16 * ks + 3]), pk2(kj[16 * ks + 4], kj[16 * ks + 5]),
                       pk2(kj[16 * ks + 6], kj[16 * ks + 7]));
      kk = MFMA32(fa, fb, kk);
      qk = MFMA32(fq, fb, qk);
    }
    const int j = 32 * jt + lr;
#pragma unroll
    for (int dir = 0; dir < 2; ++dir) {
      u16* attn = tmp + dir * 16384;
      const int lj = dir ? 63 - j : j;
      const float gcj = sgc[dir * 64 + lj];
#pragma unroll
      for (int r = 0; r < 16; ++r) {
        const int i = 32 * it + (r & 3) + 8 * (r >> 2) + 4 * lh;
        const int li = dir ? 63 - i : i;
        const float dec = __expf(fminf(sgc[dir * 64 + li] - gcj, 0.f));
        const float Lv = (lj < li) ? sbeta[dir * 64 + li] * kk[r] * dec : 0.f;
        const float Av = (lj <= li) ? qk[r] * dec : 0.f;
        sL[dir * 4096 + li * 64 + lj] = Lv;
        attn[li * 64 + lj] = f2bf(Av);
      }
    }
  }
#pragma unroll
  for (int dir = 0; dir < 2; ++dir) {
    u16* kdT = tmp + dir * 16384 + 4096;
    {
      const int d = tid >> 2, lq = tid & 3;
      const float gl = sgc[dir * 64 + 63];
      unsigned o[8];
#pragma unroll
      for (int e = 0; e < 8; ++e) {
        const int li0 = lq * 16 + 2 * e, li1 = li0 + 1;
        const int i0 = dir ? 63 - li0 : li0, i1 = dir ? 63 - li1 : li1;
        float v0 = sk[i0 * 65 + d] * __expf(gl - sgc[dir * 64 + li0]);
        float v1 = sk[i1 * 65 + d] * __expf(gl - sgc[dir * 64 + li1]);
        o[e] = pk2(v0, v1);
      }
      *(uint4*)(kdT + d * 64 + lq * 16) = make_uint4(o[0], o[1], o[2], o[3]);
      *(uint4*)(kdT + d * 64 + lq * 16 + 8) = make_uint4(o[4], o[5], o[6], o[7]);
    }
    if (tid == 0) glast[unit * 2 + dir] = __expf(sgc[dir * 64 + 63]);
  }
  {
    const int cv = 512 + head * 64 + lane;
    const float w0 = cw[cv], w1 = cw[768 + cv], w2 = cw[1536 + cv];
#pragma unroll 8
    for (int i = wave; i < 64; i += 4) {
      const int tt = tt0 + i;
      float z0 = 0.f, z2 = 0.f;
      if (tt - 1 >= seg_lo) z0 = bf2f(z[(size_t)(tt - 1) * 768 + cv]);
      if (tt + 1 < seg_hi) z2 = bf2f(z[(size_t)(tt + 1) * 768 + cv]);
      float z1 = bf2f(z[(size_t)tt * 768 + cv]);
      sv[i * 72 + lane] = f2bf(silu_f(w0 * z0 + w1 * z1 + w2 * z2));
    }
  }
  __syncthreads();
  {
    const int dir = tid >> 7, col = tid & 127;
    const bool isv = col < 64;
    const int c6 = col & 63;
    float x[64];
    const char* src = isv ? (const char*)(sv + (dir ? 63 * 72 : 0) + c6) : (const char*)(sk + (dir ? 63 * 65 : 0) + c6);
    const int strideb = (isv ? 144 : 260) * (dir ? -1 : 1);
    dn_solve(sL + dir * 4096, sbeta + dir * 64, sgc + dir * 64, isv, src, strideb, x);
    u16* XT = tmp + dir * 16384 + 8192 + col * 64;
#pragma unroll
    for (int c = 0; c < 8; ++c)
      *(uint4*)(XT + 8 * c) = make_uint4(pk2(x[8 * c], x[8 * c + 1]), pk2(x[8 * c + 2], x[8 * c + 3]),
                                         pk2(x[8 * c + 4], x[8 * c + 5]), pk2(x[8 * c + 6], x[8 * c + 7]));
  }
  __threadfence_block();
  __syncthreads();
  {
    const int dir = wave >> 1, prod = wave & 1;
    const int lr = lane & 31, lh = lane >> 5;
    const u16* Aop = tmp + dir * 16384 + (prod ? 0 : 4096);
    const u16* XT = tmp + dir * 16384 + 8192;
    u16* dnd = dn + (size_t)dir * 5 * 4096;
    bf16x8 af[2][4];
#pragma unroll
    for (int mt = 0; mt < 2; ++mt)
#pragma unroll
      for (int ks = 0; ks < 4; ++ks) af[mt][ks] = *(const bf16x8*)(Aop + (mt * 32 + lr) * 64 + ks * 16 + lh * 8);
    {
      f32x16 acc[2][2];
#pragma unroll
      for (int a = 0; a < 2; ++a)
#pragma unroll
        for (int b = 0; b < 2; ++b)
#pragma unroll
          for (int i = 0; i < 16; ++i) acc[a][b][i] = 0.f;
#pragma unroll
      for (int nt = 0; nt < 2; ++nt)
#pragma unroll
        for (int ks = 0; ks < 4; ++ks) {
          bf16x8 b = *(const bf16x8*)(XT + (nt * 32 + lr) * 64 + ks * 16 + lh * 8);
          acc[0][nt] = MFMA32(af[0][ks], b, acc[0][nt]);
          acc[1][nt] = MFMA32(af[1][ks], b, acc[1][nt]);
        }
      u16* dst = dnd + (prod ? 3 : 1) * 4096;
#pragma unroll
      for (int mt = 0; mt < 2; ++mt)
#pragma unroll
        for (int nt = 0; nt < 2; ++nt)
#pragma unroll
          for (int g4 = 0; g4 < 4; ++g4) {
            uint2 o = {pk2(acc[mt][nt][4 * g4], acc[mt][nt][4 * g4 + 1]), pk2(acc[mt][nt][4 * g4 + 2], acc[mt][nt][4 * g4 + 3])};
            if (prod) {
              *(uint2*)(dst + (nt * 32 + lr) * 64 + mt * 32 + 8 * g4 + 4 * lh) = o;
            } else {
              const int dvv = nt * 32 + lr;
              const int mm = 2 * mt + (g4 >> 1), qq = 2 * (g4 & 1) + lh;
              *(uint2*)(dst + (((dvv >> 4) * 64 + qq * 16 + (dvv & 15)) * 4 + mm) * 4) = o;
            }
          }
    }
    {
      f32x16 acc[2][2];
#pragma unroll
      for (int a = 0; a < 2; ++a)
#pragma unroll
        for (int b = 0; b < 2; ++b)
#pragma unroll
          for (int i = 0; i < 16; ++i) acc[a][b][i] = 0.f;
#pragma unroll
      for (int mt = 0; mt < 2; ++mt)
#pragma unroll
        for (int ks = 0; ks < 4; ++ks) {
          bf16x8 a = *(const bf16x8*)(XT + (64 + mt * 32 + lr) * 64 + ks * 16 + lh * 8);
          acc[mt][0] = MFMA32(a, af[0][ks], acc[mt][0]);
          acc[mt][1] = MFMA32(a, af[1][ks], acc[mt][1]);
        }
      u16* dst = dnd + (prod ? 2 : 0) * 4096;
#pragma unroll
      for (int nt = 0; nt < 2; ++nt) {
        const int n = nt * 32 + lr;
        const int i = dir ? 63 - n : n;
        const float eg = __expf(sgc[dir * 64 + n]);
#pragma unroll
        for (int mt = 0; mt < 2; ++mt)
#pragma unroll
          for (int g4 = 0; g4 < 4; ++g4) {
            const int d0 = mt * 32 + 8 * g4 + 4 * lh;
            float v0 = acc[mt][nt][4 * g4], v1 = acc[mt][nt][4 * g4 + 1], v2 = acc[mt][nt][4 * g4 + 2], v3 = acc[mt][nt][4 * g4 + 3];
            if (prod) {
              v0 = sq[i * 65 + d0] * eg - v0;
              v1 = sq[i * 65 + d0 + 1] * eg - v1;
              v2 = sq[i * 65 + d0 + 2] * eg - v2;
              v3 = sq[i * 65 + d0 + 3] * eg - v3;
            }
            uint2 o = {pk2(v0, v1), pk2(v2, v3)};
            if (prod) {
              *(uint2*)(dst + n * 64 + d0) = o;
            } else {
              const int mm = n >> 4, cnn = n & 15, ss = mt, hif = g4 >> 1, qq = 2 * (g4 & 1) + lh;
              *(uint2*)(dst + ((mm * 2 + ss) * 64 + qq * 16 + cnn) * 8 + 4 * hif) = o;
            }
          }
      }
    }
  }
  __syncthreads();
}

DI void s5_coeffs(const Params& p, int l, int dir, int g, int pp, float& a_re, float& a_im, float* b_re, float* b_im) {
  const int gi = (l * 2 + dir) * 16 + g;
  const int idx = gi * 64 + pp;
  const float lr = p.A_re[idx], lim = p.A_im[idx];
  const float dt = expf(p.log_dt[gi]);
  const float mag = expf(lr * dt);
  const float ang = lim * dt;
  float sn, cs;
  sincosf(ang, &sn, &cs);
  a_re = mag * cs;
  a_im = mag * sn;
  const float nr = a_re - 1.f, ni = a_im;
  const float den = 1.f / (lr * lr + lim * lim);
  const float c_re = (nr * lr + ni * lim) * den;
  const float c_im = (ni * lr - nr * lim) * den;
  const float* Br = p.B_re + (size_t)idx * 16;
  const float* Bi = p.B_im + (size_t)idx * 16;
#pragma unroll
  for (int c = 0; c < 16; ++c) {
    float br = Br[c], bi = Bi[c];
    b_re[c] = c_re * br - c_im * bi;
    b_im[c] = c_re * bi + c_im * br;
  }
}


constexpr int S5_WAVE_LDS = 12800;
DI void s5_wave_sync() { asm volatile("s_waitcnt lgkmcnt(0)" ::: "memory"); }
DI void s5_bfrags(u16* sbw, const float* b_re, const float* b_im, int lane, bf16x8* bfrag) {
  *(uint4*)(sbw + lane * 32) = make_uint4(pk2(b_re[0], b_re[1]), pk2(b_re[2], b_re[3]), pk2(b_re[4], b_re[5]), pk2(b_re[6], b_re[7]));
  *(uint4*)(sbw + lane * 32 + 8) = make_uint4(pk2(b_re[8], b_re[9]), pk2(b_re[10], b_re[11]), pk2(b_re[12], b_re[13]), pk2(b_re[14], b_re[15]));
  *(uint4*)(sbw + lane * 32 + 16) = make_uint4(pk2(b_im[0], b_im[1]), pk2(b_im[2], b_im[3]), pk2(b_im[4], b_im[5]), pk2(b_im[6], b_im[7]));
  *(uint4*)(sbw + lane * 32 + 24) = make_uint4(pk2(b_im[8], b_im[9]), pk2(b_im[10], b_im[11]), pk2(b_im[12], b_im[13]), pk2(b_im[14], b_im[15]));
  s5_wave_sync();
  const int n = lane & 15, q4 = lane >> 4;
  const unsigned keep = (q4 < 2) ? 0xffffffffu : 0u;
#pragma unroll
  for (int nt = 0; nt < 8; ++nt) {
    const int state = 16 * (nt & 3) + n, part = nt >> 2;
    uint4 v = *(const uint4*)(sbw + state * 32 + part * 16 + 8 * (q4 & 1));
    bfrag[nt] = mk8u(v.x & keep, v.y & keep, v.z & keep, v.w & keep);
  }
}
DI void s5_bu_slab(const float* su, int wave, int dir, int s, int lane, const bf16x8* bfrag, u16* busw) {
  const int n = lane & 15, q4 = lane >> 4;
  const int li = 16 * s + n;
  const int i = dir ? 63 - li : li;
  const float* ur = su + i * 64 + wave * 16 + 8 * (q4 & 1);
  const float4 u0 = *(const float4*)ur, u1 = *(const float4*)(ur + 4);
  const unsigned keep = (q4 < 2) ? 0xffffffffu : 0u;
  const bf16x8 a = mk8u(pk2(u0.x, u0.y) & keep, pk2(u0.z, u0.w) & keep, pk2(u1.x, u1.y) & keep, pk2(u1.z, u1.w) & keep);
#pragma unroll
  for (int nt = 0; nt < 8; ++nt) {
    f32x4 acc = {0.f, 0.f, 0.f, 0.f};
    acc = MFMA16(a, bfrag[nt], acc);
    const int col = (nt >> 2) * 64 + 16 * (nt & 3) + n;
#pragma unroll
    for (int j = 0; j < 4; ++j) busw[(4 * q4 + j) * 136 + col] = f2bf(acc[j]);
  }
  s5_wave_sync();
}

DI void s5_a_item(const Params& p, int l, int item, char* smem) {
  const int quarter = item & 3, dir = (item >> 2) & 1, cid = item >> 3;
  const int tid = otid(), lane = tid & 63, wave = tid >> 6;
  const int g = quarter * 4 + wave;
  float* su = (float*)smem;
  const float* uC = (const float*)(p.ws + OFF_UC);
  for (int e = tid; e < 64 * 16; e += 256) {
    int i = e >> 4, c4 = e & 15;
    *(float4*)(su + i * 64 + c4 * 4) = *(const float4*)(uC + (size_t)(cid * 64 + i) * 256 + quarter * 64 + c4 * 4);
  }
  float a_re, a_im, b_re[16], b_im[16];
  s5_coeffs(p, l, dir, g, lane, a_re, a_im, b_re, b_im);
  u16* wl = (u16*)(smem + 16384 + wave * S5_WAVE_LDS);
  u16* busw = wl + 2176;
  u16* sbw = wl + 4352;
  bf16x8 bfrag[8];
  s5_bfrags(sbw, b_re, b_im, lane, bfrag);
  __syncthreads();
  float h_re = 0.f, h_im = 0.f;
  for (int s4 = 0; s4 < 4; ++s4) {
    s5_bu_slab(su, wave, dir, s4, lane, bfrag, busw);
#pragma unroll
    for (int r = 0; r < 16; ++r) {
      const float bu_re = bf2f(busw[r * 136 + lane]), bu_im = bf2f(busw[r * 136 + 64 + lane]);
      float nr = a_re * h_re - a_im * h_im + bu_re;
      float ni = a_re * h_im + a_im * h_re + bu_im;
      h_re = nr; h_im = ni;
    }
    s5_wave_sync();
  }
  float2* E = (float2*)(p.ws + OFF_S5E);
  E[((size_t)(cid * 2 + dir) * 16 + g) * 64 + lane] = make_float2(h_re, h_im);
  __syncthreads();
}

DI int chain_cid(int dir, int pos) { return dir == 0 ? pos : (pos < 4 ? 3 - pos : 263 - pos); }

DI void s5_carry(const Params& p, int l, int sblk) {
  const int id = sblk * 256 + otid();
  const int dir = id >> 10, g = (id >> 6) & 15, pp = id & 63;
  const int gi = (l * 2 + dir) * 16 + g;
  const float lr = p.A_re[gi * 64 + pp], lim = p.A_im[gi * 64 + pp];
  const float dt = expf(p.log_dt[gi]);
  const float mag = expf(lr * dt);
  float sn, cs;
  sincosf(lim * dt, &sn, &cs);
  float ar = mag * cs, ai = mag * sn;
#pragma unroll
  for (int i = 0; i < 6; ++i) { float nr = ar * ar - ai * ai, ni = 2.f * ar * ai; ar = nr; ai = ni; }
  const float2* E = (const float2*)(p.ws + OFF_S5E);
  float2* H = (float2*)(p.ws + OFF_S5H);
  float hr = 0.f, hi = 0.f;
  asm volatile("" : "+v"(hr), "+v"(hi));
  for (int pos0 = 0; pos0 < NCH; pos0 += 20) {
    float2 e[20];
    size_t o[20];
#pragma unroll
    for (int u = 0; u < 20; ++u) {
      int cid = chain_cid(dir, pos0 + u);
      o[u] = ((size_t)(cid * 2 + dir) * 16 + g) * 64 + pp;
      e[u] = E[o[u]];
    }
#pragma unroll
    for (int u = 0; u < 20; ++u) {
      H[o[u]] = make_float2(hr, hi);
      float nr = ar * hr - ai * hi + e[u].x;
      float ni = ar * hi + ai * hr + e[u].y;
      hr = nr; hi = ni;
    }
  }
}

DI void s5_c_item(const Params& p, int l, int item, char* smem) {
  const int quarter = item & 3, cid = item >> 2;
  const int tid = otid(), lane = tid & 63, wave = tid >> 6;
  const int g = quarter * 4 + wave;
  float* su = (float*)smem;
  u16* hs = (u16*)(smem + 16384 + wave * S5_WAVE_LDS);
  u16* busw = hs + 2176;
  u16* sbw = hs + 4352;
  const float* uC = (const float*)(p.ws + OFF_UC);
  const float2* Hin = (const float2*)(p.ws + OFF_S5H);
  u16* zg = (u16*)(p.ws + OFF_QB);
  for (int e = tid; e < 64 * 16; e += 256) {
    int i = e >> 4, c4 = e & 15;
    *(float4*)(su + i * 64 + c4 * 4) = *(const float4*)(uC + (size_t)(cid * 64 + i) * 256 + quarter * 64 + c4 * 4);
  }
  __syncthreads();
  const int cc = lane & 15, q4 = lane >> 4;
  f32x4 yacc[4];
#pragma unroll
  for (int t = 0; t < 4; ++t) yacc[t] = (f32x4){0.f, 0.f, 0.f, 0.f};
#pragma unroll
  for (int dir = 0; dir < 2; ++dir) {
    float a_re, a_im, b_re[16], b_im[16];
    s5_coeffs(p, l, dir, g, lane, a_re, a_im, b_re, b_im);
    bf16x8 cf[4];
    {
      const size_t cb = ((size_t)((l * 2 + dir) * 16 + g) * 16 + cc) * 64;
#pragma unroll
      for (int s = 0; s < 4; ++s) {
        const float* src = (s < 2 ? p.C_re : p.C_im) + cb + 32 * (s & 1) + 8 * q4;
        const float sgn = (s < 2) ? 1.f : -1.f;
        float4 v0 = *(const float4*)src, v1 = *(const float4*)(src + 4);
        cf[s] = mk8u(pk2(sgn * v0.x, sgn * v0.y), pk2(sgn * v0.z, sgn * v0.w), pk2(sgn * v1.x, sgn * v1.y),
                     pk2(sgn * v1.z, sgn * v1.w));
      }
    }
    bf16x8 bfrag[8];
    s5_bfrags(sbw, b_re, b_im, lane, bfrag);
    float2 h0 = Hin[((size_t)(cid * 2 + dir) * 16 + g) * 64 + lane];
    float h_re = h0.x, h_im = h0.y;
#pragma unroll
    for (int s = 0; s < 4; ++s) {
      s5_bu_slab(su, wave, dir, s, lane, bfrag, busw);
#pragma unroll
      for (int r = 0; r < 16; ++r) {
        const float bu_re = bf2f(busw[r * 136 + lane]), bu_im = bf2f(busw[r * 136 + 64 + lane]);
        float nr = a_re * h_re - a_im * h_im + bu_re;
        float ni = a_re * h_im + a_im * h_re + bu_im;
        h_re = nr; h_im = ni;
        const int rr = dir ? 15 - r : r;
        hs[rr * 136 + lane] = f2bf(h_re);
        hs[rr * 136 + 64 + lane] = f2bf(h_im);
      }
      asm volatile("s_waitcnt lgkmcnt(0)" ::: "memory");
      const int tile = dir ? 3 - s : s;
#pragma unroll
      for (int ks = 0; ks < 4; ++ks) {
        bf16x8 a = *(const bf16x8*)(hs + cc * 136 + 32 * ks + 8 * q4);
        yacc[tile] = MFMA16(a, cf[ks], yacc[tile]);
      }
      asm volatile("s_waitcnt lgkmcnt(0)" ::: "memory");
    }
  }
  const int ch = g * 16 + cc;
  const float dsk = p.Dskip[l * 256 + ch];
#pragma unroll
  for (int tile = 0; tile < 4; ++tile)
#pragma unroll
    for (int j = 0; j < 4; ++j) {
      const int t = 16 * tile + 4 * q4 + j;
      float y = yacc[tile][j] + su[t * 64 + wave * 16 + cc] * dsk;
      zg[(size_t)(cid * 64 + t) * 256 + ch] = f2bf(gelu_tanh(y));
    }
  __syncthreads();
}

DI void dn_out_item(const Params& p, int l, int unit, char* smem) {
  const int cid = unit >> 2, head = unit & 3;
  const int tid = otid(), lane = tid & 63, wave = tid >> 6;
  const int lr = lane & 31, lh = lane >> 5;
  float* so = (float*)smem;
  const u16* gates = (const u16*)(p.ws + OFF_GATES);
  u16* mix = (u16*)(p.ws + OFF_H);
  const int dir = wave >> 1, mt = wave & 1;
  const u16* dnd = (const u16*)(p.ws + OFF_DN) + ((size_t)unit * 2 + dir) * 5 * 4096;
  const u16* Pm = dnd + 2 * 4096, *RT = dnd + 3 * 4096, *ST = dnd + 4 * 4096;
  f32x16 acc[2];
#pragma unroll
  for (int nt = 0; nt < 2; ++nt)
#pragma unroll
    for (int i = 0; i < 16; ++i) acc[nt][i] = 0.f;
#pragma unroll
  for (int ks = 0; ks < 4; ++ks) {
    bf16x8 a = *(const bf16x8*)(Pm + (mt * 32 + lr) * 64 + ks * 16 + lh * 8);
#pragma unroll
    for (int nt = 0; nt < 2; ++nt) {
      bf16x8 b = *(const bf16x8*)(ST + (nt * 32 + lr) * 64 + ks * 16 + lh * 8);
      acc[nt] = MFMA32(a, b, acc[nt]);
    }
  }
#pragma unroll
  for (int nt = 0; nt < 2; ++nt)
#pragma unroll
    for (int g4 = 0; g4 < 4; ++g4) {
      uint2 rr = *(const uint2*)(RT + (nt * 32 + lr) * 64 + mt * 32 + 8 * g4 + 4 * lh);
      acc[nt][4 * g4 + 0] += bf2f((u16)(rr.x & 0xffff));
      acc[nt][4 * g4 + 1] += bf2f((u16)(rr.x >> 16));
      acc[nt][4 * g4 + 2] += bf2f((u16)(rr.y & 0xffff));
      acc[nt][4 * g4 + 3] += bf2f((u16)(rr.y >> 16));
    }
  if (dir == 0) {
#pragma unroll
    for (int nt = 0; nt < 2; ++nt)
#pragma unroll
      for (int i = 0; i < 16; ++i) {
        const int li = mt * 32 + (i & 3) + 8 * (i >> 2) + 4 * lh;
        so[li * 65 + nt * 32 + lr] = acc[nt][i];
      }
  }
  __syncthreads();
  if (dir == 1) {
#pragma unroll
    for (int nt = 0; nt < 2; ++nt)
#pragma unroll
      for (int i = 0; i < 16; ++i) {
        const int li = mt * 32 + (i & 3) + 8 * (i >> 2) + 4 * lh;
        so[(63 - li) * 65 + nt * 32 + lr] += acc[nt][i];
      }
  }
  __syncthreads();
  const float gain = p.out_gain[l * 64 + lane];
#pragma unroll
  for (int i0 = 0; i0 < 16; ++i0) {
    const int i = wave + 4 * i0;
    const size_t tt = (size_t)cid * 64 + i;
    const int c = head * 64 + lane;
    float o = so[i * 65 + lane];
    float ms = wave_sum(o * o) * (1.f / 64.f);
    float v = o * rsqrtf(ms + EPS) * gain * bf2f(gates[tt * 1024 + 512 + c]);
    mix[tt * 1024 + 512 + c] = f2bf(v);
  }
  __syncthreads();
}

#define SCAN_LOAD(U, POS)                                                                      \
  {                                                                                            \
    const int cid_ = chain_cid(dir, (POS));                                                    \
    const u16* base_ = dnb + ((size_t)(cid_ * 4 + head) * 2 + dir) * 5 * 4096;                 \
    _Pragma("unroll") for (int m = 0; m < 4; ++m) {                                            \
      _Pragma("unroll") for (int s2 = 0; s2 < 2; ++s2) {                                       \
        const uint4 t_ = *(const uint4*)(base_ + ((m * 2 + s2) * 64 + lane) * 8);              \
        mlo##U[m][s2] = make_uint2(t_.x, t_.y);                                                \
        mhi##U[m][s2] = make_uint2(t_.z, t_.w);                                                \
      }                                                                                        \
    }                                                                                          \
    {                                                                                          \
      const uint4 t0_ = *(const uint4*)(base_ + 4096 + (cgp * 64 + lane) * 16);                \
      const uint4 t1_ = *(const uint4*)(base_ + 4096 + (cgp * 64 + lane) * 16 + 8);            \
      ntv##U[0] = make_uint2(t0_.x, t0_.y); ntv##U[1] = make_uint2(t0_.z, t0_.w);              \
      ntv##U[2] = make_uint2(t1_.x, t1_.y); ntv##U[3] = make_uint2(t1_.z, t1_.w);              \
    }                                                                                          \
    gl##U = glast[(cid_ * 4 + head) * 2 + dir];                                                \
  }
#define SCAN_COMPUTE(U, POS)                                                                   \
  {                                                                                            \
    const int cid_ = chain_cid(dir, (POS));                                                    \
    u16* STp_ = dnb + (((size_t)(cid_ * 4 + head) * 2 + dir) * 5 + 4) * 4096 + dv * 64 + 4 * q4; \
    unsigned pk_[4][2];                                                                        \
    _Pragma("unroll") for (int m = 0; m < 4; ++m) {                                            \
      pk_[m][0] = pk2(S[m][0], S[m][1]);                                                       \
      pk_[m][1] = pk2(S[m][2], S[m][3]);                                                       \
      *(uint2*)(STp_ + 16 * m) = make_uint2(pk_[m][0], pk_[m][1]);                             \
    }                                                                                          \
    bf16x8 sb0_ = mk8u(pk_[0][0], pk_[0][1], pk_[1][0], pk_[1][1]);                            \
    bf16x8 sb1_ = mk8u(pk_[2][0], pk_[2][1], pk_[3][0], pk_[3][1]);                            \
    _Pragma("unroll") for (int m = 0; m < 4; ++m) {                                            \
      f32x4 acc_ = {0.f, 0.f, 0.f, 0.f};                                                       \
      acc_ = MFMA16(mk8(mlo##U[m][0], mhi##U[m][0]), sb0_, acc_);                              \
      acc_ = MFMA16(mk8(mlo##U[m][1], mhi##U[m][1]), sb1_, acc_);                              \
      S[m][0] = gl##U * S[m][0] - acc_[0] + bf2f((u16)(ntv##U[m].x & 0xffff));                 \
      S[m][1] = gl##U * S[m][1] - acc_[1] + bf2f((u16)(ntv##U[m].x >> 16));                    \
      S[m][2] = gl##U * S[m][2] - acc_[2] + bf2f((u16)(ntv##U[m].y & 0xffff));                 \
      S[m][3] = gl##U * S[m][3] - acc_[3] + bf2f((u16)(ntv##U[m].y >> 16));                    \
    }                                                                                          \
  }
DI void dn_scan_wave(const Params& p, int task) {
  const int head = task & 3, dir = (task >> 2) & 1, cgp = task >> 3;
  const int lane = otid() & 63;
  const int cn = lane & 15, q4 = lane >> 4;
  const int dv = cgp * 16 + cn;
  u16* dnb = (u16*)(p.ws + OFF_DN);
  const float* glast = (const float*)(p.ws + OFF_GLAST);
  f32x4 S[4];
#pragma unroll
  for (int m = 0; m < 4; ++m) S[m] = (f32x4){0.f, 0.f, 0.f, 0.f};
  uint2 mlo0[4][2], mhi0[4][2], ntv0[4]; float gl0;
  uint2 mlo1[4][2], mhi1[4][2], ntv1[4]; float gl1;
  uint2 mlo2[4][2], mhi2[4][2], ntv2[4]; float gl2;
  uint2 mlo3[4][2], mhi3[4][2], ntv3[4]; float gl3;
  SCAN_LOAD(0, 0) SCAN_LOAD(1, 1) SCAN_LOAD(2, 2) SCAN_LOAD(3, 3)
  for (int pos0 = 0; pos0 < NCH; pos0 += 4) {
    const bool more = pos0 + 4 < NCH;
    SCAN_COMPUTE(0, pos0) if (more) SCAN_LOAD(0, pos0 + 4)
    SCAN_COMPUTE(1, pos0 + 1) if (more) SCAN_LOAD(1, pos0 + 5)
    SCAN_COMPUTE(2, pos0 + 2) if (more) SCAN_LOAD(2, pos0 + 6)
    SCAN_COMPUTE(3, pos0 + 3) if (more) SCAN_LOAD(3, pos0 + 7)
  }
}

constexpr int A_LD = 72;
constexpr int V_LD = 136;
DI void attn_item(const Params& p, int item, char* smem) {
  int head, q0, ntiles;
  if (item < 512) { head = item & 7; q0 = NCTX + (item >> 3) * 256; ntiles = NCH; }
  else { head = item - 512; q0 = 0; ntiles = 4; }
  const int kvh = head >> 2;
  const int tid = otid(), lane = tid & 63, wave = tid >> 6;
  const int lr = lane & 31, lh = lane >> 5;
  const u16* Qb = (const u16*)(p.ws + OFF_QB) + (size_t)head * T * 64;
  const u16* Kb = (const u16*)(p.ws + OFF_KB) + (size_t)kvh * T * 64;
  const u16* Vt = (const u16*)(p.ws + OFF_VT) + (size_t)kvh * 64 * T;
  u16* Ks = (u16*)smem;
  u16* Vs = Ks + 2 * 128 * A_LD;
  bf16x8 qf[2][4];
#pragma unroll
  for (int qt = 0; qt < 2; ++qt)
#pragma unroll
    for (int ks = 0; ks < 4; ++ks)
      qf[qt][ks] = *(const bf16x8*)(Qb + (size_t)(q0 + wave * 64 + qt * 32 + lr) * 64 + ks * 16 + lh * 8);

  f32x16 ot[2][2];
#pragma unroll
  for (int a = 0; a < 2; ++a)
#pragma unroll
    for (int b = 0; b < 2; ++b)
#pragma unroll
      for (int i = 0; i < 16; ++i) ot[a][b][i] = 0.f;
  float lrun[2] = {0.f, 0.f};

  uint4 rk0, rk1, rv0, rv1;
  const int srow = tid >> 3, sch = tid & 7;
  const u16* Kg = Kb + (size_t)srow * 64 + sch * 8;
  const u16* Vg = Vt + (size_t)srow * T + sch * 8;
#define A_LOAD(J_)                                                               \
  {                                                                              \
    const u16* kg_ = Kg + (size_t)(J_) * 4096;                                   \
    const u16* vg_ = Vg + (size_t)(J_) * 64;                                     \
    rk0 = *(const uint4*)(kg_);  rk1 = *(const uint4*)(kg_ + 32 * 64);           \
    rv0 = *(const uint4*)(vg_);  rv1 = *(const uint4*)(vg_ + (size_t)32 * T);    \
  }
#define A_STORE(BUF_, HALF_)                                                     \
  {                                                                              \
    u16* ks_ = Ks + ((BUF_) * 128 + (HALF_) * 64 + srow) * A_LD + sch * 8;       \
    u16* vs_ = Vs + ((BUF_) * 64 + srow) * V_LD + (HALF_) * 64 + sch * 8;        \
    *(uint4*)(ks_) = rk0;  *(uint4*)(ks_ + 32 * A_LD) = rk1;                     \
    *(uint4*)(vs_) = rv0;  *(uint4*)(vs_ + 32 * V_LD) = rv1;                     \
  }
  A_LOAD(0)
  A_STORE(0, 0)
  A_LOAD(1)
  A_STORE(0, 1)
  __syncthreads();
  const int npairs = ntiles >> 1;
  for (int jj = 0; jj < npairs; ++jj) {
    const int buf = jj & 1;
    const int jnext = (jj + 1 < npairs ? jj + 1 : jj) * 2;
#pragma unroll 1
    for (int half = 0; half < 2; ++half) {
    A_LOAD(jnext + half)
    __builtin_amdgcn_sched_barrier(0);
    const u16* Kt = Ks + (buf * 128 + half * 64) * A_LD;
    const u16* Vtile = Vs + buf * 64 * V_LD + half * 64;
    f32x16 st[2][2];
#pragma unroll
    for (int a = 0; a < 2; ++a)
#pragma unroll
      for (int b = 0; b < 2; ++b)
#pragma unroll
        for (int i = 0; i < 16; ++i) st[a][b][i] = 0.f;
    {
      bf16x8 kf[2][4];
#pragma unroll
      for (int kt = 0; kt < 2; ++kt)
#pragma unroll
        for (int ks = 0; ks < 4; ++ks) kf[kt][ks] = *(const bf16x8*)(Kt + (kt * 32 + lr) * A_LD + ks * 16 + lh * 8);
      __builtin_amdgcn_sched_barrier(0);
#pragma unroll
      for (int kt = 0; kt < 2; ++kt)
#pragma unroll
        for (int ks = 0; ks < 4; ++ks) {
          st[kt][0] = MFMA32(kf[kt][ks], qf[0][ks], st[kt][0]);
          st[kt][1] = MFMA32(kf[kt][ks], qf[1][ks], st[kt][1]);
        }
    }
#pragma unroll
    for (int kt = 0; kt < 2; ++kt) {
#pragma unroll
      for (int qt = 0; qt < 2; ++qt) {
        float ls0 = 0.f, ls1 = 0.f;
#pragma unroll
        for (int i = 0; i < 16; i += 2) {
          float p0 = __builtin_amdgcn_exp2f(st[kt][qt][i]);
          float p1 = __builtin_amdgcn_exp2f(st[kt][qt][i + 1]);
          st[kt][qt][i] = p0;
          st[kt][qt][i + 1] = p1;
          ls0 += p0;
          ls1 += p1;
        }
        lrun[qt] += ls0 + ls1;
      }
#pragma unroll
      for (int ss = 0; ss < 2; ++ss) {
        bf16x8 pb[2];
#pragma unroll
        for (int qt = 0; qt < 2; ++qt)
          pb[qt] = mk8u(pk2(st[kt][qt][8 * ss + 0], st[kt][qt][8 * ss + 1]), pk2(st[kt][qt][8 * ss + 2], st[kt][qt][8 * ss + 3]),
                        pk2(st[kt][qt][8 * ss + 4], st[kt][qt][8 * ss + 5]), pk2(st[kt][qt][8 * ss + 6], st[kt][qt][8 * ss + 7]));
#pragma unroll
        for (int dt = 0; dt < 2; ++dt) {
          const u16* pr = Vtile + (dt * 32 + lr) * V_LD + 32 * kt + 16 * ss + 4 * lh;
          uint2 lo = *(const uint2*)pr;
          uint2 hi = *(const uint2*)(pr + 8);
          bf16x8 a = mk8(lo, hi);
#pragma unroll
          for (int qt = 0; qt < 2; ++qt) ot[dt][qt] = MFMA32(a, pb[qt], ot[dt][qt]);
        }
      }
    }
    __builtin_amdgcn_sched_barrier(0);
    A_STORE(buf ^ 1, half)
    }
    __syncthreads();
  }
  const u16* gates = (const u16*)(p.ws + OFF_GATES);
  u16* mix = (u16*)(p.ws + OFF_H);
#pragma unroll
  for (int qt = 0; qt < 2; ++qt) {
    const float lt = lrun[qt] + __shfl_xor(lrun[qt], 32);
    const float inv = 1.f / lt;
    const size_t row = (size_t)(q0 + wave * 64 + qt * 32 + lr);
#pragma unroll
    for (int dt = 0; dt < 2; ++dt)
#pragma unroll
      for (int g4 = 0; g4 < 4; ++g4) {
        const int d0 = 32 * dt + 8 * g4 + 4 * lh;
        uint2 gg = *(const uint2*)(gates + row * 1024 + head * 64 + d0);
        float o0 = ot[dt][qt][4 * g4 + 0] * inv * bf2f((u16)(gg.x & 0xffff));
        float o1 = ot[dt][qt][4 * g4 + 1] * inv * bf2f((u16)(gg.x >> 16));
        float o2 = ot[dt][qt][4 * g4 + 2] * inv * bf2f((u16)(gg.y & 0xffff));
        float o3 = ot[dt][qt][4 * g4 + 3] * inv * bf2f((u16)(gg.y >> 16));
        uint2 o = {pk2(o0, o1), pk2(o2, o3)};
        *(uint2*)(mix + row * 1024 + head * 64 + d0) = o;
      }
  }
}

DI void final_ln_phase(const Params& p, int l, const float* ctx_src, const float* lat_src) {
  const int lane = otid() & 63, wave = otid() >> 6;
  const int nw = gridDim.x * 4;
  const float* y = (const float*)(p.ws + OFF_DN);
  const float* modv = (const float*)(p.ws + OFF_MODV);
  float* ctx1 = (float*)(p.ws + OFF_CTX1);
  u16* h = (u16*)(p.ws + OFF_H);
  const int rstart = (l == 1) ? NCTX : 0;
  for (int r = rstart + blockIdx.x * 4 + wave; r < T; r += nw) {
    const bool isc = r < NCTX;
    const float* src = isc ? ctx_src + (size_t)r * DM : lat_src + (size_t)(r - NCTX) * DM;
    float* dst = isc ? ctx1 + (size_t)r * DM : p.out + (size_t)(r - NCTX) * DM;
    const float* mod = modv + (l * 2 + (isc ? 1 : 0)) * 3072;
    float4 v[4];
    float s = 0.f;
#pragma unroll
    for (int i = 0; i < 4; ++i) {
      int c0 = (i * 64 + lane) * 4;
      float4 xv = *(const float4*)(src + c0);
      float4 yv = *(const float4*)(y + (size_t)r * DM + c0);
      float4 gv = *(const float4*)(mod + 2048 + c0);
      v[i].x = DN_ALPHA * xv.x + gv.x * yv.x;
      v[i].y = DN_ALPHA * xv.y + gv.y * yv.y;
      v[i].z = DN_ALPHA * xv.z + gv.z * yv.z;
      v[i].w = DN_ALPHA * xv.w + gv.w * yv.w;
      s += v[i].x + v[i].y + v[i].z + v[i].w;
    }
    float mu = wave_sum(s) * (1.f / DM);
    float q = 0.f;
#pragma unroll
    for (int i = 0; i < 4; ++i) {
      v[i].x -= mu; v[i].y -= mu; v[i].z -= mu; v[i].w -= mu;
      q += v[i].x * v[i].x + v[i].y * v[i].y + v[i].z * v[i].z + v[i].w * v[i].w;
    }
    float rstd = rsqrtf(wave_sum(q) * (1.f / DM) + EPS);
    float s2 = 0.f;
#pragma unroll
    for (int i = 0; i < 4; ++i) {
      int c0 = (i * 64 + lane) * 4;
      float4 g = *(const float4*)(p.ln_g + l * DM + c0);
      float4 b = *(const float4*)(p.ln_b + l * DM + c0);
      v[i].x = v[i].x * rstd * g.x + b.x;
      v[i].y = v[i].y * rstd * g.y + b.y;
      v[i].z = v[i].z * rstd * g.z + b.z;
      v[i].w = v[i].w * rstd * g.w + b.w;
      *(float4*)(dst + c0) = v[i];
      s2 += v[i].x + v[i].y + v[i].z + v[i].w;
    }
    if (l == 0) {
      const float* mod1 = modv + (2 + (isc ? 1 : 0)) * 3072;
      float mu2 = wave_sum(s2) * (1.f / DM);
      float q2 = 0.f;
#pragma unroll
      for (int i = 0; i < 4; ++i) {
        v[i].x -= mu2; v[i].y -= mu2; v[i].z -= mu2; v[i].w -= mu2;
        q2 += v[i].x * v[i].x + v[i].y * v[i].y + v[i].z * v[i].z + v[i].w * v[i].w;
      }
      float rstd2 = rsqrtf(wave_sum(q2) * (1.f / DM) + EPS);
#pragma unroll
      for (int i = 0; i < 4; ++i) {
        int c0 = (i * 64 + lane) * 4;
        float4 sh = *(const float4*)(mod1 + c0);
        float4 sc = *(const float4*)(mod1 + 1024 + c0);
        float o0 = v[i].x * rstd2 * (1.f + sc.x) + sh.x;
        float o1 = v[i].y * rstd2 * (1.f + sc.y) + sh.y;
        float o2 = v[i].z * rstd2 * (1.f + sc.z) + sh.z;
        float o3 = v[i].w * rstd2 * (1.f + sc.w) + sh.w;
        uint2 pk = {pk2(o0, o1), pk2(o2, o3)};
        *(uint2*)(h + (size_t)r * DM + c0) = pk;
      }
    }
  }
}

#ifndef REP_ATTN
#define REP_ATTN 1
#endif
#ifndef REP_SCAN
#define REP_SCAN 1
#endif
#ifndef REP_GEMM
#define REP_GEMM 1
#endif
#ifndef REP_PREP
#define REP_PREP 1
#endif
#ifndef REP_P5
#define REP_P5 1
#endif
typedef const __attribute__((address_space(4))) Params* KParamsPtr;
DI const Params& kp() {
  KParamsPtr q = (KParamsPtr)__builtin_amdgcn_kernarg_segment_ptr();
  asm volatile("" : "+s"(q));
  return *(const Params*)q;
}
__global__ void __launch_bounds__(256, 2) fwd_megakernel(Params pin) {
  cg::grid_group grid = cg::this_grid();
  __shared__ __attribute__((aligned(16))) char smem[SMEM_BYTES];
  const int nb = gridDim.x;
  __shared__ uint4 xb_words;
  if (threadIdx.x == 0) xb_words = make_uint4(0u, 0u, 0u, 0u);
  __syncthreads();
  (void)xcd_barrier_post((unsigned*)(kp().ws + OFF_BAR), (volatile LAS unsigned*)&xb_words);
#define GRID_BARRIER() do { XcdBarrier xb_; xb_.bar = (unsigned*)(kp().ws + OFF_BAR); xb_.x = xb_xcc_id(); xb_.st = (volatile LAS unsigned*)&xb_words; xcd_barrier(xb_); } while (0)

  if (kp().ws == nullptr) grid.sync();
  setup_phase(kp(), smem);
  GRID_BARRIER();
  { const Params& p = kp(); ln_mod_phase(p, p.ctx, p.x, 0); }
  GRID_BARRIER();

  for (int l = 0; l < 2; ++l) {
    for (int rep = 0; rep < REP_GEMM; ++rep) gemm_in_phase(kp(), l, smem);
    GRID_BARRIER();
    {
      const int nx = (nb > 64 && nb < 1040) ? (1040 % nb) : 0;
      for (int item = blockIdx.x; item < 1040; item += nb) dn_prep_item(kp(), l, item, smem);
      if ((int)blockIdx.x >= nx)
        for (int item = (int)blockIdx.x - nx; item < 2080; item += nb - nx) s5_a_item(kp(), l, item, smem);
    }
    GRID_BARRIER();
    for (int rep = 0; rep < REP_SCAN; ++rep)
    for (int item = blockIdx.x; item < 40; item += nb) {
      if (item < 32) { if ((otid() >> 6) == 0) dn_scan_wave(kp(), item); }
      else s5_carry(kp(), l, item - 32);
    }
    GRID_BARRIER();
    {
      const int nattn = (l == 1) ? 512 : 520;
      for (int rep = 0; rep < REP_ATTN; ++rep)
        for (int item = blockIdx.x; item < nattn; item += nb) attn_item(kp(), item, smem);
    }
    GRID_BARRIER();
    {
      const int skip = (l == 1) ? 16 : 0;
      const int nper = 1040 - skip;
      for (int rep = 0; rep < REP_P5; ++rep)
      for (int item = blockIdx.x; item < 2 * nper; item += nb) {
        if (item < nper) s5_c_item(kp(), l, item + skip, smem);
        else dn_out_item(kp(), l, item - nper + skip, smem);
      }
    }
    GRID_BARRIER();
    gemm_glu_phase(kp(), l, smem);
    GRID_BARRIER();
    gemm_out_phase(kp(), l, smem);
    GRID_BARRIER();
    {
      const Params& p = kp();
      if (l == 0) final_ln_phase(p, 0, p.ctx, p.x);
      else final_ln_phase(p, 1, (const float*)(p.ws + OFF_CTX1), p.out);
    }
    if (l == 0) GRID_BARRIER();
  }
}

extern "C" void kernel_launch(void* const* d_in, const int* in_sizes, int n_in, void* d_out, int out_size, void* d_ws,
                              size_t ws_size, hipStream_t stream) {
  static int grid_blocks = 0;
  if (!grid_blocks) {
    int dev = 0, cus = 0, per_cu = 0;
    hipGetDevice(&dev);
    hipDeviceGetAttribute(&cus, hipDeviceAttributeMultiprocessorCount, dev);
    hipOccupancyMaxActiveBlocksPerMultiprocessor(&per_cu, fwd_megakernel, 256, 0);
    if (per_cu > 2) per_cu = 2;
    if (per_cu < 1) per_cu = 1;
    grid_blocks = cus * per_cu;
  }
  Params p{};
  const float** pp = (const float**)&p;
  for (int i = 0; i < 26; ++i) pp[i] = (const float*)d_in[i];
  p.out = (float*)d_out;
  p.ws = (char*)d_ws;
  void* args[] = {&p};
  (void)hipMemsetAsync((char*)d_ws + OFF_BAR, 0, XCD_BAR_WORDS * 4, stream);
  hipError_t e = hipLaunchCooperativeKernel((void*)fwd_megakernel, dim3(grid_blocks), dim3(256), args, 0, stream);
  if (e != hipSuccess) fprintf(stderr, "cooperative launch failed: %s (grid %d)\n", hipGetErrorString(e), grid_blocks);
}
```

```cpp
#include <hip/hip_runtime.h>
#include <hip/hip_cooperative_groups.h>
#include <cstdio>
namespace cg = cooperative_groups;

#define DI __device__ __forceinline__
typedef unsigned short u16;
using bf16x8 = __attribute__((ext_vector_type(8))) short;
using f32x16 = __attribute__((ext_vector_type(16))) float;
using f32x4 = __attribute__((ext_vector_type(4))) float;
typedef __bf16 bf2_t __attribute__((ext_vector_type(2)));
typedef float f2_t __attribute__((ext_vector_type(2)));

#define MFMA32(a, b, c) __builtin_amdgcn_mfma_f32_32x32x16_bf16((a), (b), (c), 0, 0, 0)
#define MFMA16(a, b, c) __builtin_amdgcn_mfma_f32_16x16x32_bf16((a), (b), (c), 0, 0, 0)

constexpr int T = 16640;
constexpr int NCTX = 256;
constexpr int DM = 1024;
constexpr int NIN = 2832;
constexpr int NINP = 2944;
constexpr int NCH = 260;
constexpr float EPS = 1e-6f;
constexpr float DN_ALPHA = 1.4142135623730951f;

constexpr size_t al256(size_t x) { return (x + 255) & ~(size_t)255; }
constexpr size_t OFF_WINT = 0;
constexpr size_t OFF_WOUTT = OFF_WINT + al256((size_t)2 * NINP * 1024 * 2);
constexpr size_t OFF_GLUWT = OFF_WOUTT + al256((size_t)2 * 1024 * 1024 * 2);
constexpr size_t OFF_MODV = OFF_GLUWT + al256((size_t)2 * 256 * 256 * 2);
constexpr size_t OFF_ROPE = OFF_MODV + al256((size_t)2 * 2 * 3072 * 4);
constexpr size_t OFF_H = OFF_ROPE + al256((size_t)256 * 16 * 2 * 4);
constexpr size_t OFF_QB = OFF_H + al256((size_t)T * 1024 * 2);
constexpr size_t OFF_KB = OFF_QB + al256((size_t)8 * T * 64 * 2);
constexpr size_t OFF_VT = OFF_KB + al256((size_t)2 * T * 64 * 2);
constexpr size_t OFF_GATES = OFF_VT + al256((size_t)2 * T * 64 * 2);
constexpr size_t OFF_QKVB = OFF_GATES + al256((size_t)T * 1024 * 2);
constexpr size_t OFF_UC = OFF_QKVB + al256((size_t)T * 768 * 2);
constexpr size_t OFF_BD = OFF_UC + al256((size_t)T * 256 * 4);
constexpr size_t OFF_DN = OFF_BD + al256((size_t)T * 16 * 4);
constexpr size_t OFF_GLAST = OFF_DN + al256((size_t)1040 * 2 * 5 * 4096 * 2);
constexpr size_t OFF_S5E = OFF_GLAST + al256((size_t)1040 * 2 * 4);
constexpr size_t OFF_S5H = OFF_S5E + al256((size_t)NCH * 2 * 16 * 64 * 2 * 4);
constexpr size_t OFF_CTX1 = OFF_S5H + al256((size_t)NCH * 2 * 16 * 64 * 2 * 4);
constexpr size_t OFF_BAR = OFF_CTX1 + al256((size_t)256 * 1024 * 4);
constexpr size_t WS_TOTAL = OFF_BAR + 16384;
static_assert(WS_TOTAL <= (size_t)256 * 1024 * 1024, "workspace too large");
static_assert((size_t)T * 1024 * 4 <= (size_t)1040 * 2 * 5 * 4096 * 2, "y alias");

struct Params {
  const float *x, *c, *ctx, *c_ctx, *w_mod, *b_mod, *w_in, *qg, *kg, *conv_w, *A_log, *dt_bias, *out_gain,
      *A_re, *A_im, *log_dt, *B_re, *B_im, *C_re, *C_im, *Dskip, *glu_w, *glu_b, *w_out, *ln_g, *ln_b;
  float* out;
  char* ws;
};

constexpr int SMEM_BYTES = 75 * 1024;

DI float bf2f(u16 v) { return __uint_as_float(((unsigned)v) << 16); }
DI unsigned pk2(float a, float b) {
  f2_t v = {a, b};
  bf2_t r = __builtin_convertvector(v, bf2_t);
  return __builtin_bit_cast(unsigned, r);
}
DI u16 f2bf(float a) { return (u16)(pk2(a, 0.f) & 0xffffu); }
DI float silu_f(float x) { return x / (1.f + __expf(-x)); }
DI float sigmoid_f(float x) { return 1.f / (1.f + __expf(-x)); }
template <int CTRL>
DI float dppf(float v) {
  return __builtin_bit_cast(float, __builtin_amdgcn_update_dpp(0, __builtin_bit_cast(int, v), CTRL, 0xf, 0xf, true));
}
DI float wave_sum(float v) {
  v += dppf<0xB1>(v);
  v += dppf<0x4E>(v);
  v += dppf<0x141>(v);
  v += dppf<0x140>(v);
  v += __shfl_xor(v, 16);
  v += __shfl_xor(v, 32);
  return v;
}
DI int otid() { int t = threadIdx.x; asm volatile("" : "+v"(t)); return t; }
DI float gelu_tanh(float x) {
  float u = 0.7978845608028654f * (x + 0.044715f * x * x * x);
  float t = 1.f - 2.f / (1.f + __expf(2.f * u));
  return 0.5f * x * (1.f + t);
}
DI bf16x8 mk8(uint2 lo, uint2 hi) {
  uint4 v = {lo.x, lo.y, hi.x, hi.y};
  return __builtin_bit_cast(bf16x8, v);
}
DI bf16x8 mk8u(unsigned a, unsigned b, unsigned c, unsigned d) {
  uint4 v = {a, b, c, d};
  return __builtin_bit_cast(bf16x8, v);
}


#define XB_TMO      128
#define XB_XCNT(j)  (256  + 64 * (j))
#define XB_XSUB(j)  (1280 + 64 * (j))
#define XB_XGEN(j)  (2304 + 64 * (j))
#define XB_TOP      3328
#define XB_TOPGEN   3392
#define XCD_BAR_WORDS 3456
#define XB_SPIN_CAP (1u << 18)
#define LAS __attribute__((address_space(3)))
DI unsigned xb_ld(unsigned* p) { return __hip_atomic_load(p, __ATOMIC_RELAXED, __HIP_MEMORY_SCOPE_AGENT); }
DI unsigned xb_add(unsigned* p, unsigned v) { return __hip_atomic_fetch_add(p, v, __ATOMIC_RELAXED, __HIP_MEMORY_SCOPE_AGENT); }
DI unsigned xb_xcc_id() { return (unsigned)__builtin_amdgcn_s_getreg((3 << 11) | 20) & 0xFu; }
#define XB_SPIN(cond, bar) do { unsigned _sp = 0; while (cond) { __builtin_amdgcn_s_sleep(1); \
    if ((++_sp & 255u) == 0u) { if (xb_ld(&(bar)[XB_TMO])) break; if (_sp > XB_SPIN_CAP) { atomicAdd(&(bar)[XB_TMO], 1u); break; } } } } while (0)
struct XcdBarrier { unsigned* bar; unsigned x; volatile LAS unsigned* st; };
DI XcdBarrier xcd_barrier_post(unsigned* bar, volatile LAS unsigned* st) {
  XcdBarrier b; b.bar = bar; b.x = xb_xcc_id(); b.st = st;
  if (threadIdx.x == 0) (void)xb_add(&bar[XB_XCNT(b.x)], 1u);
  return b;
}
DI void xcd_barrier_complete(unsigned* bar, unsigned x, unsigned& nloc, unsigned& nx) {
  const unsigned G = gridDim.x * gridDim.y * gridDim.z;
  unsigned sum, cnt, mine, sp = 0u;
  for (;;) {
    sum = 0u; cnt = 0u; mine = 0u;
#pragma unroll
    for (unsigned j = 0; j < 16; ++j) { const unsigned c = xb_ld(&bar[XB_XCNT(j)]); sum += c; cnt += (c > 0u) ? 1u : 0u; mine = (j == x) ? c : mine; }
    if (sum == G) break;
    __builtin_amdgcn_s_sleep(1);
    if ((++sp & 255u) == 0u) { if (xb_ld(&bar[XB_TMO])) break; if (sp > XB_SPIN_CAP) { atomicAdd(&bar[XB_TMO], 1u); break; } }
  }
  nloc = mine > 0u ? mine : 1u; nx = cnt > 0u ? cnt : 1u;
}
DI void xcd_barrier(const XcdBarrier& b) {
  asm volatile("s_waitcnt vmcnt(0)" ::: "memory");
  __syncthreads();
  if (threadIdx.x == 0) {
    unsigned* bar = b.bar;
    __builtin_amdgcn_s_waitcnt(0);
    unsigned nloc = b.st[0], nx = b.st[1];
    if (nloc == 0u) { xcd_barrier_complete(bar, b.x, nloc, nx); b.st[0] = nloc; b.st[1] = nx; }
    const unsigned old = xb_add(&bar[XB_XSUB(b.x)], 1u);
    const unsigned gen = old / nloc;
    if (old + 1u == (gen + 1u) * nloc) {
      __builtin_amdgcn_fence(__ATOMIC_RELEASE, "agent");
      asm volatile("s_waitcnt vmcnt(0)" ::: "memory");
      const unsigned og = xb_add(&bar[XB_TOP], 1u);
      const unsigned tg = og / nx;
      if (og + 1u == (tg + 1u) * nx) xb_add(&bar[XB_TOPGEN], 1u);
      else XB_SPIN(xb_ld(&bar[XB_TOPGEN]) == tg, bar);
      __builtin_amdgcn_fence(__ATOMIC_ACQUIRE, "agent");
      xb_add(&bar[XB_XGEN(b.x)], 1u);
      asm volatile("s_waitcnt vmcnt(0)" ::: "memory");
    } else {
      XB_SPIN(xb_ld(&bar[XB_XGEN(b.x)]) == gen, bar);
      __builtin_amdgcn_fence(__ATOMIC_ACQUIRE, "agent");
      asm volatile("s_waitcnt vmcnt(0)" ::: "memory");
    }
  }
  __syncthreads();
}

DI void transpose_item(const float* __restrict__ src, int src_ld, u16* __restrict__ dst, int dst_ld, int k0, int n0,
                       bool permute_in, char* smem) {
  float* tile = (float*)smem;
  const int tid = otid();
#pragma unroll
  for (int i = 0; i < 16; ++i) {
    int k = i * 4 + (tid >> 6), n = tid & 63;
    int nd = n0 + n, ns = nd;
    if (permute_in) {
      if (nd < 2304) ns = nd;
      else if (nd < 2816) ns = nd + 16;
      else if (nd < 2832) ns = nd - 512;
      else ns = -1;
    }
    float v = (ns >= 0) ? src[(size_t)(k0 + k) * src_ld + ns] : 0.f;
    tile[k * 65 + n] = v;
  }
  __syncthreads();
#pragma unroll 4
  for (int i = 0; i < 16; ++i) {
    int n = i * 4 + (tid >> 6), k = tid & 63;
    dst[(size_t)(n0 + n) * dst_ld + k0 + k] = f2bf(tile[k * 65 + n]);
  }
  __syncthreads();
}

DI void mod_item(const Params& p, int item, char* smem) {
  const int l = item / 96, grp = item % 96;
  float* ssc = (float*)smem;
  float* red = ssc + 2048;
  const int tid = otid();
  for (int i = tid; i < 1024; i += 256) {
    ssc[i] = silu_f(p.c[i]);
    ssc[1024 + i] = silu_f(p.c_ctx[i]);
  }
  __syncthreads();
  const int kq = tid >> 5, n = tid & 31, col = grp * 32 + n;
  const float* w = p.w_mod + (size_t)l * 1024 * 3072 + col;
  float a0 = 0.f, a1 = 0.f;
#pragma unroll 16
  for (int k = kq * 128; k < kq * 128 + 128; ++k) {
    float wv = w[(size_t)k * 3072];
    a0 += ssc[k] * wv;
    a1 += ssc[1024 + k] * wv;
  }
  red[(0 * 8 + kq) * 32 + n] = a0;
  red[(1 * 8 + kq) * 32 + n] = a1;
  __syncthreads();
  if (tid < 64) {
    int v = tid >> 5, nn = tid & 31;
    float s = 0.f;
    for (int q = 0; q < 8; ++q) s += red[(v * 8 + q) * 32 + nn];
    int cc = grp * 32 + nn;
    float* modv = (float*)(p.ws + OFF_MODV);
    modv[(l * 2 + v) * 3072 + cc] = s + p.b_mod[l * 3072 + cc];
  }
  __syncthreads();
}

DI void setup_light_item(const Params& p, int it, char* smem) {
  constexpr int N_A = 2 * 16 * 46, N_B = 2 * 16 * 16, N_C = 2 * 4 * 4;
  if (it < N_A) {
    int l = it / (16 * 46), r = it % (16 * 46);
    int kt = r / 46, nt = r % 46;
    transpose_item(p.w_in + (size_t)l * 1024 * NIN, NIN, (u16*)(p.ws + OFF_WINT) + (size_t)l * NINP * 1024, 1024,
                   kt * 64, nt * 64, true, smem);
    return;
  }
  it -= N_A;
  if (it < N_B) {
    int l = it / 256, r = it % 256;
    int kt = r / 16, nt = r % 16;
    transpose_item(p.w_out + (size_t)l * 1024 * 1024, 1024, (u16*)(p.ws + OFF_WOUTT) + (size_t)l * 1024 * 1024, 1024,
                   kt * 64, nt * 64, false, smem);
    return;
  }
  it -= N_B;
  if (it < N_C) {
    int l = it / 16, r = it % 16;
    int kt = r / 4, nt = r % 4;
    transpose_item(p.glu_w + (size_t)l * 256 * 256, 256, (u16*)(p.ws + OFF_GLUWT) + (size_t)l * 256 * 256, 256,
                   kt * 64, nt * 64, false, smem);
    return;
  }
  float* rope = (float*)(p.ws + OFF_ROPE);
  for (int e = otid(); e < 4096; e += 256) {
    int row = e >> 4, j = e & 15;
    float inv = powf(10000.f, -(float)j / 16.f);
    float ang = (float)row * inv;
    rope[e * 2] = cosf(ang);
    rope[e * 2 + 1] = sinf(ang);
  }
}

DI void setup_phase(const Params& p, char* smem) {
  constexpr int N_LIGHT = 2 * 16 * 46 + 2 * 16 * 16 + 2 * 4 * 4 + 1, N_D = 192;
  const int nb = gridDim.x, b = blockIdx.x;
  if (nb >= N_D + 64) {
    if (b < N_D) { mod_item(p, b, smem); setup_light_item(p, b, smem); }
    else for (int it = b; it < N_LIGHT; it += nb - N_D) setup_light_item(p, it, smem);
  } else {
    for (int item = b; item < N_LIGHT + N_D; item += nb) {
      if (item < N_LIGHT) setup_light_item(p, item, smem);
      else mod_item(p, item - N_LIGHT, smem);
    }
  }
}

DI void ln_mod_phase(const Params& p, const float* ctx_src, const float* lat_src, int l) {
  const int lane = otid() & 63, wave = otid() >> 6;
  const int nw = gridDim.x * 4;
  u16* h = (u16*)(p.ws + OFF_H);
  const float* modv = (const float*)(p.ws + OFF_MODV);
  for (int r = blockIdx.x * 4 + wave; r < T; r += nw) {
    const float* src = (r < NCTX) ? ctx_src + (size_t)r * DM : lat_src + (size_t)(r - NCTX) * DM;
    const float* mod = modv + (l * 2 + (r < NCTX ? 1 : 0)) * 3072;
    float4 v[4];
    float s = 0.f;
#pragma unroll
    for (int i = 0; i < 4; ++i) {
      v[i] = *(const float4*)(src + (i * 64 + lane) * 4);
      s += v[i].x + v[i].y + v[i].z + v[i].w;
    }
    float mu = wave_sum(s) * (1.f / DM);
    float q = 0.f;
#pragma unroll
    for (int i = 0; i < 4; ++i) {
      v[i].x -= mu; v[i].y -= mu; v[i].z -= mu; v[i].w -= mu;
      q += v[i].x * v[i].x + v[i].y * v[i].y + v[i].z * v[i].z + v[i].w * v[i].w;
    }
    float rstd = rsqrtf(wave_sum(q) * (1.f / DM) + EPS);
#pragma unroll
    for (int i = 0; i < 4; ++i) {
      int c0 = (i * 64 + lane) * 4;
      float4 sh = *(const float4*)(mod + c0);
      float4 sc = *(const float4*)(mod + 1024 + c0);
      float o0 = v[i].x * rstd * (1.f + sc.x) + sh.x;
      float o1 = v[i].y * rstd * (1.f + sc.y) + sh.y;
      float o2 = v[i].z * rstd * (1.f + sc.z) + sh.z;
      float o3 = v[i].w * rstd * (1.f + sc.w) + sh.w;
      uint2 pk = {pk2(o0, o1), pk2(o2, o3)};
      *(uint2*)(h + (size_t)r * DM + c0) = pk;
    }
  }
}

constexpr int G_LDA = 72;
DI void gemm_tile_compute(const u16* __restrict__ A, int lda, const u16* __restrict__ Bt, int ldb, int K, int m0, int n0,
                          char* smem) {
  u16* As = (u16*)smem;
  u16* Bs = As + 2 * 128 * G_LDA;
  const int tid = otid(), lane = tid & 63, wave = tid >> 6;
  const int wm = wave >> 1, wn = wave & 1;
  const int lr = lane & 31, lh = lane >> 5;
  f32x16 acc[2][2];
#pragma unroll
  for (int a = 0; a < 2; ++a)
#pragma unroll
    for (int b = 0; b < 2; ++b)
#pragma unroll
      for (int i = 0; i < 16; ++i) acc[a][b][i] = 0.f;

  const int KT = K / 64;
  uint4 ra0, ra1, ra2, ra3, rb0, rb1, rb2, rb3;
  const int srow = tid >> 3, sch = tid & 7;
  const u16* Ag = A + (size_t)(m0 + srow) * lda + sch * 8;
  const u16* Bg = Bt + (size_t)(n0 + srow) * ldb + sch * 8;
  const size_t a32 = (size_t)32 * lda, b32 = (size_t)32 * ldb;
#define G_LOAD(KT_)                                                                       \
  {                                                                                       \
    const u16* ag_ = Ag + (KT_) * 64;                                                     \
    const u16* bg_ = Bg + (KT_) * 64;                                                     \
    ra0 = *(const uint4*)(ag_);            rb0 = *(const uint4*)(bg_);                    \
    ra1 = *(const uint4*)(ag_ + a32);      rb1 = *(const uint4*)(bg_ + b32);              \
    ra2 = *(const uint4*)(ag_ + 2 * a32);  rb2 = *(const uint4*)(bg_ + 2 * b32);          \
    ra3 = *(const uint4*)(ag_ + 3 * a32);  rb3 = *(const uint4*)(bg_ + 3 * b32);          \
  }
#define G_STORE(BUF_)                                                                     \
  {                                                                                       \
    u16* as_ = As + ((BUF_) * 128 + srow) * G_LDA + sch * 8;                              \
    u16* bs_ = Bs + ((BUF_) * 128 + srow) * G_LDA + sch * 8;                              \
    *(uint4*)(as_) = ra0;                    *(uint4*)(bs_) = rb0;                        \
    *(uint4*)(as_ + 32 * G_LDA) = ra1;       *(uint4*)(bs_ + 32 * G_LDA) = rb1;           \
    *(uint4*)(as_ + 64 * G_LDA) = ra2;       *(uint4*)(bs_ + 64 * G_LDA) = rb2;           \
    *(uint4*)(as_ + 96 * G_LDA) = ra3;       *(uint4*)(bs_ + 96 * G_LDA) = rb3;           \
  }
  G_LOAD(0)
  G_STORE(0)
  __syncthreads();
  for (int kt = 0; kt < KT; ++kt) {
    const int buf = kt & 1;
    const int ktn = kt + 1 < KT ? kt + 1 : kt;
    G_LOAD(ktn)
    __builtin_amdgcn_sched_barrier(0);
    const u16* Ab = As + (buf * 128 + wm * 64 + lr) * G_LDA + lh * 8;
    const u16* Bb = Bs + (buf * 128 + wn * 64 + lr) * G_LDA + lh * 8;
    bf16x8 fa0[4], fa1[4], fb0[4], fb1[4];
#pragma unroll
    for (int ks = 0; ks < 4; ++ks) {
      fa0[ks] = *(const bf16x8*)(Ab + ks * 16);
      fa1[ks] = *(const bf16x8*)(Ab + 32 * G_LDA + ks * 16);
      fb0[ks] = *(const bf16x8*)(Bb + ks * 16);
      fb1[ks] = *(const bf16x8*)(Bb + 32 * G_LDA + ks * 16);
    }
    __builtin_amdgcn_sched_barrier(0);
#pragma unroll
    for (int ks = 0; ks < 4; ++ks) {
      acc[0][0] = MFMA32(fa0[ks], fb0[ks], acc[0][0]);
      acc[0][1] = MFMA32(fa0[ks], fb1[ks], acc[0][1]);
      acc[1][0] = MFMA32(fa1[ks], fb0[ks], acc[1][0]);
      acc[1][1] = MFMA32(fa1[ks], fb1[ks], acc[1][1]);
    }
    __builtin_amdgcn_sched_barrier(0);
    G_STORE(buf ^ 1)
    __syncthreads();
  }
  float* Cs = (float*)smem;
#pragma unroll
  for (int mi = 0; mi < 2; ++mi)
#pragma unroll
    for (int ni = 0; ni < 2; ++ni)
#pragma unroll
      for (int i = 0; i < 16; ++i) {
        int row = wm * 64 + mi * 32 + (i & 3) + 8 * (i >> 2) + 4 * lh;
        int col = wn * 64 + ni * 32 + lr;
        Cs[row * 132 + col] = acc[mi][ni][i];
      }
  __syncthreads();
}

template <bool OUT_BF16, bool SILU>
DI void epi_store(const float* Cs, void* dst, int ld, int m0, int coff, int ncols) {
  const int tid = otid();
  const int cpr = ncols >> 2;
  for (int idx = tid; idx < 128 * cpr; idx += 256) {
    int row = idx / cpr, c4 = idx % cpr;
    float4 v = *(const float4*)(Cs + row * 132 + 4 * c4);
    if (SILU) { v.x = silu_f(v.x); v.y = silu_f(v.y); v.z = silu_f(v.z); v.w = silu_f(v.w); }
    size_t o = (size_t)(m0 + row) * ld + coff + 4 * c4;
    if (OUT_BF16) *(uint2*)((u16*)dst + o) = make_uint2(pk2(v.x, v.y), pk2(v.z, v.w));
    else *(float4*)((float*)dst + o) = v;
  }
}

DI void epi_qk(const Params& p, const float* Cs, int l, int m0, int nt) {
  const int tid = otid();
  const int row = tid & 127, hh = tid >> 7;
  const int gr = m0 + row;
  const bool isk = (nt == 4);
  const float* gain = (isk ? p.kg : p.qg) + l * 64;
  float v[64];
  float ss = 0.f;
#pragma unroll
  for (int d4 = 0; d4 < 16; ++d4) {
    float4 t4 = *(const float4*)(Cs + row * 132 + hh * 64 + d4 * 4);
    v[4 * d4] = t4.x; v[4 * d4 + 1] = t4.y; v[4 * d4 + 2] = t4.z; v[4 * d4 + 3] = t4.w;
    ss += t4.x * t4.x + t4.y * t4.y + t4.z * t4.z + t4.w * t4.w;
  }
  float rinv = rsqrtf(ss * (1.f / 64.f) + EPS);
#pragma unroll
  for (int d = 0; d < 64; ++d) v[d] = v[d] * rinv * gain[d];
  if (gr >= NCTX) {
    const int t = gr - NCTX;
    const float* rope = (const float*)(p.ws + OFF_ROPE);
    const float* rr = rope + (t >> 6) * 32;
    const float* rc = rope + (t & 63) * 32;
#pragma unroll
    for (int j = 0; j < 16; ++j) {
      float c1 = rr[2 * j], s1 = rr[2 * j + 1];
      float a = v[j], b = v[j + 16];
      v[j] = a * c1 - b * s1;
      v[j + 16] = b * c1 + a * s1;
      float c2 = rc[2 * j], s2 = rc[2 * j + 1];
      float a2 = v[32 + j], b2 = v[48 + j];
      v[32 + j] = a2 * c2 - b2 * s2;
      v[48 + j] = b2 * c2 + a2 * s2;
    }
  }
  if (!isk) {
    constexpr float QS = 0.125f * 1.4426950408889634f;
#pragma unroll
    for (int d = 0; d < 64; ++d) v[d] *= QS;
  }
  u16* dst;
  if (isk) dst = (u16*)(p.ws + OFF_KB) + ((size_t)hh * T + gr) * 64;
  else dst = (u16*)(p.ws + OFF_QB) + ((size_t)(2 * nt + hh) * T + gr) * 64;
#pragma unroll
  for (int c = 0; c < 8; ++c) {
    uint4 o = {pk2(v[8 * c], v[8 * c + 1]), pk2(v[8 * c + 2], v[8 * c + 3]), pk2(v[8 * c + 4], v[8 * c + 5]),
               pk2(v[8 * c + 6], v[8 * c + 7])};
    *(uint4*)(dst + 8 * c) = o;
  }
}

DI void epi_v(const Params& p, const float* Cs, int m0) {
  const int tid = otid();
  const int c = tid & 127, half = tid >> 7;
  const int kvh = c >> 6, d = c & 63;
  u16* dst = (u16*)(p.ws + OFF_VT) + ((size_t)kvh * 64 + d) * T + m0 + half * 64;
#pragma unroll
  for (int g = 0; g < 8; ++g) {
    float v[8];
#pragma unroll
    for (int e = 0; e < 8; ++e) v[e] = Cs[(half * 64 + g * 8 + e) * 132 + c];
    uint4 o = {pk2(v[0], v[1]), pk2(v[2], v[3]), pk2(v[4], v[5]), pk2(v[6], v[7])};
    *(uint4*)(dst + g * 8) = o;
  }
}

DI void gemm_in_phase(const Params& p, int l, char* smem) {
  const u16* A = (const u16*)(p.ws + OFF_H);
  const u16* Bt = (const u16*)(p.ws + OFF_WINT) + (size_t)l * NINP * 1024;
  constexpr int MT = T / 128, NT = NINP / 128;
  const float* Cs = (const float*)smem;
  constexpr int NFULL = (MT / 8) * 8 * NT, MREM = MT % 8;
  for (int item = blockIdx.x; item < MT * NT; item += gridDim.x) {
    int mt, nt;
    if (item < NFULL) { const int xcd = item & 7, r = item >> 3; mt = (r / NT) * 8 + xcd; nt = r % NT; }
    else { const int j = item - NFULL; mt = (MT / 8) * 8 + j % MREM; nt = j / MREM; }
    const int m0 = mt * 128;
    gemm_tile_compute(A, 1024, Bt, 1024, 1024, m0, nt * 128, smem);
    if (nt <= 4) epi_qk(p, Cs, l, m0, nt);
    else if (nt == 5) epi_v(p, Cs, m0);
    else if (nt <= 9) epi_store<true, true>(Cs, p.ws + OFF_GATES, 1024, m0, (nt - 6) * 128, 128);
    else if (nt <= 15) epi_store<true, false>(Cs, p.ws + OFF_QKVB, 768, m0, (nt - 10) * 128, 128);
    else if (nt <= 17) epi_store<true, true>(Cs, p.ws + OFF_GATES, 1024, m0, 512 + (nt - 16) * 128, 128);
    else if (nt <= 19) epi_store<false, false>(Cs, p.ws + OFF_UC, 256, m0, (nt - 18) * 128, 128);
    else if (nt <= 21) epi_store<true, true>(Cs, p.ws + OFF_GATES, 1024, m0, 768 + (nt - 20) * 128, 128);
    else epi_store<false, false>(Cs, p.ws + OFF_BD, 16, m0, 0, 16);
    __syncthreads();
  }
}

DI void gemm_glu_phase(const Params& p, int l, char* smem) {
  const u16* A = (const u16*)(p.ws + OFF_QB);
  const u16* Bt = (const u16*)(p.ws + OFF_GLUWT) + (size_t)l * 256 * 256;
  const u16* gates = (const u16*)(p.ws + OFF_GATES);
  u16* mix = (u16*)(p.ws + OFF_H);
  const float* Cs = (const float*)smem;
  constexpr int MT = T / 128;
  for (int item = blockIdx.x; item < MT * 2; item += gridDim.x) {
    const int mt = item >> 1, nt = item & 1;
    const int m0 = mt * 128, n0 = nt * 128;
    gemm_tile_compute(A, 256, Bt, 256, 256, m0, n0, smem);
    for (int idx = otid(); idx < 128 * 64; idx += 256) {
      int row = idx >> 6, cp = idx & 63;
      int col = n0 + 2 * cp;
      size_t r = (size_t)(m0 + row);
      float a0 = Cs[row * 132 + 2 * cp] + p.glu_b[l * 256 + col];
      float a1 = Cs[row * 132 + 2 * cp + 1] + p.glu_b[l * 256 + col + 1];
      unsigned zz = *(const unsigned*)(A + r * 256 + col);
      unsigned gg = *(const unsigned*)(gates + r * 1024 + 768 + col);
      float z0 = bf2f((u16)(zz & 0xffff)), z1 = bf2f((u16)(zz >> 16));
      float g0 = bf2f((u16)(gg & 0xffff)), g1 = bf2f((u16)(gg >> 16));
      float o0 = z0 * sigmoid_f(a0) * g0, o1 = z1 * sigmoid_f(a1) * g1;
      *(unsigned*)(mix + r * 1024 + 768 + col) = pk2(o0, o1);
    }
    __syncthreads();
  }
}

DI void gemm_out_phase(const Params& p, int l, char* smem) {
  const u16* A = (const u16*)(p.ws + OFF_H);
  const u16* Bt = (const u16*)(p.ws + OFF_WOUTT) + (size_t)l * 1024 * 1024;
  const float* Cs = (const float*)smem;
  constexpr int MT = T / 128, NT = 8;
  const int mstart = (l == 1) ? 2 : 0;
  constexpr int NFULL = (MT / 8) * 8 * NT, MREM = MT % 8;
  const int nitems = (l == 1) ? NFULL : MT * NT;
  for (int item = blockIdx.x; item < nitems; item += gridDim.x) {
    int mt, nt;
    if (item < NFULL) { const int xcd = item & 7, r = item >> 3; mt = (r / NT) * 8 + xcd; nt = r % NT; }
    else { const int j = item - NFULL; mt = (MT / 8) * 8 + j % MREM; nt = j / MREM; }
    if (mt < mstart) mt += (MT / 8) * 8;
    gemm_tile_compute(A, 1024, Bt, 1024, 1024, mt * 128, nt * 128, smem);
    epi_store<false, false>(Cs, p.ws + OFF_DN, 1024, mt * 128, nt * 128, 128);
    __syncthreads();
  }
}

DI void dn_solve(const float* Lr, const float* sb, const float* gc, bool isv, const char* src, int stride_bytes, float* x) {
  int off = 0;
  const int hioff = isv ? 0 : 2;
  const unsigned lomask = isv ? 0u : 0xffffu;
  const float gsel = isv ? 0.f : 1.f;
#pragma unroll
  for (int li = 0; li < 64; ++li) {
    const unsigned hi = *(const u16*)(src + off + hioff);
    const unsigned lo = *(const u16*)(src + off);
    const float gcl = gc[li];
    float r = __uint_as_float((hi << 16) | (lo & lomask)) * __expf(gcl * gsel);
    off += stride_bytes;
    asm volatile("" : "+v"(off));
    float acc = r * sb[li];
#pragma unroll
    for (int lj4 = 0; lj4 < (li + 3) / 4; ++lj4) {
      float4 Lq = *(const float4*)(Lr + li * 64 + lj4 * 4);
      if (lj4 * 4 + 0 < li) acc -= Lq.x * x[lj4 * 4 + 0];
      if (lj4 * 4 + 1 < li) acc -= Lq.y * x[lj4 * 4 + 1];
      if (lj4 * 4 + 2 < li) acc -= Lq.z * x[lj4 * 4 + 2];
      if (lj4 * 4 + 3 < li) acc -= Lq.w * x[lj4 * 4 + 3];
    }
    x[li] = acc;
    if (li & 1) __builtin_amdgcn_sched_barrier(0);
  }
}

DI void dn_prep_item(const Params& p, int l, int unit, char* smem) {
  const int cid = unit >> 2, head = unit & 3;
  const int tt0 = cid * 64;
  const int seg_lo = cid < 4 ? 0 : NCTX, seg_hi = cid < 4 ? NCTX : T;
  float* sq = (float*)smem;
  float* sk = sq + 64 * 65;
  float* sL = sk + 64 * 65;
  float* sbeta = sL + 2 * 4096;
  float* sgc = sbeta + 128;
  float* sg = sgc + 128;
  u16* sv = (u16*)(sg + 128);
  const u16* z = (const u16*)(p.ws + OFF_QKVB);
  const float* bd = (const float*)(p.ws + OFF_BD);
  const float* cw = p.conv_w + l * 3 * 768;
  u16* dn = (u16*)(p.ws + OFF_DN) + (size_t)unit * 2 * 5 * 4096;
  u16* tmp = (u16*)(p.ws + OFF_H) + (size_t)blockIdx.x * 32768;
  float* glast = (float*)(p.ws + OFF_GLAST);
  const int tid = otid(), lane = tid & 63, wave = tid >> 6;

  {
    const int cq = head * 64 + lane, ck = 256 + head * 64 + lane;
    const float wq0 = cw[cq], wq1 = cw[768 + cq], wq2 = cw[1536 + cq];
    const float wk0 = cw[ck], wk1 = cw[768 + ck], wk2 = cw[1536 + ck];
#pragma unroll 8
    for (int i = wave; i < 64; i += 4) {
      const int tt = tt0 + i;
      float zq0 = 0.f, zq2 = 0.f, zk0 = 0.f, zk2 = 0.f;
      if (tt - 1 >= seg_lo) { zq0 = bf2f(z[(size_t)(tt - 1) * 768 + cq]); zk0 = bf2f(z[(size_t)(tt - 1) * 768 + ck]); }
      if (tt + 1 < seg_hi) { zq2 = bf2f(z[(size_t)(tt + 1) * 768 + cq]); zk2 = bf2f(z[(size_t)(tt + 1) * 768 + ck]); }
      float zq1 = bf2f(z[(size_t)tt * 768 + cq]), zk1 = bf2f(z[(size_t)tt * 768 + ck]);
      float vq = silu_f(wq0 * zq0 + wq1 * zq1 + wq2 * zq2);
      float vk = silu_f(wk0 * zk0 + wk1 * zk1 + wk2 * zk2);
      float s1 = wave_sum(vq * vq), s2 = wave_sum(vk * vk);
      sq[i * 65 + lane] = vq * rsqrtf(s1 + EPS) * 0.125f;
      sk[i * 65 + lane] = vk * rsqrtf(s2 + EPS);
    }
  }
  if (tid < 128) {
    const int dir = tid >> 6, i = tid & 63;
    const int tt = tt0 + i;
    const int li = dir ? 63 - i : i;
    float br = bd[(size_t)tt * 16 + dir * 4 + head];
    float ar = bd[(size_t)tt * 16 + 8 + dir * 4 + head];
    sbeta[dir * 64 + li] = 1.f / (1.f + expf(-br));
    float xx = ar + p.dt_bias[l * 8 + dir * 4 + head];
    float sp = fmaxf(xx, 0.f) + log1pf(expf(-fabsf(xx)));
    sg[dir * 64 + li] = -expf(p.A_log[l * 8 + dir * 4 + head]) * sp;
  }
  __syncthreads();
  if (tid == 0 || tid == 64) {
    const int dir = tid >> 6;
    float a = 0.f;
    for (int li = 0; li < 64; ++li) { a += sg[dir * 64 + li]; sgc[dir * 64 + li] = a; }
  }
  __syncthreads();

  {
    const int it = wave >> 1, jt = wave & 1;
    const int lr = lane & 31, lh = lane >> 5;
    f32x16 kk, qk;
#pragma unroll
    for (int r = 0; r < 16; ++r) { kk[r] = 0.f; qk[r] = 0.f; }
    const float* ki = sk + (32 * it + lr) * 65 + 8 * lh;
    const float* qi = sq + (32 * it + lr) * 65 + 8 * lh;
    const float* kj = sk + (32 * jt + lr) * 65 + 8 * lh;
#pragma unroll
    for (int ks = 0; ks < 4; ++ks) {
      bf16x8 fa = mk8u(pk2(ki[16 * ks], ki[16 * ks + 1]), pk2(ki[16 * ks + 2], ki[16 * ks + 3]), pk2(ki[16 * ks + 4], ki[16 * ks + 5]),
                       pk2(ki[16 * ks + 6], ki[16 * ks + 7]));
      bf16x8 fq = mk8u(pk2(qi[16 * ks], qi[16 * ks + 1]), pk2(qi[16 * ks + 2], qi[16 * ks + 3]), pk2(qi[16 * ks + 4], qi[16 * ks + 5]),
                       pk2(qi[16 * ks + 6], qi[16 * ks + 7]));
      bf16x8 fb = mk8u(pk2(kj[16 * ks], kj[16 * ks + 1]), pk2(kj[16 * ks + 2], kj[16 * ks + 3]), pk2(kj[16 * ks + 4], kj[16 * ks + 5]),
                       pk2(kj[16 * ks + 6], kj[16 * ks + 7]));
      kk = MFMA32(fa, fb, kk);
      qk = MFMA32(fq, fb, qk);
    }
    const int j = 32 * jt + lr;
#pragma unroll
    for (int dir = 0; dir < 2; ++dir) {
      u16* attn = tmp + dir * 16384;
      const int lj = dir ? 63 - j : j;
      const float gcj = sgc[dir * 64 + lj];
#pragma unroll
      for (int r = 0; r < 16; ++r) {
        const int i = 32 * it + (r & 3) + 8 * (r >> 2) + 4 * lh;
        const int li = dir ? 63 - i : i;
        const float dec = __expf(fminf(sgc[dir * 64 + li] - gcj, 0.f));
        const float Lv = (lj < li) ? sbeta[dir * 64 + li] * kk[r] * dec : 0.f;
        const float Av = (lj <= li) ? qk[r] * dec : 0.f;
        sL[dir * 4096 + li * 64 + lj] = Lv;
        attn[li * 64 + lj] = f2bf(Av);
      }
    }
  }
#pragma unroll
  for (int dir = 0; dir < 2; ++dir) {
    u16* kdT = tmp + dir * 16384 + 4096;
    {
      const int d = tid >> 2, lq = tid & 3;
      const float gl = sgc[dir * 64 + 63];
      unsigned o[8];
#pragma unroll
      for (int e = 0; e < 8; ++e) {
        const int li0 = lq * 16 + 2 * e, li1 = li0 + 1;
        const int i0 = dir ? 63 - li0 : li0, i1 = dir ? 63 - li1 : li1;
        float v0 = sk[i0 * 65 + d] * __expf(gl - sgc[dir * 64 + li0]);
        float v1 = sk[i1 * 65 + d] * __expf(gl - sgc[dir * 64 + li1]);
        o[e] = pk2(v0, v1);
      }
      *(uint4*)(kdT + d * 64 + lq * 16) = make_uint4(o[0], o[1], o[2], o[3]);
      *(uint4*)(kdT + d * 64 + lq * 16 + 8) = make_uint4(o[4], o[5], o[6], o[7]);
    }
    if (tid == 0) glast[unit * 2 + dir] = __expf(sgc[dir * 64 + 63]);
  }
  {
    const int cv = 512 + head * 64 + lane;
    const float w0 = cw[cv], w1 = cw[768 + cv], w2 = cw[1536 + cv];
#pragma unroll 8
    for (int i = wave; i < 64; i += 4) {
      const int tt = tt0 + i;
      float z0 = 0.f, z2 = 0.f;
      if (tt - 1 >= seg_lo) z0 = bf2f(z[(size_t)(tt - 1) * 768 + cv]);
      if (tt + 1 < seg_hi) z2 = bf2f(z[(size_t)(tt + 1) * 768 + cv]);
      float z1 = bf2f(z[(size_t)tt * 768 + cv]);
      sv[i * 72 + lane] = f2bf(silu_f(w0 * z0 + w1 * z1 + w2 * z2));
    }
  }
  __syncthreads();
  {
    const int dir = tid >> 7, col = tid & 127;
    const bool isv = col < 64;
    const int c6 = col & 63;
    float x[64];
    const char* src = isv ? (const char*)(sv + (dir ? 63 * 72 : 0) + c6) : (const char*)(sk + (dir ? 63 * 65 : 0) + c6);
    const int strideb = (isv ? 144 : 260) * (dir ? -1 : 1);
    dn_solve(sL + dir * 4096, sbeta + dir * 64, sgc + dir * 64, isv, src, strideb, x);
    u16* XT = tmp + dir * 16384 + 8192 + col * 64;
#pragma unroll
    for (int c = 0; c < 8; ++c)
      *(uint4*)(XT + 8 * c) = make_uint4(pk2(x[8 * c], x[8 * c + 1]), pk2(x[8 * c + 2], x[8 * c + 3]),
                                         pk2(x[8 * c + 4], x[8 * c + 5]), pk2(x[8 * c + 6], x[8 * c + 7]));
  }
  __threadfence_block();
  __syncthreads();
  {
    const int dir = wave >> 1, prod = wave & 1;
    const int lr = lane & 31, lh = lane >> 5;
    const u16* Aop = tmp + dir * 16384 + (prod ? 0 : 4096);
    const u16* XT = tmp + dir * 16384 + 8192;
    u16* dnd = dn + (size_t)dir * 5 * 4096;
    bf16x8 af[2][4];
#pragma unroll
    for (int mt = 0; mt < 2; ++mt)
#pragma unroll
      for (int ks = 0; ks < 4; ++ks) af[mt][ks] = *(const bf16x8*)(Aop + (mt * 32 + lr) * 64 + ks * 16 + lh * 8);
    {
      f32x16 acc[2][2];
#pragma unroll
      for (int a = 0; a < 2; ++a)
#pragma unroll
        for (int b = 0; b < 2; ++b)
#pragma unroll
          for (int i = 0; i < 16; ++i) acc[a][b][i] = 0.f;
#pragma unroll
      for (int nt = 0; nt < 2; ++nt)
#pragma unroll
        for (int ks = 0; ks < 4; ++ks) {
          bf16x8 b = *(const bf16x8*)(XT + (nt * 32 + lr) * 64 + ks * 16 + lh * 8);
          acc[0][nt] = MFMA32(af[0][ks], b, acc[0][nt]);
          acc[1][nt] = MFMA32(af[1][ks], b, acc[1][nt]);
        }
      u16* dst = dnd + (prod ? 3 : 1) * 4096;
#pragma unroll
      for (int mt = 0; mt < 2; ++mt)
#pragma unroll
        for (int nt = 0; nt < 2; ++nt)
#pragma unroll
          for (int g4 = 0; g4 < 4; ++g4) {
            uint2 o = {pk2(acc[mt][nt][4 * g4], acc[mt][nt][4 * g4 + 1]), pk2(acc[mt][nt][4 * g4 + 2], acc[mt][nt][4 * g4 + 3])};
            if (prod) {
              *(uint2*)(dst + (nt * 32 + lr) * 64 + mt * 32 + 8 * g4 + 4 * lh) = o;
            } else {
              const int dvv = nt * 32 + lr;
              const int mm = 2 * mt + (g4 >> 1), qq = 2 * (g4 & 1) + lh;
              *(uint2*)(dst + (((dvv >> 4) * 64 + qq * 16 + (dvv & 15)) * 4 + mm) * 4) = o;
            }
          }
    }
    {
      f32x16 acc[2][2];
#pragma unroll
      for (int a = 0; a < 2; ++a)
#pragma unroll
        for (int b = 0; b < 2; ++b)
#pragma unroll
          for (int i = 0; i < 16; ++i) acc[a][b][i] = 0.f;
#pragma unroll
      for (int mt = 0; mt < 2; ++mt)
#pragma unroll
        for (int ks = 0; ks < 4; ++ks) {
          bf16x8 a = *(const bf16x8*)(XT + (64 + mt * 32 + lr) * 64 + ks * 16 + lh * 8);
          acc[mt][0] = MFMA32(a, af[0][ks], acc[mt][0]);
          acc[mt][1] = MFMA32(a, af[1][ks], acc[mt][1]);
        }
      u16* dst = dnd + (prod ? 2 : 0) * 4096;
#pragma unroll
      for (int nt = 0; nt < 2; ++nt) {
        const int n = nt * 32 + lr;
        const int i = dir ? 63 - n : n;
        const float eg = __expf(sgc[dir * 64 + n]);
#pragma unroll
        for (int mt = 0; mt < 2; ++mt)
#pragma unroll
          for (int g4 = 0; g4 < 4; ++g4) {
            const int d0 = mt * 32 + 8 * g4 + 4 * lh;
            float v0 = acc[mt][nt][4 * g4], v1 = acc[mt][nt][4 * g4 + 1], v2 = acc[mt][nt][4 * g4 + 2], v3 = acc[mt][nt][4 * g4 + 3];
            if (prod) {
              v0 = sq[i * 65 + d0] * eg - v0;
              v1 = sq[i * 65 + d0 + 1] * eg - v1;
              v2 = sq[i * 65 + d0 + 2] * eg - v2;
              v3 = sq[i * 65 + d0 + 3] * eg - v3;
            }
            uint2 o = {pk2(v0, v1), pk2(v2, v3)};
            if (prod) {
              *(uint2*)(dst + n * 64 + d0) = o;
            } else {
              const int mm = n >> 4, cnn = n & 15, ss = mt, hif = g4 >> 1, qq = 2 * (g4 & 1) + lh;
              *(uint2*)(dst + ((mm * 2 + ss) * 64 + qq * 16 + cnn) * 8 + 4 * hif) = o;
            }
          }
      }
    }
  }
  __syncthreads();
}

DI void s5_coeffs(const Params& p, int l, int dir, int g, int pp, float& a_re, float& a_im, float* b_re, float* b_im) {
  const int gi = (l * 2 + dir) * 16 + g;
  const int idx = gi * 64 + pp;
  const float lr = p.A_re[idx], lim = p.A_im[idx];
  const float dt = expf(p.log_dt[gi]);
  const float mag = expf(lr * dt);
  const float ang = lim * dt;
  float sn, cs;
  sincosf(ang, &sn, &cs);
  a_re = mag * cs;
  a_im = mag * sn;
  const float nr = a_re - 1.f, ni = a_im;
  const float den = 1.f / (lr * lr + lim * lim);
  const float c_re = (nr * lr + ni * lim) * den;
  const float c_im = (ni * lr - nr * lim) * den;
  const float* Br = p.B_re + (size_t)idx * 16;
  const float* Bi = p.B_im + (size_t)idx * 16;
#pragma unroll
  for (int c = 0; c < 16; ++c) {
    float br = Br[c], bi = Bi[c];
    b_re[c] = c_re * br - c_im * bi;
    b_im[c] = c_re * bi + c_im * br;
  }
}


constexpr int S5_WAVE_LDS = 12800;
DI void s5_wave_sync() { asm volatile("s_waitcnt lgkmcnt(0)" ::: "memory"); }
DI void s5_bfrags(u16* sbw, const float* b_re, const float* b_im, int lane, bf16x8* bfrag) {
  *(uint4*)(sbw + lane * 32) = make_uint4(pk2(b_re[0], b_re[1]), pk2(b_re[2], b_re[3]), pk2(b_re[4], b_re[5]), pk2(b_re[6], b_re[7]));
  *(uint4*)(sbw + lane * 32 + 8) = make_uint4(pk2(b_re[8], b_re[9]), pk2(b_re[10], b_re[11]), pk2(b_re[12], b_re[13]), pk2(b_re[14], b_re[15]));
  *(uint4*)(sbw + lane * 32 + 16) = make_uint4(pk2(b_im[0], b_im[1]), pk2(b_im[2], b_im[3]), pk2(b_im[4], b_im[5]), pk2(b_im[6], b_im[7]));
  *(uint4*)(sbw + lane * 32 + 24) = make_uint4(pk2(b_im[8], b_im[9]), pk2(b_im[10], b_im[11]), pk2(b_im[12], b_im[13]), pk2(b_im[14], b_im[15]));
  s5_wave_sync();
  const int n = lane & 15, q4 = lane >> 4;
  const unsigned keep = (q4 < 2) ? 0xffffffffu : 0u;
#pragma unroll
  for (int nt = 0; nt < 8; ++nt) {
    const int state = 16 * (nt & 3) + n, part = nt >> 2;
    uint4 v = *(const uint4*)(sbw + state * 32 + part * 16 + 8 * (q4 & 1));
    bfrag[nt] = mk8u(v.x & keep, v.y & keep, v.z & keep, v.w & keep);
  }
}
DI void s5_bu_slab(const float* su, int wave, int dir, int s, int lane, const bf16x8* bfrag, u16* busw) {
  const int n = lane & 15, q4 = lane >> 4;
  const int li = 16 * s + n;
  const int i = dir ? 63 - li : li;
  const float* ur = su + i * 64 + wave * 16 + 8 * (q4 & 1);
  const float4 u0 = *(const float4*)ur, u1 = *(const float4*)(ur + 4);
  const unsigned keep = (q4 < 2) ? 0xffffffffu : 0u;
  const bf16x8 a = mk8u(pk2(u0.x, u0.y) & keep, pk2(u0.z, u0.w) & keep, pk2(u1.x, u1.y) & keep, pk2(u1.z, u1.w) & keep);
#pragma unroll
  for (int nt = 0; nt < 8; ++nt) {
    f32x4 acc = {0.f, 0.f, 0.f, 0.f};
    acc = MFMA16(a, bfrag[nt], acc);
    const int col = (nt >> 2) * 64 + 16 * (nt & 3) + n;
#pragma unroll
    for (int j = 0; j < 4; ++j) busw[(4 * q4 + j) * 136 + col] = f2bf(acc[j]);
  }
  s5_wave_sync();
}

DI void s5_a_item(const Params& p, int l, int item, char* smem) {
  const int quarter = item & 3, dir = (item >> 2) & 1, cid = item >> 3;
  const int tid = otid(), lane = tid & 63, wave = tid >> 6;
  const int g = quarter * 4 + wave;
  float* su = (float*)smem;
  const float* uC = (const float*)(p.ws + OFF_UC);
  for (int e = tid; e < 64 * 16; e += 256) {
    int i = e >> 4, c4 = e & 15;
    *(float4*)(su + i * 64 + c4 * 4) = *(const float4*)(uC + (size_t)(cid * 64 + i) * 256 + quarter * 64 + c4 * 4);
  }
  float a_re, a_im, b_re[16], b_im[16];
  s5_coeffs(p, l, dir, g, lane, a_re, a_im, b_re, b_im);
  u16* wl = (u16*)(smem + 16384 + wave * S5_WAVE_LDS);
  u16* busw = wl + 2176;
  u16* sbw = wl + 4352;
  bf16x8 bfrag[8];
  s5_bfrags(sbw, b_re, b_im, lane, bfrag);
  __syncthreads();
  float h_re = 0.f, h_im = 0.f;
  for (int s4 = 0; s4 < 4; ++s4) {
    s5_bu_slab(su, wave, dir, s4, lane, bfrag, busw);
#pragma unroll
    for (int r = 0; r < 16; ++r) {
      const float bu_re = bf2f(busw[r * 136 + lane]), bu_im = bf2f(busw[r * 136 + 64 + lane]);
      float nr = a_re * h_re - a_im * h_im + bu_re;
      float ni = a_re * h_im + a_im * h_re + bu_im;
      h_re = nr; h_im = ni;
    }
    s5_wave_sync();
  }
  float2* E = (float2*)(p.ws + OFF_S5E);
  E[((size_t)(cid * 2 + dir) * 16 + g) * 64 + lane] = make_float2(h_re, h_im);
  __syncthreads();
}

DI int chain_cid(int dir, int pos) { return dir == 0 ? pos : (pos < 4 ? 3 - pos : 263 - pos); }

DI void s5_carry(const Params& p, int l, int sblk) {
  const int id = sblk * 256 + otid();
  const int dir = id >> 10, g = (id >> 6) & 15, pp = id & 63;
  const int gi = (l * 2 + dir) * 16 + g;
  const float lr = p.A_re[gi * 64 + pp], lim = p.A_im[gi * 64 + pp];
  const float dt = expf(p.log_dt[gi]);
  const float mag = expf(lr * dt);
  float sn, cs;
  sincosf(lim * dt, &sn, &cs);
  float ar = mag * cs, ai = mag * sn;
#pragma unroll
  for (int i = 0; i < 6; ++i) { float nr = ar * ar - ai * ai, ni = 2.f * ar * ai; ar = nr; ai = ni; }
  const float2* E = (const float2*)(p.ws + OFF_S5E);
  float2* H = (float2*)(p.ws + OFF_S5H);
  float hr = 0.f, hi = 0.f;
  asm volatile("" : "+v"(hr), "+v"(hi));
  for (int pos0 = 0; pos0 < NCH; pos0 += 20) {
    float2 e[20];
    size_t o[20];
#pragma unroll
    for (int u = 0; u < 20; ++u) {
      int cid = chain_cid(dir, pos0 + u);
      o[u] = ((size_t)(cid * 2 + dir) * 16 + g) * 64 + pp;
      e[u] = E[o[u]];
    }
#pragma unroll
    for (int u = 0; u < 20; ++u) {
      H[o[u]] = make_float2(hr, hi);
      float nr = ar * hr - ai * hi + e[u].x;
      float ni = ar * hi + ai * hr + e[u].y;
      hr = nr; hi = ni;
    }
  }
}

DI void s5_c_item(const Params& p, int l, int item, char* smem) {
  const int quarter = item & 3, cid = item >> 2;
  const int tid = otid(), lane = tid & 63, wave = tid >> 6;
  const int g = quarter * 4 + wave;
  float* su = (float*)smem;
  u16* hs = (u16*)(smem + 16384 + wave * S5_WAVE_LDS);
  u16* busw = hs + 2176;
  u16* sbw = hs + 4352;
  const float* uC = (const float*)(p.ws + OFF_UC);
  const float2* Hin = (const float2*)(p.ws + OFF_S5H);
  u16* zg = (u16*)(p.ws + OFF_QB);
  for (int e = tid; e < 64 * 16; e += 256) {
    int i = e >> 4, c4 = e & 15;
    *(float4*)(su + i * 64 + c4 * 4) = *(const float4*)(uC + (size_t)(cid * 64 + i) * 256 + quarter * 64 + c4 * 4);
  }
  __syncthreads();
  const int cc = lane & 15, q4 = lane >> 4;
  f32x4 yacc[4];
#pragma unroll
  for (int t = 0; t < 4; ++t) yacc[t] = (f32x4){0.f, 0.f, 0.f, 0.f};
#pragma unroll
  for (int dir = 0; dir < 2; ++dir) {
    float a_re, a_im, b_re[16], b_im[16];
    s5_coeffs(p, l, dir, g, lane, a_re, a_im, b_re, b_im);
    bf16x8 cf[4];
    {
      const size_t cb = ((size_t)((l * 2 + dir) * 16 + g) * 16 + cc) * 64;
#pragma unroll
      for (int s = 0; s < 4; ++s) {
        const float* src = (s < 2 ? p.C_re : p.C_im) + cb + 32 * (s & 1) + 8 * q4;
        const float sgn = (s < 2) ? 1.f : -1.f;
        float4 v0 = *(const float4*)src, v1 = *(const float4*)(src + 4);
        cf[s] = mk8u(pk2(sgn * v0.x, sgn * v0.y), pk2(sgn * v0.z, sgn * v0.w), pk2(sgn * v1.x, sgn * v1.y),
                     pk2(sgn * v1.z, sgn * v1.w));
      }
    }
    bf16x8 bfrag[8];
    s5_bfrags(sbw, b_re, b_im, lane, bfrag);
    float2 h0 = Hin[((size_t)(cid * 2 + dir) * 16 + g) * 64 + lane];
    float h_re = h0.x, h_im = h0.y;
#pragma unroll
    for (int s = 0; s < 4; ++s) {
      s5_bu_slab(su, wave, dir, s, lane, bfrag, busw);
#pragma unroll
      for (int r = 0; r < 16; ++r) {
        const float bu_re = bf2f(busw[r * 136 + lane]), bu_im = bf2f(busw[r * 136 + 64 + lane]);
        float nr = a_re * h_re - a_im * h_im + bu_re;
        float ni = a_re * h_im + a_im * h_re + bu_im;
        h_re = nr; h_im = ni;
        const int rr = dir ? 15 - r : r;
        hs[rr * 136 + lane] = f2bf(h_re);
        hs[rr * 136 + 64 + lane] = f2bf(h_im);
      }
      asm volatile("s_waitcnt lgkmcnt(0)" ::: "memory");
      const int tile = dir ? 3 - s : s;
#pragma unroll
      for (int ks = 0; ks < 4; ++ks) {
        bf16x8 a = *(const bf16x8*)(hs + cc * 136 + 32 * ks + 8 * q4);
        yacc[tile] = MFMA16(a, cf[ks], yacc[tile]);
      }
      asm volatile("s_waitcnt lgkmcnt(0)" ::: "memory");
    }
  }
  const int ch = g * 16 + cc;
  const float dsk = p.Dskip[l * 256 + ch];
#pragma unroll
  for (int tile = 0; tile < 4; ++tile)
#pragma unroll
    for (int j = 0; j < 4; ++j) {
      const int t = 16 * tile + 4 * q4 + j;
      float y = yacc[tile][j] + su[t * 64 + wave * 16 + cc] * dsk;
      zg[(size_t)(cid * 64 + t) * 256 + ch] = f2bf(gelu_tanh(y));
    }
  __syncthreads();
}

DI void dn_out_item(const Params& p, int l, int unit, char* smem) {
  const int cid = unit >> 2, head = unit & 3;
  const int tid = otid(), lane = tid & 63, wave = tid >> 6;
  const int lr = lane & 31, lh = lane >> 5;
  float* so = (float*)smem;
  const u16* gates = (const u16*)(p.ws + OFF_GATES);
  u16* mix = (u16*)(p.ws + OFF_H);
  const int dir = wave >> 1, mt = wave & 1;
  const u16* dnd = (const u16*)(p.ws + OFF_DN) + ((size_t)unit * 2 + dir) * 5 * 4096;
  const u16* Pm = dnd + 2 * 4096, *RT = dnd + 3 * 4096, *ST = dnd + 4 * 4096;
  f32x16 acc[2];
#pragma unroll
  for (int nt = 0; nt < 2; ++nt)
#pragma unroll
    for (int i = 0; i < 16; ++i) acc[nt][i] = 0.f;
#pragma unroll
  for (int ks = 0; ks < 4; ++ks) {
    bf16x8 a = *(const bf16x8*)(Pm + (mt * 32 + lr) * 64 + ks * 16 + lh * 8);
#pragma unroll
    for (int nt = 0; nt < 2; ++nt) {
      bf16x8 b = *(const bf16x8*)(ST + (nt * 32 + lr) * 64 + ks * 16 + lh * 8);
      acc[nt] = MFMA32(a, b, acc[nt]);
    }
  }
#pragma unroll
  for (int nt = 0; nt < 2; ++nt)
#pragma unroll
    for (int g4 = 0; g4 < 4; ++g4) {
      uint2 rr = *(const uint2*)(RT + (nt * 32 + lr) * 64 + mt * 32 + 8 * g4 + 4 * lh);
      acc[nt][4 * g4 + 0] += bf2f((u16)(rr.x & 0xffff));
      acc[nt][4 * g4 + 1] += bf2f((u16)(rr.x >> 16));
      acc[nt][4 * g4 + 2] += bf2f((u16)(rr.y & 0xffff));
      acc[nt][4 * g4 + 3] += bf2f((u16)(rr.y >> 16));
    }
  if (dir == 0) {
#pragma unroll
    for (int nt = 0; nt < 2; ++nt)
#pragma unroll
      for (int i = 0; i < 16; ++i) {
        const int li = mt * 32 + (i & 3) + 8 * (i >> 2) + 4 * lh;
        so[li * 65 + nt * 32 + lr] = acc[nt][i];
      }
  }
  __syncthreads();
  if (dir == 1) {
#pragma unroll
    for (int nt = 0; nt < 2; ++nt)
#pragma unroll
      for (int i = 0; i < 16; ++i) {
        const int li = mt * 32 + (i & 3) + 8 * (i >> 2) + 4 * lh;
        so[(63 - li) * 65 + nt * 32 + lr] += acc[nt][i];
      }
  }
  __syncthreads();
  const float gain = p.out_gain[l * 64 + lane];
#pragma unroll
  for (int i0 = 0; i0 < 16; ++i0) {
    const int i = wave + 4 * i0;
    const size_t tt = (size_t)cid * 64 + i;
    const int c = head * 64 + lane;
    float o = so[i * 65 + lane];
    float ms = wave_sum(o * o) * (1.f / 64.f);
    float v = o * rsqrtf(ms + EPS) * gain * bf2f(gates[tt * 1024 + 512 + c]);
    mix[tt * 1024 + 512 + c] = f2bf(v);
  }
  __syncthreads();
}

#define SCAN_LOAD(U, POS)                                                                      \
  {                                                                                            \
    const int cid_ = chain_cid(dir, (POS));                                                    \
    const u16* base_ = dnb + ((size_t)(cid_ * 4 + head) * 2 + dir) * 5 * 4096;                 \
    _Pragma("unroll") for (int m = 0; m < 4; ++m) {                                            \
      _Pragma("unroll") for (int s2 = 0; s2 < 2; ++s2) {                                       \
        const uint4 t_ = *(const uint4*)(base_ + ((m * 2 + s2) * 64 + lane) * 8);              \
        mlo##U[m][s2] = make_uint2(t_.x, t_.y);                                                \
        mhi##U[m][s2] = make_uint2(t_.z, t_.w);                                                \
      }                                                                                        \
    }                                                                                          \
    {                                                                                          \
      const uint4 t0_ = *(const uint4*)(base_ + 4096 + (cgp * 64 + lane) * 16);                \
      const uint4 t1_ = *(const uint4*)(base_ + 4096 + (cgp * 64 + lane) * 16 + 8);            \
      ntv##U[0] = make_uint2(t0_.x, t0_.y); ntv##U[1] = make_uint2(t0_.z, t0_.w);              \
      ntv##U[2] = make_uint2(t1_.x, t1_.y); ntv##U[3] = make_uint2(t1_.z, t1_.w);              \
    }                                                                                          \
    gl##U = glast[(cid_ * 4 + head) * 2 + dir];                                                \
  }
#define SCAN_COMPUTE(U, POS)                                                                   \
  {                                                                                            \
    const int cid_ = chain_cid(dir, (POS));                                                    \
    u16* STp_ = dnb + (((size_t)(cid_ * 4 + head) * 2 + dir) * 5 + 4) * 4096 + dv * 64 + 4 * q4; \
    unsigned pk_[4][2];                                                                        \
    _Pragma("unroll") for (int m = 0; m < 4; ++m) {                                            \
      pk_[m][0] = pk2(S[m][0], S[m][1]);                                                       \
      pk_[m][1] = pk2(S[m][2], S[m][3]);                                                       \
      *(uint2*)(STp_ + 16 * m) = make_uint2(pk_[m][0], pk_[m][1]);                             \
    }                                                                                          \
    bf16x8 sb0_ = mk8u(pk_[0][0], pk_[0][1], pk_[1][0], pk_[1][1]);                            \
    bf16x8 sb1_ = mk8u(pk_[2][0], pk_[2][1], pk_[3][0], pk_[3][1]);                            \
    _Pragma("unroll") for (int m = 0; m < 4; ++m) {                                            \
      f32x4 acc_ = {0.f, 0.f, 0.f, 0.f};                                                       \
      acc_ = MFMA16(mk8(mlo##U[m][0], mhi##U[m][0]), sb0_, acc_);                              \
      acc_ = MFMA16(mk8(mlo##U[m][1], mhi##U[m][1]), sb1_, acc_);                              \
      S[m][0] = gl##U * S[m][0] - acc_[0] + bf2f((u16)(ntv##U[m].x & 0xffff));                 \
      S[m][1] = gl##U * S[m][1] - acc_[1] + bf2f((u16)(ntv##U[m].x >> 16));                    \
      S[m][2] = gl##U * S[m][2] - acc_[2] + bf2f((u16)(ntv##U[m].y & 0xffff));                 \
      S[m][3] = gl##U * S[m][3] - acc_[3] + bf2f((u16)(ntv##U[m].y >> 16));                    \
    }                                                                                          \
  }
DI void dn_scan_wave(const Params& p, int task) {
  const int head = task & 3, dir = (task >> 2) & 1, cgp = task >> 3;
  const int lane = otid() & 63;
  const int cn = lane & 15, q4 = lane >> 4;
  const int dv = cgp * 16 + cn;
  u16* dnb = (u16*)(p.ws + OFF_DN);
  const float* glast = (const float*)(p.ws + OFF_GLAST);
  f32x4 S[4];
#pragma unroll
  for (int m = 0; m < 4; ++m) S[m] = (f32x4){0.f, 0.f, 0.f, 0.f};
  uint2 mlo0[4][2], mhi0[4][2], ntv0[4]; float gl0;
  uint2 mlo1[4][2], mhi1[4][2], ntv1[4]; float gl1;
  uint2 mlo2[4][2], mhi2[4][2], ntv2[4]; float gl2;
  uint2 mlo3[4][2], mhi3[4][2], ntv3[4]; float gl3;
  SCAN_LOAD(0, 0) SCAN_LOAD(1, 1) SCAN_LOAD(2, 2) SCAN_LOAD(3, 3)
  for (int pos0 = 0; pos0 < NCH; pos0 += 4) {
    const bool more = pos0 + 4 < NCH;
    SCAN_COMPUTE(0, pos0) if (more) SCAN_LOAD(0, pos0 + 4)
    SCAN_COMPUTE(1, pos0 + 1) if (more) SCAN_LOAD(1, pos0 + 5)
    SCAN_COMPUTE(2, pos0 + 2) if (more) SCAN_LOAD(2, pos0 + 6)
    SCAN_COMPUTE(3, pos0 + 3) if (more) SCAN_LOAD(3, pos0 + 7)
  }
}

constexpr int A_LD = 72;
constexpr int V_LD = 136;
DI void attn_item(const Params& p, int item, char* smem) {
  int head, q0, ntiles;
  if (item < 512) { head = item & 7; q0 = NCTX + (item >> 3) * 256; ntiles = NCH; }
  else { head = item - 512; q0 = 0; ntiles = 4; }
  const int kvh = head >> 2;
  const int tid = otid(), lane = tid & 63, wave = tid >> 6;
  const int lr = lane & 31, lh = lane >> 5;
  const u16* Qb = (const u16*)(p.ws + OFF_QB) + (size_t)head * T * 64;
  const u16* Kb = (const u16*)(p.ws + OFF_KB) + (size_t)kvh * T * 64;
  const u16* Vt = (const u16*)(p.ws + OFF_VT) + (size_t)kvh * 64 * T;
  u16* Ks = (u16*)smem;
  u16* Vs = Ks + 2 * 128 * A_LD;
  bf16x8 qf[2][4];
#pragma unroll
  for (int qt = 0; qt < 2; ++qt)
#pragma unroll
    for (int ks = 0; ks < 4; ++ks)
      qf[qt][ks] = *(const bf16x8*)(Qb + (size_t)(q0 + wave * 64 + qt * 32 + lr) * 64 + ks * 16 + lh * 8);

  f32x16 ot[2][2];
#pragma unroll
  for (int a = 0; a < 2; ++a)
#pragma unroll
    for (int b = 0; b < 2; ++b)
#pragma unroll
      for (int i = 0; i < 16; ++i) ot[a][b][i] = 0.f;
  float lrun[2] = {0.f, 0.f};

  uint4 rk0, rk1, rv0, rv1;
  const int srow = tid >> 3, sch = tid & 7;
  const u16* Kg = Kb + (size_t)srow * 64 + sch * 8;
  const u16* Vg = Vt + (size_t)srow * T + sch * 8;
#define A_LOAD(J_)                                                               \
  {                                                                              \
    const u16* kg_ = Kg + (size_t)(J_) * 4096;                                   \
    const u16* vg_ = Vg + (size_t)(J_) * 64;                                     \
    rk0 = *(const uint4*)(kg_);  rk1 = *(const uint4*)(kg_ + 32 * 64);           \
    rv0 = *(const uint4*)(vg_);  rv1 = *(const uint4*)(vg_ + (size_t)32 * T);    \
  }
#define A_STORE(BUF_, HALF_)                                                     \
  {                                                                              \
    u16* ks_ = Ks + ((BUF_) * 128 + (HALF_) * 64 + srow) * A_LD + sch * 8;       \
    u16* vs_ = Vs + ((BUF_) * 64 + srow) * V_LD + (HALF_) * 64 + sch * 8;        \
    *(uint4*)(ks_) = rk0;  *(uint4*)(ks_ + 32 * A_LD) = rk1;                     \
    *(uint4*)(vs_) = rv0;  *(uint4*)(vs_ + 32 * V_LD) = rv1;                     \
  }
  A_LOAD(0)
  A_STORE(0, 0)
  A_LOAD(1)
  A_STORE(0, 1)
  __syncthreads();
  const int npairs = ntiles >> 1;
  for (int jj = 0; jj < npairs; ++jj) {
    const int buf = jj & 1;
    const int jnext = (jj + 1 < npairs ? jj + 1 : jj) * 2;
#pragma unroll 1
    for (int half = 0; half < 2; ++half) {
    A_LOAD(jnext + half)
    __builtin_amdgcn_sched_barrier(0);
    const u16* Kt = Ks + (buf * 128 + half * 64) * A_LD;
    const u16* Vtile = Vs + buf * 64 * V_LD + half * 64;
    f32x16 st[2][2];
#pragma unroll
    for (int a = 0; a < 2; ++a)
#pragma unroll
      for (int b = 0; b < 2; ++b)
#pragma unroll
        for (int i = 0; i < 16; ++i) st[a][b][i] = 0.f;
    {
      bf16x8 kf[2][4];
#pragma unroll
      for (int kt = 0; kt < 2; ++kt)
#pragma unroll
        for (int ks = 0; ks < 4; ++ks) kf[kt][ks] = *(const bf16x8*)(Kt + (kt * 32 + lr) * A_LD + ks * 16 + lh * 8);
      __builtin_amdgcn_sched_barrier(0);
#pragma unroll
      for (int kt = 0; kt < 2; ++kt)
#pragma unroll
        for (int ks = 0; ks < 4; ++ks) {
          st[kt][0] = MFMA32(kf[kt][ks], qf[0][ks], st[kt][0]);
          st[kt][1] = MFMA32(kf[kt][ks], qf[1][ks], st[kt][1]);
        }
    }
#pragma unroll
    for (int kt = 0; kt < 2; ++kt) {
#pragma unroll
      for (int qt = 0; qt < 2; ++qt) {
        float ls0 = 0.f, ls1 = 0.f;
#pragma unroll
        for (int i = 0; i < 16; i += 2) {
          float p0 = __builtin_amdgcn_exp2f(st[kt][qt][i]);
          float p1 = __builtin_amdgcn_exp2f(st[kt][qt][i + 1]);
          st[kt][qt][i] = p0;
          st[kt][qt][i + 1] = p1;
          ls0 += p0;
          ls1 += p1;
        }
        lrun[qt] += ls0 + ls1;
      }
#pragma unroll
      for (int ss = 0; ss < 2; ++ss) {
        bf16x8 pb[2];
#pragma unroll
        for (int qt = 0; qt < 2; ++qt)
          pb[qt] = mk8u(pk2(st[kt][qt][8 * ss + 0], st[kt][qt][8 * ss + 1]), pk2(st[kt][qt][8 * ss + 2], st[kt][qt][8 * ss + 3]),
                        pk2(st[kt][qt][8 * ss + 4], st[kt][qt][8 * ss + 5]), pk2(st[kt][qt][8 * ss + 6], st[kt][qt][8 * ss + 7]));
#pragma unroll
        for (int dt = 0; dt < 2; ++dt) {
          const u16* pr = Vtile + (dt * 32 + lr) * V_LD + 32 * kt + 16 * ss + 4 * lh;
          uint2 lo = *(const uint2*)pr;
          uint2 hi = *(const uint2*)(pr + 8);
          bf16x8 a = mk8(lo, hi);
#pragma unroll
          for (int qt = 0; qt < 2; ++qt) ot[dt][qt] = MFMA32(a, pb[qt], ot[dt][qt]);
        }
      }
    }
    __builtin_amdgcn_sched_barrier(0);
    A_STORE(buf ^ 1, half)
    }
    __syncthreads();
  }
  const u16* gates = (const u16*)(p.ws + OFF_GATES);
  u16* mix = (u16*)(p.ws + OFF_H);
#pragma unroll
  for (int qt = 0; qt < 2; ++qt) {
    const float lt = lrun[qt] + __shfl_xor(lrun[qt], 32);
    const float inv = 1.f / lt;
    const size_t row = (size_t)(q0 + wave * 64 + qt * 32 + lr);
#pragma unroll
    for (int dt = 0; dt < 2; ++dt)
#pragma unroll
      for (int g4 = 0; g4 < 4; ++g4) {
        const int d0 = 32 * dt + 8 * g4 + 4 * lh;
        uint2 gg = *(const uint2*)(gates + row * 1024 + head * 64 + d0);
        float o0 = ot[dt][qt][4 * g4 + 0] * inv * bf2f((u16)(gg.x & 0xffff));
        float o1 = ot[dt][qt][4 * g4 + 1] * inv * bf2f((u16)(gg.x >> 16));
        float o2 = ot[dt][qt][4 * g4 + 2] * inv * bf2f((u16)(gg.y & 0xffff));
        float o3 = ot[dt][qt][4 * g4 + 3] * inv * bf2f((u16)(gg.y >> 16));
        uint2 o = {pk2(o0, o1), pk2(o2, o3)};
        *(uint2*)(mix + row * 1024 + head * 64 + d0) = o;
      }
  }
}

DI void final_ln_phase(const Params& p, int l, const float* ctx_src, const float* lat_src) {
  const int lane = otid() & 63, wave = otid() >> 6;
  const int nw = gridDim.x * 4;
  const float* y = (const float*)(p.ws + OFF_DN);
  const float* modv = (const float*)(p.ws + OFF_MODV);
  float* ctx1 = (float*)(p.ws + OFF_CTX1);
  u16* h = (u16*)(p.ws + OFF_H);
  const int rstart = (l == 1) ? NCTX : 0;
  for (int r = rstart + blockIdx.x * 4 + wave; r < T; r += nw) {
    const bool isc = r < NCTX;
    const float* src = isc ? ctx_src + (size_t)r * DM : lat_src + (size_t)(r - NCTX) * DM;
    float* dst = isc ? ctx1 + (size_t)r * DM : p.out + (size_t)(r - NCTX) * DM;
    const float* mod = modv + (l * 2 + (isc ? 1 : 0)) * 3072;
    float4 v[4];
    float s = 0.f;
#pragma unroll
    for (int i = 0; i < 4; ++i) {
      int c0 = (i * 64 + lane) * 4;
      float4 xv = *(const float4*)(src + c0);
      float4 yv = *(const float4*)(y + (size_t)r * DM + c0);
      float4 gv = *(const float4*)(mod + 2048 + c0);
      v[i].x = DN_ALPHA * xv.x + gv.x * yv.x;
      v[i].y = DN_ALPHA * xv.y + gv.y * yv.y;
      v[i].z = DN_ALPHA * xv.z + gv.z * yv.z;
      v[i].w = DN_ALPHA * xv.w + gv.w * yv.w;
      s += v[i].x + v[i].y + v[i].z + v[i].w;
    }
    float mu = wave_sum(s) * (1.f / DM);
    float q = 0.f;
#pragma unroll
    for (int i = 0; i < 4; ++i) {
      v[i].x -= mu; v[i].y -= mu; v[i].z -= mu; v[i].w -= mu;
      q += v[i].x * v[i].x + v[i].y * v[i].y + v[i].z * v[i].z + v[i].w * v[i].w;
    }
    float rstd = rsqrtf(wave_sum(q) * (1.f / DM) + EPS);
    float s2 = 0.f;
#pragma unroll
    for (int i = 0; i < 4; ++i) {
      int c0 = (i * 64 + lane) * 4;
      float4 g = *(const float4*)(p.ln_g + l * DM + c0);
      float4 b = *(const float4*)(p.ln_b + l * DM + c0);
      v[i].x = v[i].x * rstd * g.x + b.x;
      v[i].y = v[i].y * rstd * g.y + b.y;
      v[i].z = v[i].z * rstd * g.z + b.z;
      v[i].w = v[i].w * rstd * g.w + b.w;
      *(float4*)(dst + c0) = v[i];
      s2 += v[i].x + v[i].y + v[i].z + v[i].w;
    }
    if (l == 0) {
      const float* mod1 = modv + (2 + (isc ? 1 : 0)) * 3072;
      float mu2 = wave_sum(s2) * (1.f / DM);
      float q2 = 0.f;
#pragma unroll
      for (int i = 0; i < 4; ++i) {
        v[i].x -= mu2; v[i].y -= mu2; v[i].z -= mu2; v[i].w -= mu2;
        q2 += v[i].x * v[i].x + v[i].y * v[i].y + v[i].z * v[i].z + v[i].w * v[i].w;
      }
      float rstd2 = rsqrtf(wave_sum(q2) * (1.f / DM) + EPS);
#pragma unroll
      for (int i = 0; i < 4; ++i) {
        int c0 = (i * 64 + lane) * 4;
        float4 sh = *(const float4*)(mod1 + c0);
        float4 sc = *(const float4*)(mod1 + 1024 + c0);
        float o0 = v[i].x * rstd2 * (1.f + sc.x) + sh.x;
        float o1 = v[i].y * rstd2 * (1.f + sc.y) + sh.y;
        float o2 = v[i].z * rstd2 * (1.f + sc.z) + sh.z;
        float o3 = v[i].w * rstd2 * (1.f + sc.w) + sh.w;
        uint2 pk = {pk2(o0, o1), pk2(o2, o3)};
        *(uint2*)(h + (size_t)r * DM + c0) = pk;
      }
    }
  }
}

#ifndef REP_ATTN
#define REP_ATTN 1
#endif
#ifndef REP_SCAN
#define REP_SCAN 1
#endif
#ifndef REP_GEMM
#define REP_GEMM 1
#endif
#ifndef REP_PREP
#define REP_PREP 1
#endif
#ifndef REP_P5
#define REP_P5 1
#endif
typedef const __attribute__((address_space(4))) Params* KParamsPtr;
DI const Params& kp() {
  KParamsPtr q = (KParamsPtr)__builtin_amdgcn_kernarg_segment_ptr();
  asm volatile("" : "+s"(q));
  return *(const Params*)q;
}
__global__ void __launch_bounds__(256, 2) fwd_megakernel(Params pin) {
  cg::grid_group grid = cg::this_grid();
  __shared__ __attribute__((aligned(16))) char smem[SMEM_BYTES];
  const int nb = gridDim.x;
  __shared__ uint4 xb_words;
  if (threadIdx.x == 0) xb_words = make_uint4(0u, 0u, 0u, 0u);
  __syncthreads();
  (void)xcd_barrier_post((unsigned*)(kp().ws + OFF_BAR), (volatile LAS unsigned*)&xb_words);
#define GRID_BARRIER() do { XcdBarrier xb_; xb_.bar = (unsigned*)(kp().ws + OFF_BAR); xb_.x = xb_xcc_id(); xb_.st = (volatile LAS unsigned*)&xb_words; xcd_barrier(xb_); } while (0)

  if (kp().ws == nullptr) grid.sync();
  setup_phase(kp(), smem);
  GRID_BARRIER();
  { const Params& p = kp(); ln_mod_phase(p, p.ctx, p.x, 0); }
  GRID_BARRIER();

  for (int l = 0; l < 2; ++l) {
    for (int rep = 0; rep < REP_GEMM; ++rep) gemm_in_phase(kp(), l, smem);
    GRID_BARRIER();
    {
      const int nx = (nb > 64 && nb < 1040) ? (1040 % nb) : 0;
      for (int item = blockIdx.x; item < 1040; item += nb) dn_prep_item(kp(), l, item, smem);
      if ((int)blockIdx.x >= nx)
        for (int item = (int)blockIdx.x - nx; item < 2080; item += nb - nx) s5_a_item(kp(), l, item, smem);
    }
    GRID_BARRIER();
    for (int rep = 0; rep < REP_SCAN; ++rep)
    for (int item = blockIdx.x; item < 40; item += nb) {
      if (item < 32) { if ((otid() >> 6) == 0) dn_scan_wave(kp(), item); }
      else s5_carry(kp(), l, item - 32);
    }
    GRID_BARRIER();
    {
      const int nattn = (l == 1) ? 512 : 520;
      for (int rep = 0; rep < REP_ATTN; ++rep)
        for (int item = blockIdx.x; item < nattn; item += nb) attn_item(kp(), item, smem);
    }
    GRID_BARRIER();
    {
      const int skip = (l == 1) ? 16 : 0;
      const int nper = 1040 - skip;
      for (int rep = 0; rep < REP_P5; ++rep)
      for (int item = blockIdx.x; item < 2 * nper; item += nb) {
        if (item < nper) s5_c_item(kp(), l, item + skip, smem);
        else dn_out_item(kp(), l, item - nper + skip, smem);
      }
    }
    GRID_BARRIER();
    gemm_glu_phase(kp(), l, smem);
    GRID_BARRIER();
    gemm_out_phase(kp(), l, smem);
    GRID_BARRIER();
    {
      const Params& p = kp();
      if (l == 0) final_ln_phase(p, 0, p.ctx, p.x);
      else final_ln_phase(p, 1, (const float*)(p.ws + OFF_CTX1), p.out);
    }
    if (l == 0) GRID_BARRIER();
  }
}

extern "C" void kernel_launch(void* const* d_in, const int* in_sizes, int n_in, void* d_out, int out_size, void* d_ws,
                              size_t ws_size, hipStream_t stream) {
  static int grid_blocks = 0;
  if (!grid_blocks) {
    int dev = 0, cus = 0, per_cu = 0;
    hipGetDevice(&dev);
    hipDeviceGetAttribute(&cus, hipDeviceAttributeMultiprocessorCount, dev);
    hipOccupancyMaxActiveBlocksPerMultiprocessor(&per_cu, fwd_megakernel, 256, 0);
    if (per_cu > 2) per_cu = 2;
    if (per_cu < 1) per_cu = 1;
    grid_blocks = cus * per_cu;
  }
  Params p{};
  const float** pp = (const float**)&p;
  for (int i = 0; i < 26; ++i) pp[i] = (const float*)d_in[i];
  p.out = (float*)d_out;
  p.ws = (char*)d_ws;
  void* args[] = {&p};
  (void)hipMemsetAsync((char*)d_ws + OFF_BAR, 0, XCD_BAR_WORDS * 4, stream);
  hipError_t e = hipLaunchCooperativeKernel((void*)fwd_megakernel, dim3(grid_blocks), dim3(256), args, 0, stream);
  if (e != hipSuccess) fprintf(stderr, "cooperative launch failed: %s (grid %d)\n", hipGetErrorString(e), grid_blocks);
}
```

```cpp
#include <hip/hip_runtime.h>
#include <hip/hip_cooperative_groups.h>
#include <cstdio>
namespace cg = cooperative_groups;

#define DI __device__ __forceinline__
typedef unsigned short u16;
using bf16x8 = __attribute__((ext_vector_type(8))) short;
using f32x16 = __attribute__((ext_vector_type(16))) float;
using f32x4 = __attribute__((ext_vector_type(4))) float;
typedef __bf16 bf2_t __attribute__((ext_vector_type(2)));
typedef float f2_t __attribute__((ext_vector_type(2)));

#define MFMA32(a, b, c) __builtin_amdgcn_mfma_f32_32x32x16_bf16((a), (b), (c), 0, 0, 0)
#define MFMA16(a, b, c) __builtin_amdgcn_mfma_f32_16x16x32_bf16((a), (b), (c), 0, 0, 0)

constexpr int T = 16640;
constexpr int NCTX = 256;
constexpr int DM = 1024;
constexpr int NIN = 2832;
constexpr int NINP = 2944;
constexpr int NCH = 260;
constexpr float EPS = 1e-6f;
constexpr float DN_ALPHA = 1.4142135623730951f;

constexpr size_t al256(size_t x) { return (x + 255) & ~(size_t)255; }
constexpr size_t OFF_WINT = 0;
constexpr size_t OFF_WOUTT = OFF_WINT + al256((size_t)2 * NINP * 1024 * 2);
constexpr size_t OFF_GLUWT = OFF_WOUTT + al256((size_t)2 * 1024 * 1024 * 2);
constexpr size_t OFF_MODV = OFF_GLUWT + al256((size_t)2 * 256 * 256 * 2);
constexpr size_t OFF_ROPE = OFF_MODV + al256((size_t)2 * 2 * 3072 * 4);
constexpr size_t OFF_H = OFF_ROPE + al256((size_t)256 * 16 * 2 * 4);
constexpr size_t OFF_QB = OFF_H + al256((size_t)T * 1024 * 2);
constexpr size_t OFF_KB = OFF_QB + al256((size_t)8 * T * 64 * 2);
constexpr size_t OFF_VT = OFF_KB + al256((size_t)2 * T * 64 * 2);
constexpr size_t OFF_GATES = OFF_VT + al256((size_t)2 * T * 64 * 2);
constexpr size_t OFF_QKVB = OFF_GATES + al256((size_t)T * 1024 * 2);
constexpr size_t OFF_UC = OFF_QKVB + al256((size_t)T * 768 * 2);
constexpr size_t OFF_BD = OFF_UC + al256((size_t)T * 256 * 4);
constexpr size_t OFF_DN = OFF_BD + al256((size_t)T * 16 * 4);
constexpr size_t OFF_GLAST = OFF_DN + al256((size_t)1040 * 2 * 5 * 4096 * 2);
constexpr size_t OFF_S5E = OFF_GLAST + al256((size_t)1040 * 2 * 4);
constexpr size_t OFF_S5H = OFF_S5E + al256((size_t)NCH * 2 * 16 * 64 * 2 * 4);
constexpr size_t OFF_CTX1 = OFF_S5H + al256((size_t)NCH * 2 * 16 * 64 * 2 * 4);
constexpr size_t OFF_BAR = OFF_CTX1 + al256((size_t)256 * 1024 * 4);
constexpr size_t WS_TOTAL = OFF_BAR + 16384;
static_assert(WS_TOTAL <= (size_t)256 * 1024 * 1024, "workspace too large");
static_assert((size_t)T * 1024 * 4 <= (size_t)1040 * 2 * 5 * 4096 * 2, "y alias");

struct Params {
  const float *x, *c, *ctx, *c_ctx, *w_mod, *b_mod, *w_in, *qg, *kg, *conv_w, *A_log, *dt_bias, *out_gain,
      *A_re, *A_im, *log_dt, *B_re, *B_im, *C_re, *C_im, *Dskip, *glu_w, *glu_b, *w_out, *ln_g, *ln_b;
  float* out;
  char* ws;
};

constexpr int SMEM_BYTES = 75 * 1024;

DI float bf2f(u16 v) { return __uint_as_float(((unsigned)v) << 16); }
DI unsigned pk2(float a, float b) {
  f2_t v = {a, b};
  bf2_t r = __builtin_convertvector(v, bf2_t);
  return __builtin_bit_cast(unsigned, r);
}
DI u16 f2bf(float a) { return (u16)(pk2(a, 0.f) & 0xffffu); }
DI float silu_f(float x) { return x / (1.f + __expf(-x)); }
DI float sigmoid_f(float x) { return 1.f / (1.f + __expf(-x)); }
template <int CTRL>
DI float dppf(float v) {
  return __builtin_bit_cast(float, __builtin_amdgcn_update_dpp(0, __builtin_bit_cast(int, v), CTRL, 0xf, 0xf, true));
}
DI float wave_sum(float v) {
  v += dppf<0xB1>(v);
  v += dppf<0x4E>(v);
  v += dppf<0x141>(v);
  v += dppf<0x140>(v);
  v += __shfl_xor(v, 16);
  v += __shfl_xor(v, 32);
  return v;
}
DI int otid() { int t = threadIdx.x; asm volatile("" : "+v"(t)); return t; }
typedef float f4v_t __attribute__((ext_vector_type(4)));
DI float4 nt_load4(const float* p) { f4v_t v = __builtin_nontemporal_load((const f4v_t*)p); return make_float4(v.x, v.y, v.z, v.w); }
DI void nt_store4(float* p, float4 a) { f4v_t v = {a.x, a.y, a.z, a.w}; __builtin_nontemporal_store(v, (f4v_t*)p); }
DI float gelu_tanh(float x) {
  float u = 0.7978845608028654f * (x + 0.044715f * x * x * x);
  float t = 1.f - 2.f / (1.f + __expf(2.f * u));
  return 0.5f * x * (1.f + t);
}
DI bf16x8 mk8(uint2 lo, uint2 hi) {
  uint4 v = {lo.x, lo.y, hi.x, hi.y};
  return __builtin_bit_cast(bf16x8, v);
}
DI bf16x8 mk8u(unsigned a, unsigned b, unsigned c, unsigned d) {
  uint4 v = {a, b, c, d};
  return __builtin_bit_cast(bf16x8, v);
}


#define XB_TMO      128
#define XB_XCNT(j)  (256  + 64 * (j))
#define XB_XSUB(j)  (1280 + 64 * (j))
#define XB_XGEN(j)  (2304 + 64 * (j))
#define XB_TOP      3328
#define XB_TOPGEN   3392
#define XCD_BAR_WORDS 3456
#define XB_SPIN_CAP (1u << 18)
#define LAS __attribute__((address_space(3)))
DI unsigned xb_ld(unsigned* p) { return __hip_atomic_load(p, __ATOMIC_RELAXED, __HIP_MEMORY_SCOPE_AGENT); }
DI unsigned xb_add(unsigned* p, unsigned v) { return __hip_atomic_fetch_add(p, v, __ATOMIC_RELAXED, __HIP_MEMORY_SCOPE_AGENT); }
DI unsigned xb_xcc_id() { return (unsigned)__builtin_amdgcn_s_getreg((3 << 11) | 20) & 0xFu; }
#define XB_SPIN(cond, bar) do { unsigned _sp = 0; while (cond) { __builtin_amdgcn_s_sleep(1); \
    if ((++_sp & 255u) == 0u) { if (xb_ld(&(bar)[XB_TMO])) break; if (_sp > XB_SPIN_CAP) { atomicAdd(&(bar)[XB_TMO], 1u); break; } } } } while (0)
struct XcdBarrier { unsigned* bar; unsigned x; volatile LAS unsigned* st; };
DI XcdBarrier xcd_barrier_post(unsigned* bar, volatile LAS unsigned* st) {
  XcdBarrier b; b.bar = bar; b.x = xb_xcc_id(); b.st = st;
  if (threadIdx.x == 0) (void)xb_add(&bar[XB_XCNT(b.x)], 1u);
  return b;
}
DI void xcd_barrier_complete(unsigned* bar, unsigned x, unsigned& nloc, unsigned& nx) {
  const unsigned G = gridDim.x * gridDim.y * gridDim.z;
  unsigned sum, cnt, mine, sp = 0u;
  for (;;) {
    sum = 0u; cnt = 0u; mine = 0u;
#pragma unroll
    for (unsigned j = 0; j < 16; ++j) { const unsigned c = xb_ld(&bar[XB_XCNT(j)]); sum += c; cnt += (c > 0u) ? 1u : 0u; mine = (j == x) ? c : mine; }
    if (sum == G) break;
    __builtin_amdgcn_s_sleep(1);
    if ((++sp & 255u) == 0u) { if (xb_ld(&bar[XB_TMO])) break; if (sp > XB_SPIN_CAP) { atomicAdd(&bar[XB_TMO], 1u); break; } }
  }
  nloc = mine > 0u ? mine : 1u; nx = cnt > 0u ? cnt : 1u;
}
DI void xcd_barrier(const XcdBarrier& b) {
  asm volatile("s_waitcnt vmcnt(0)" ::: "memory");
  __syncthreads();
  if (threadIdx.x == 0) {
    unsigned* bar = b.bar;
    __builtin_amdgcn_s_waitcnt(0);
    unsigned nloc = b.st[0], nx = b.st[1];
    if (nloc == 0u) { xcd_barrier_complete(bar, b.x, nloc, nx); b.st[0] = nloc; b.st[1] = nx; }
    const unsigned old = xb_add(&bar[XB_XSUB(b.x)], 1u);
    const unsigned gen = old / nloc;
    if (old + 1u == (gen + 1u) * nloc) {
      __builtin_amdgcn_fence(__ATOMIC_RELEASE, "agent");
      asm volatile("s_waitcnt vmcnt(0)" ::: "memory");
      const unsigned og = xb_add(&bar[XB_TOP], 1u);
      const unsigned tg = og / nx;
      if (og + 1u == (tg + 1u) * nx) xb_add(&bar[XB_TOPGEN], 1u);
      else XB_SPIN(xb_ld(&bar[XB_TOPGEN]) == tg, bar);
      __builtin_amdgcn_fence(__ATOMIC_ACQUIRE, "agent");
      xb_add(&bar[XB_XGEN(b.x)], 1u);
      asm volatile("s_waitcnt vmcnt(0)" ::: "memory");
    } else {
      XB_SPIN(xb_ld(&bar[XB_XGEN(b.x)]) == gen, bar);
      __builtin_amdgcn_fence(__ATOMIC_ACQUIRE, "agent");
      asm volatile("s_waitcnt vmcnt(0)" ::: "memory");
    }
  }
  __syncthreads();
}

DI void transpose_item(const float* __restrict__ src, int src_ld, u16* __restrict__ dst, int dst_ld, int k0, int n0,
                       bool permute_in, char* smem) {
  float* tile = (float*)smem;
  const int tid = otid();
#pragma unroll
  for (int i = 0; i < 16; ++i) {
    int k = i * 4 + (tid >> 6), n = tid & 63;
    int nd = n0 + n, ns = nd;
    if (permute_in) {
      if (nd < 2304) ns = nd;
      else if (nd < 2816) ns = nd + 16;
      else if (nd < 2832) ns = nd - 512;
      else ns = -1;
    }
    float v = (ns >= 0) ? src[(size_t)(k0 + k) * src_ld + ns] : 0.f;
    tile[k * 65 + n] = v;
  }
  __syncthreads();
#pragma unroll 4
  for (int i = 0; i < 16; ++i) {
    int n = i * 4 + (tid >> 6), k = tid & 63;
    dst[(size_t)(n0 + n) * dst_ld + k0 + k] = f2bf(tile[k * 65 + n]);
  }
  __syncthreads();
}

DI void mod_item(const Params& p, int item, char* smem) {
  const int l = item / 96, grp = item % 96;
  float* ssc = (float*)smem;
  float* red = ssc + 2048;
  const int tid = otid();
  for (int i = tid; i < 1024; i += 256) {
    ssc[i] = silu_f(p.c[i]);
    ssc[1024 + i] = silu_f(p.c_ctx[i]);
  }
  __syncthreads();
  const int kq = tid >> 5, n = tid & 31, col = grp * 32 + n;
  const float* w = p.w_mod + (size_t)l * 1024 * 3072 + col;
  float a0 = 0.f, a1 = 0.f;
#pragma unroll 16
  for (int k = kq * 128; k < kq * 128 + 128; ++k) {
    float wv = w[(size_t)k * 3072];
    a0 += ssc[k] * wv;
    a1 += ssc[1024 + k] * wv;
  }
  red[(0 * 8 + kq) * 32 + n] = a0;
  red[(1 * 8 + kq) * 32 + n] = a1;
  __syncthreads();
  if (tid < 64) {
    int v = tid >> 5, nn = tid & 31;
    float s = 0.f;
    for (int q = 0; q < 8; ++q) s += red[(v * 8 + q) * 32 + nn];
    int cc = grp * 32 + nn;
    float* modv = (float*)(p.ws + OFF_MODV);
    modv[(l * 2 + v) * 3072 + cc] = s + p.b_mod[l * 3072 + cc];
  }
  __syncthreads();
}

DI void setup_light_item(const Params& p, int it, char* smem) {
  constexpr int N_A = 2 * 16 * 46, N_B = 2 * 16 * 16, N_C = 2 * 4 * 4;
  if (it < N_A) {
    int l = it / (16 * 46), r = it % (16 * 46);
    int kt = r / 46, nt = r % 46;
    transpose_item(p.w_in + (size_t)l * 1024 * NIN, NIN, (u16*)(p.ws + OFF_WINT) + (size_t)l * NINP * 1024, 1024,
                   kt * 64, nt * 64, true, smem);
    return;
  }
  it -= N_A;
  if (it < N_B) {
    int l = it / 256, r = it % 256;
    int kt = r / 16, nt = r % 16;
    transpose_item(p.w_out + (size_t)l * 1024 * 1024, 1024, (u16*)(p.ws + OFF_WOUTT) + (size_t)l * 1024 * 1024, 1024,
                   kt * 64, nt * 64, false, smem);
    return;
  }
  it -= N_B;
  if (it < N_C) {
    int l = it / 16, r = it % 16;
    int kt = r / 4, nt = r % 4;
    transpose_item(p.glu_w + (size_t)l * 256 * 256, 256, (u16*)(p.ws + OFF_GLUWT) + (size_t)l * 256 * 256, 256,
                   kt * 64, nt * 64, false, smem);
    return;
  }
  float* rope = (float*)(p.ws + OFF_ROPE);
  for (int e = otid(); e < 4096; e += 256) {
    int row = e >> 4, j = e & 15;
    float inv = powf(10000.f, -(float)j / 16.f);
    float ang = (float)row * inv;
    rope[e * 2] = cosf(ang);
    rope[e * 2 + 1] = sinf(ang);
  }
}

DI void setup_phase(const Params& p, char* smem) {
  constexpr int N_LIGHT = 2 * 16 * 46 + 2 * 16 * 16 + 2 * 4 * 4 + 1, N_D = 192;
  const int nb = gridDim.x, b = blockIdx.x;
  if (nb >= N_D + 64) {
    if (b < N_D) { mod_item(p, b, smem); setup_light_item(p, b, smem); }
    else for (int it = b; it < N_LIGHT; it += nb - N_D) setup_light_item(p, it, smem);
  } else {
    for (int item = b; item < N_LIGHT + N_D; item += nb) {
      if (item < N_LIGHT) setup_light_item(p, item, smem);
      else mod_item(p, item - N_LIGHT, smem);
    }
  }
}

DI void ln_mod_phase(const Params& p, const float* ctx_src, const float* lat_src, int l) {
  const int lane = otid() & 63, wave = otid() >> 6;
  const int nw = gridDim.x * 4;
  u16* h = (u16*)(p.ws + OFF_H);
  const float* modv = (const float*)(p.ws + OFF_MODV);
  for (int r = blockIdx.x * 4 + wave; r < T; r += nw) {
    const float* src = (r < NCTX) ? ctx_src + (size_t)r * DM : lat_src + (size_t)(r - NCTX) * DM;
    const float* mod = modv + (l * 2 + (r < NCTX ? 1 : 0)) * 3072;
    float4 v[4];
    float s = 0.f;
#pragma unroll
    for (int i = 0; i < 4; ++i) {
      v[i] = nt_load4(src + (i * 64 + lane) * 4);
      s += v[i].x + v[i].y + v[i].z + v[i].w;
    }
    float mu = wave_sum(s) * (1.f / DM);
    float q = 0.f;
#pragma unroll
    for (int i = 0; i < 4; ++i) {
      v[i].x -= mu; v[i].y -= mu; v[i].z -= mu; v[i].w -= mu;
      q += v[i].x * v[i].x + v[i].y * v[i].y + v[i].z * v[i].z + v[i].w * v[i].w;
    }
    float rstd = rsqrtf(wave_sum(q) * (1.f / DM) + EPS);
#pragma unroll
    for (int i = 0; i < 4; ++i) {
      int c0 = (i * 64 + lane) * 4;
      float4 sh = *(const float4*)(mod + c0);
      float4 sc = *(const float4*)(mod + 1024 + c0);
      float o0 = v[i].x * rstd * (1.f + sc.x) + sh.x;
      float o1 = v[i].y * rstd * (1.f + sc.y) + sh.y;
      float o2 = v[i].z * rstd * (1.f + sc.z) + sh.z;
      float o3 = v[i].w * rstd * (1.f + sc.w) + sh.w;
      uint2 pk = {pk2(o0, o1), pk2(o2, o3)};
      *(uint2*)(h + (size_t)r * DM + c0) = pk;
    }
  }
}

constexpr int G_LDA = 72;
DI void gemm_tile_compute(const u16* __restrict__ A, int lda, const u16* __restrict__ Bt, int ldb, int K, int m0, int n0,
                          char* smem) {
  u16* As = (u16*)smem;
  u16* Bs = As + 2 * 128 * G_LDA;
  const int tid = otid(), lane = tid & 63, wave = tid >> 6;
  const int wm = wave >> 1, wn = wave & 1;
  const int lr = lane & 31, lh = lane >> 5;
  f32x16 acc[2][2];
#pragma unroll
  for (int a = 0; a < 2; ++a)
#pragma unroll
    for (int b = 0; b < 2; ++b)
#pragma unroll
      for (int i = 0; i < 16; ++i) acc[a][b][i] = 0.f;

  const int KT = K / 64;
  uint4 ra0, ra1, ra2, ra3, rb0, rb1, rb2, rb3;
  const int srow = tid >> 3, sch = tid & 7;
  const u16* Ag = A + (size_t)(m0 + srow) * lda + sch * 8;
  const u16* Bg = Bt + (size_t)(n0 + srow) * ldb + sch * 8;
  const size_t a32 = (size_t)32 * lda, b32 = (size_t)32 * ldb;
#define G_LOAD(KT_)                                                                       \
  {                                                                                       \
    const u16* ag_ = Ag + (KT_) * 64;                                                     \
    const u16* bg_ = Bg + (KT_) * 64;                                                     \
    ra0 = *(const uint4*)(ag_);            rb0 = *(const uint4*)(bg_);                    \
    ra1 = *(const uint4*)(ag_ + a32);      rb1 = *(const uint4*)(bg_ + b32);              \
    ra2 = *(const uint4*)(ag_ + 2 * a32);  rb2 = *(const uint4*)(bg_ + 2 * b32);          \
    ra3 = *(const uint4*)(ag_ + 3 * a32);  rb3 = *(const uint4*)(bg_ + 3 * b32);          \
  }
#define G_STORE(BUF_)                                                                     \
  {                                                                                       \
    u16* as_ = As + ((BUF_) * 128 + srow) * G_LDA + sch * 8;                              \
    u16* bs_ = Bs + ((BUF_) * 128 + srow) * G_LDA + sch * 8;                              \
    *(uint4*)(as_) = ra0;                    *(uint4*)(bs_) = rb0;                        \
    *(uint4*)(as_ + 32 * G_LDA) = ra1;       *(uint4*)(bs_ + 32 * G_LDA) = rb1;           \
    *(uint4*)(as_ + 64 * G_LDA) = ra2;       *(uint4*)(bs_ + 64 * G_LDA) = rb2;           \
    *(uint4*)(as_ + 96 * G_LDA) = ra3;       *(uint4*)(bs_ + 96 * G_LDA) = rb3;           \
  }
  G_LOAD(0)
  G_STORE(0)
  __syncthreads();
  for (int kt = 0; kt < KT; ++kt) {
    const int buf = kt & 1;
    const int ktn = kt + 1 < KT ? kt + 1 : kt;
    G_LOAD(ktn)
    __builtin_amdgcn_sched_barrier(0);
    const u16* Ab = As + (buf * 128 + wm * 64 + lr) * G_LDA + lh * 8;
    const u16* Bb = Bs + (buf * 128 + wn * 64 + lr) * G_LDA + lh * 8;
    bf16x8 fa0[4], fa1[4], fb0[4], fb1[4];
#pragma unroll
    for (int ks = 0; ks < 4; ++ks) {
      fa0[ks] = *(const bf16x8*)(Ab + ks * 16);
      fa1[ks] = *(const bf16x8*)(Ab + 32 * G_LDA + ks * 16);
      fb0[ks] = *(const bf16x8*)(Bb + ks * 16);
      fb1[ks] = *(const bf16x8*)(Bb + 32 * G_LDA + ks * 16);
    }
    __builtin_amdgcn_sched_barrier(0);
#pragma unroll
    for (int ks = 0; ks < 4; ++ks) {
      acc[0][0] = MFMA32(fa0[ks], fb0[ks], acc[0][0]);
      acc[0][1] = MFMA32(fa0[ks], fb1[ks], acc[0][1]);
      acc[1][0] = MFMA32(fa1[ks], fb0[ks], acc[1][0]);
      acc[1][1] = MFMA32(fa1[ks], fb1[ks], acc[1][1]);
    }
    __builtin_amdgcn_sched_barrier(0);
    G_STORE(buf ^ 1)
    __syncthreads();
  }
  float* Cs = (float*)smem;
#pragma unroll
  for (int mi = 0; mi < 2; ++mi)
#pragma unroll
    for (int ni = 0; ni < 2; ++ni)
#pragma unroll
      for (int i = 0; i < 16; ++i) {
        int row = wm * 64 + mi * 32 + (i & 3) + 8 * (i >> 2) + 4 * lh;
        int col = wn * 64 + ni * 32 + lr;
        Cs[row * 132 + col] = acc[mi][ni][i];
      }
  __syncthreads();
}

template <bool OUT_BF16, bool SILU>
DI void epi_store(const float* Cs, void* dst, int ld, int m0, int coff, int ncols) {
  const int tid = otid();
  const int cpr = ncols >> 2;
  for (int idx = tid; idx < 128 * cpr; idx += 256) {
    int row = idx / cpr, c4 = idx % cpr;
    float4 v = *(const float4*)(Cs + row * 132 + 4 * c4);
    if (SILU) { v.x = silu_f(v.x); v.y = silu_f(v.y); v.z = silu_f(v.z); v.w = silu_f(v.w); }
    size_t o = (size_t)(m0 + row) * ld + coff + 4 * c4;
    if (OUT_BF16) *(uint2*)((u16*)dst + o) = make_uint2(pk2(v.x, v.y), pk2(v.z, v.w));
    else *(float4*)((float*)dst + o) = v;
  }
}

DI void epi_qk(const Params& p, const float* Cs, int l, int m0, int nt) {
  const int tid = otid();
  const int row = tid & 127, hh = tid >> 7;
  const int gr = m0 + row;
  const bool isk = (nt == 4);
  const float* gain = (isk ? p.kg : p.qg) + l * 64;
  float v[64];
  float ss = 0.f;
#pragma unroll
  for (int d4 = 0; d4 < 16; ++d4) {
    float4 t4 = *(const float4*)(Cs + row * 132 + hh * 64 + d4 * 4);
    v[4 * d4] = t4.x; v[4 * d4 + 1] = t4.y; v[4 * d4 + 2] = t4.z; v[4 * d4 + 3] = t4.w;
    ss += t4.x * t4.x + t4.y * t4.y + t4.z * t4.z + t4.w * t4.w;
  }
  float rinv = rsqrtf(ss * (1.f / 64.f) + EPS);
#pragma unroll
  for (int d = 0; d < 64; ++d) v[d] = v[d] * rinv * gain[d];
  if (gr >= NCTX) {
    const int t = gr - NCTX;
    const float* rope = (const float*)(p.ws + OFF_ROPE);
    const float* rr = rope + (t >> 6) * 32;
    const float* rc = rope + (t & 63) * 32;
#pragma unroll
    for (int j = 0; j < 16; ++j) {
      float c1 = rr[2 * j], s1 = rr[2 * j + 1];
      float a = v[j], b = v[j + 16];
      v[j] = a * c1 - b * s1;
      v[j + 16] = b * c1 + a * s1;
      float c2 = rc[2 * j], s2 = rc[2 * j + 1];
      float a2 = v[32 + j], b2 = v[48 + j];
      v[32 + j] = a2 * c2 - b2 * s2;
      v[48 + j] = b2 * c2 + a2 * s2;
    }
  }
  if (!isk) {
    constexpr float QS = 0.125f * 1.4426950408889634f;
#pragma unroll
    for (int d = 0; d < 64; ++d) v[d] *= QS;
  }
  u16* dst;
  if (isk) dst = (u16*)(p.ws + OFF_KB) + ((size_t)hh * T + gr) * 64;
  else dst = (u16*)(p.ws + OFF_QB) + ((size_t)(2 * nt + hh) * T + gr) * 64;
#pragma unroll
  for (int c = 0; c < 8; ++c) {
    uint4 o = {pk2(v[8 * c], v[8 * c + 1]), pk2(v[8 * c + 2], v[8 * c + 3]), pk2(v[8 * c + 4], v[8 * c + 5]),
               pk2(v[8 * c + 6], v[8 * c + 7])};
    *(uint4*)(dst + 8 * c) = o;
  }
}

DI void epi_v(const Params& p, const float* Cs, int m0) {
  const int tid = otid();
  const int c = tid & 127, half = tid >> 7;
  const int kvh = c >> 6, d = c & 63;
  u16* dst = (u16*)(p.ws + OFF_VT) + ((size_t)kvh * 64 + d) * T + m0 + half * 64;
#pragma unroll
  for (int g = 0; g < 8; ++g) {
    float v[8];
#pragma unroll
    for (int e = 0; e < 8; ++e) v[e] = Cs[(half * 64 + g * 8 + e) * 132 + c];
    uint4 o = {pk2(v[0], v[1]), pk2(v[2], v[3]), pk2(v[4], v[5]), pk2(v[6], v[7])};
    *(uint4*)(dst + g * 8) = o;
  }
}

DI void gemm_in_phase(const Params& p, int l, char* smem) {
  const u16* A = (const u16*)(p.ws + OFF_H);
  const u16* Bt = (const u16*)(p.ws + OFF_WINT) + (size_t)l * NINP * 1024;
  constexpr int MT = T / 128, NT = NINP / 128;
  const float* Cs = (const float*)smem;
  constexpr int NFULL = (MT / 8) * 8 * NT, MREM = MT % 8;
  for (int item = blockIdx.x; item < MT * NT; item += gridDim.x) {
    int mt, nt;
    if (item < NFULL) { const int xcd = item & 7, r = item >> 3; mt = (r / NT) * 8 + xcd; nt = r % NT; }
    else { const int j = item - NFULL; mt = (MT / 8) * 8 + j % MREM; nt = j / MREM; }
    const int m0 = mt * 128;
    gemm_tile_compute(A, 1024, Bt, 1024, 1024, m0, nt * 128, smem);
    if (nt <= 4) epi_qk(p, Cs, l, m0, nt);
    else if (nt == 5) epi_v(p, Cs, m0);
    else if (nt <= 9) epi_store<true, true>(Cs, p.ws + OFF_GATES, 1024, m0, (nt - 6) * 128, 128);
    else if (nt <= 15) epi_store<true, false>(Cs, p.ws + OFF_QKVB, 768, m0, (nt - 10) * 128, 128);
    else if (nt <= 17) epi_store<true, true>(Cs, p.ws + OFF_GATES, 1024, m0, 512 + (nt - 16) * 128, 128);
    else if (nt <= 19) epi_store<false, false>(Cs, p.ws + OFF_UC, 256, m0, (nt - 18) * 128, 128);
    else if (nt <= 21) epi_store<true, true>(Cs, p.ws + OFF_GATES, 1024, m0, 768 + (nt - 20) * 128, 128);
    else epi_store<false, false>(Cs, p.ws + OFF_BD, 16, m0, 0, 16);
    __syncthreads();
  }
}

DI void gemm_glu_phase(const Params& p, int l, char* smem) {
  const u16* A = (const u16*)(p.ws + OFF_QB);
  const u16* Bt = (const u16*)(p.ws + OFF_GLUWT) + (size_t)l * 256 * 256;
  const u16* gates = (const u16*)(p.ws + OFF_GATES);
  u16* mix = (u16*)(p.ws + OFF_H);
  const float* Cs = (const float*)smem;
  constexpr int MT = T / 128;
  for (int item = blockIdx.x; item < MT * 2; item += gridDim.x) {
    const int mt = item >> 1, nt = item & 1;
    const int m0 = mt * 128, n0 = nt * 128;
    gemm_tile_compute(A, 256, Bt, 256, 256, m0, n0, smem);
    for (int idx = otid(); idx < 128 * 64; idx += 256) {
      int row = idx >> 6, cp = idx & 63;
      int col = n0 + 2 * cp;
      size_t r = (size_t)(m0 + row);
      float a0 = Cs[row * 132 + 2 * cp] + p.glu_b[l * 256 + col];
      float a1 = Cs[row * 132 + 2 * cp + 1] + p.glu_b[l * 256 + col + 1];
      unsigned zz = *(const unsigned*)(A + r * 256 + col);
      unsigned gg = *(const unsigned*)(gates + r * 1024 + 768 + col);
      float z0 = bf2f((u16)(zz & 0xffff)), z1 = bf2f((u16)(zz >> 16));
      float g0 = bf2f((u16)(gg & 0xffff)), g1 = bf2f((u16)(gg >> 16));
      float o0 = z0 * sigmoid_f(a0) * g0, o1 = z1 * sigmoid_f(a1) * g1;
      *(unsigned*)(mix + r * 1024 + 768 + col) = pk2(o0, o1);
    }
    __syncthreads();
  }
}

DI void gemm_out_phase(const Params& p, int l, char* smem) {
  const u16* A = (const u16*)(p.ws + OFF_H);
  const u16* Bt = (const u16*)(p.ws + OFF_WOUTT) + (size_t)l * 1024 * 1024;
  const float* Cs = (const float*)smem;
  constexpr int MT = T / 128, NT = 8;
  const int mstart = (l == 1) ? 2 : 0;
  constexpr int NFULL = (MT / 8) * 8 * NT, MREM = MT % 8;
  const int nitems = (l == 1) ? NFULL : MT * NT;
  for (int item = blockIdx.x; item < nitems; item += gridDim.x) {
    int mt, nt;
    if (item < NFULL) { const int xcd = item & 7, r = item >> 3; mt = (r / NT) * 8 + xcd; nt = r % NT; }
    else { const int j = item - NFULL; mt = (MT / 8) * 8 + j % MREM; nt = j / MREM; }
    if (mt < mstart) mt += (MT / 8) * 8;
    gemm_tile_compute(A, 1024, Bt, 1024, 1024, mt * 128, nt * 128, smem);
    epi_store<false, false>(Cs, p.ws + OFF_DN, 1024, mt * 128, nt * 128, 128);
    __syncthreads();
  }
}

DI void dn_solve(const float* Lr, const float* sb, const float* gc, bool isv, const char* src, int stride_bytes, float* x) {
  int off = 0;
  const int hioff = isv ? 0 : 2;
  const unsigned lomask = isv ? 0u : 0xffffu;
  const float gsel = isv ? 0.f : 1.f;
#pragma unroll
  for (int li = 0; li < 64; ++li) {
    const unsigned hi = *(const u16*)(src + off + hioff);
    const unsigned lo = *(const u16*)(src + off);
    const float gcl = gc[li];
    float r = __uint_as_float((hi << 16) | (lo & lomask)) * __expf(gcl * gsel);
    off += stride_bytes;
    asm volatile("" : "+v"(off));
    float acc = r * sb[li];
#pragma unroll
    for (int lj4 = 0; lj4 < (li + 3) / 4; ++lj4) {
      float4 Lq = *(const float4*)(Lr + li * 64 + lj4 * 4);
      if (lj4 * 4 + 0 < li) acc -= Lq.x * x[lj4 * 4 + 0];
      if (lj4 * 4 + 1 < li) acc -= Lq.y * x[lj4 * 4 + 1];
      if (lj4 * 4 + 2 < li) acc -= Lq.z * x[lj4 * 4 + 2];
      if (lj4 * 4 + 3 < li) acc -= Lq.w * x[lj4 * 4 + 3];
    }
    x[li] = acc;
    if (li & 1) __builtin_amdgcn_sched_barrier(0);
  }
}

DI void dn_prep_item(const Params& p, int l, int unit, char* smem) {
  const int cid = unit >> 2, head = unit & 3;
  const int tt0 = cid * 64;
  const int seg_lo = cid < 4 ? 0 : NCTX, seg_hi = cid < 4 ? NCTX : T;
  float* sq = (float*)smem;
  float* sk = sq + 64 * 65;
  float* sL = sk + 64 * 65;
  float* sbeta = sL + 2 * 4096;
  float* sgc = sbeta + 128;
  float* sg = sgc + 128;
  u16* sv = (u16*)(sg + 128);
  const u16* z = (const u16*)(p.ws + OFF_QKVB);
  const float* bd = (const float*)(p.ws + OFF_BD);
  const float* cw = p.conv_w + l * 3 * 768;
  u16* dn = (u16*)(p.ws + OFF_DN) + (size_t)unit * 2 * 5 * 4096;
  u16* tmp = (u16*)(p.ws + OFF_H) + (size_t)blockIdx.x * 32768;
  float* glast = (float*)(p.ws + OFF_GLAST);
  const int tid = otid(), lane = tid & 63, wave = tid >> 6;

  {
    const int cq = head * 64 + lane, ck = 256 + head * 64 + lane;
    const float wq0 = cw[cq], wq1 = cw[768 + cq], wq2 = cw[1536 + cq];
    const float wk0 = cw[ck], wk1 = cw[768 + ck], wk2 = cw[1536 + ck];
#pragma unroll 8
    for (int i = wave; i < 64; i += 4) {
      const int tt = tt0 + i;
      float zq0 = 0.f, zq2 = 0.f, zk0 = 0.f, zk2 = 0.f;
      if (tt - 1 >= seg_lo) { zq0 = bf2f(z[(size_t)(tt - 1) * 768 + cq]); zk0 = bf2f(z[(size_t)(tt - 1) * 768 + ck]); }
      if (tt + 1 < seg_hi) { zq2 = bf2f(z[(size_t)(tt + 1) * 768 + cq]); zk2 = bf2f(z[(size_t)(tt + 1) * 768 + ck]); }
      float zq1 = bf2f(z[(size_t)tt * 768 + cq]), zk1 = bf2f(z[(size_t)tt * 768 + ck]);
      float vq = silu_f(wq0 * zq0 + wq1 * zq1 + wq2 * zq2);
      float vk = silu_f(wk0 * zk0 + wk1 * zk1 + wk2 * zk2);
      float s1 = wave_sum(vq * vq), s2 = wave_sum(vk * vk);
      sq[i * 65 + lane] = vq * rsqrtf(s1 + EPS) * 0.125f;
      sk[i * 65 + lane] = vk * rsqrtf(s2 + EPS);
    }
  }
  if (tid < 128) {
    const int dir = tid >> 6, i = tid & 63;
    const int tt = tt0 + i;
    const int li = dir ? 63 - i : i;
    float br = bd[(size_t)tt * 16 + dir * 4 + head];
    float ar = bd[(size_t)tt * 16 + 8 + dir * 4 + head];
    sbeta[dir * 64 + li] = 1.f / (1.f + expf(-br));
    float xx = ar + p.dt_bias[l * 8 + dir * 4 + head];
    float sp = fmaxf(xx, 0.f) + log1pf(expf(-fabsf(xx)));
    sg[dir * 64 + li] = -expf(p.A_log[l * 8 + dir * 4 + head]) * sp;
  }
  __syncthreads();
  if (tid == 0 || tid == 64) {
    const int dir = tid >> 6;
    float a = 0.f;
    for (int li = 0; li < 64; ++li) { a += sg[dir * 64 + li]; sgc[dir * 64 + li] = a; }
  }
  __syncthreads();

  {
    const int it = wave >> 1, jt = wave & 1;
    const int lr = lane & 31, lh = lane >> 5;
    f32x16 kk, qk;
#pragma unroll
    for (int r = 0; r < 16; ++r) { kk[r] = 0.f; qk[r] = 0.f; }
    const float* ki = sk + (32 * it + lr) * 65 + 8 * lh;
    const float* qi = sq + (32 * it + lr) * 65 + 8 * lh;
    const float* kj = sk + (32 * jt + lr) * 65 + 8 * lh;
#pragma unroll
    for (int ks = 0; ks < 4; ++ks) {
      bf16x8 fa = mk8u(pk2(ki[16 * ks], ki[16 * ks + 1]), pk2(ki[16 * ks + 2], ki[16 * ks + 3]), pk2(ki[16 * ks + 4], ki[16 * ks + 5]),
                       pk2(ki[16 * ks + 6], ki[16 * ks + 7]));
      bf16x8 fq = mk8u(pk2(qi[16 * ks], qi[16 * ks + 1]), pk2(qi[16 * ks + 2], qi[16 * ks + 3]), pk2(qi[16 * ks + 4], qi[16 * ks + 5]),
                       pk2(qi[16 * ks + 6], qi[16 * ks + 7]));
      bf16x8 fb = mk8u(pk2(kj[16 * ks], kj[16 * ks + 1]), pk2(kj[16 * ks + 2], kj[16 * ks + 3]), pk2(kj[16 * ks + 4], kj[16 * ks + 5]),
                       pk2(kj[16 * ks + 6], kj[16 * ks + 7]));
      kk = MFMA32(fa, fb, kk);
      qk = MFMA32(fq, fb, qk);
    }
    const int j = 32 * jt + lr;
#pragma unroll
    for (int dir = 0; dir < 2; ++dir) {
      u16* attn = tmp + dir * 16384;
      const int lj = dir ? 63 - j : j;
      const float gcj = sgc[dir * 64 + lj];
#pragma unroll
      for (int r = 0; r < 16; ++r) {
        const int i = 32 * it + (r & 3) + 8 * (r >> 2) + 4 * lh;
        const int li = dir ? 63 - i : i;
        const float dec = __expf(fminf(sgc[dir * 64 + li] - gcj, 0.f));
        const float Lv = (lj < li) ? sbeta[dir * 64 + li] * kk[r] * dec : 0.f;
        const float Av = (lj <= li) ? qk[r] * dec : 0.f;
        sL[dir * 4096 + li * 64 + lj] = Lv;
        attn[li * 64 + lj] = f2bf(Av);
      }
    }
  }
#pragma unroll
  for (int dir = 0; dir < 2; ++dir) {
    u16* kdT = tmp + dir * 16384 + 4096;
    {
      const int d = tid >> 2, lq = tid & 3;
      const float gl = sgc[dir * 64 + 63];
      unsigned o[8];
#pragma unroll
      for (int e = 0; e < 8; ++e) {
        const int li0 = lq * 16 + 2 * e, li1 = li0 + 1;
        const int i0 = dir ? 63 - li0 : li0, i1 = dir ? 63 - li1 : li1;
        float v0 = sk[i0 * 65 + d] * __expf(gl - sgc[dir * 64 + li0]);
        float v1 = sk[i1 * 65 + d] * __expf(gl - sgc[dir * 64 + li1]);
        o[e] = pk2(v0, v1);
      }
      *(uint4*)(kdT + d * 64 + lq * 16) = make_uint4(o[0], o[1], o[2], o[3]);
      *(uint4*)(kdT + d * 64 + lq * 16 + 8) = make_uint4(o[4], o[5], o[6], o[7]);
    }
    if (tid == 0) glast[unit * 2 + dir] = __expf(sgc[dir * 64 + 63]);
  }
  {
    const int cv = 512 + head * 64 + lane;
    const float w0 = cw[cv], w1 = cw[768 + cv], w2 = cw[1536 + cv];
#pragma unroll 8
    for (int i = wave; i < 64; i += 4) {
      const int tt = tt0 + i;
      float z0 = 0.f, z2 = 0.f;
      if (tt - 1 >= seg_lo) z0 = bf2f(z[(size_t)(tt - 1) * 768 + cv]);
      if (tt + 1 < seg_hi) z2 = bf2f(z[(size_t)(tt + 1) * 768 + cv]);
      float z1 = bf2f(z[(size_t)tt * 768 + cv]);
      sv[i * 72 + lane] = f2bf(silu_f(w0 * z0 + w1 * z1 + w2 * z2));
    }
  }
  __syncthreads();
  {
    const int dir = tid >> 7, col = tid & 127;
    const bool isv = col < 64;
    const int c6 = col & 63;
    float x[64];
    const char* src = isv ? (const char*)(sv + (dir ? 63 * 72 : 0) + c6) : (const char*)(sk + (dir ? 63 * 65 : 0) + c6);
    const int strideb = (isv ? 144 : 260) * (dir ? -1 : 1);
    dn_solve(sL + dir * 4096, sbeta + dir * 64, sgc + dir * 64, isv, src, strideb, x);
    u16* XT = tmp + dir * 16384 + 8192 + col * 64;
#pragma unroll
    for (int c = 0; c < 8; ++c)
      *(uint4*)(XT + 8 * c) = make_uint4(pk2(x[8 * c], x[8 * c + 1]), pk2(x[8 * c + 2], x[8 * c + 3]),
                                         pk2(x[8 * c + 4], x[8 * c + 5]), pk2(x[8 * c + 6], x[8 * c + 7]));
  }
  __threadfence_block();
  __syncthreads();
  {
    const int dir = wave >> 1, prod = wave & 1;
    const int lr = lane & 31, lh = lane >> 5;
    const u16* Aop = tmp + dir * 16384 + (prod ? 0 : 4096);
    const u16* XT = tmp + dir * 16384 + 8192;
    u16* dnd = dn + (size_t)dir * 5 * 4096;
    bf16x8 af[2][4];
#pragma unroll
    for (int mt = 0; mt < 2; ++mt)
#pragma unroll
      for (int ks = 0; ks < 4; ++ks) af[mt][ks] = *(const bf16x8*)(Aop + (mt * 32 + lr) * 64 + ks * 16 + lh * 8);
    {
      f32x16 acc[2][2];
#pragma unroll
      for (int a = 0; a < 2; ++a)
#pragma unroll
        for (int b = 0; b < 2; ++b)
#pragma unroll
          for (int i = 0; i < 16; ++i) acc[a][b][i] = 0.f;
#pragma unroll
      for (int nt = 0; nt < 2; ++nt)
#pragma unroll
        for (int ks = 0; ks < 4; ++ks) {
          bf16x8 b = *(const bf16x8*)(XT + (nt * 32 + lr) * 64 + ks * 16 + lh * 8);
          acc[0][nt] = MFMA32(af[0][ks], b, acc[0][nt]);
          acc[1][nt] = MFMA32(af[1][ks], b, acc[1][nt]);
        }
      u16* dst = dnd + (prod ? 3 : 1) * 4096;
#pragma unroll
      for (int mt = 0; mt < 2; ++mt)
#pragma unroll
        for (int nt = 0; nt < 2; ++nt)
#pragma unroll
          for (int g4 = 0; g4 < 4; ++g4) {
            uint2 o = {pk2(acc[mt][nt][4 * g4], acc[mt][nt][4 * g4 + 1]), pk2(acc[mt][nt][4 * g4 + 2], acc[mt][nt][4 * g4 + 3])};
            if (prod) {
              *(uint2*)(dst + (nt * 32 + lr) * 64 + mt * 32 + 8 * g4 + 4 * lh) = o;
            } else {
              const int dvv = nt * 32 + lr;
              const int mm = 2 * mt + (g4 >> 1), qq = 2 * (g4 & 1) + lh;
              *(uint2*)(dst + (((dvv >> 4) * 64 + qq * 16 + (dvv & 15)) * 4 + mm) * 4) = o;
            }
          }
    }
    {
      f32x16 acc[2][2];
#pragma unroll
      for (int a = 0; a < 2; ++a)
#pragma unroll
        for (int b = 0; b < 2; ++b)
#pragma unroll
          for (int i = 0; i < 16; ++i) acc[a][b][i] = 0.f;
#pragma unroll
      for (int mt = 0; mt < 2; ++mt)
#pragma unroll
        for (int ks = 0; ks < 4; ++ks) {
          bf16x8 a = *(const bf16x8*)(XT + (64 + mt * 32 + lr) * 64 + ks * 16 + lh * 8);
          acc[mt][0] = MFMA32(a, af[0][ks], acc[mt][0]);
          acc[mt][1] = MFMA32(a, af[1][ks], acc[mt][1]);
        }
      u16* dst = dnd + (prod ? 2 : 0) * 4096;
#pragma unroll
      for (int nt = 0; nt < 2; ++nt) {
        const int n = nt * 32 + lr;
        const int i = dir ? 63 - n : n;
        const float eg = __expf(sgc[dir * 64 + n]);
#pragma unroll
        for (int mt = 0; mt < 2; ++mt)
#pragma unroll
          for (int g4 = 0; g4 < 4; ++g4) {
            const int d0 = mt * 32 + 8 * g4 + 4 * lh;
            float v0 = acc[mt][nt][4 * g4], v1 = acc[mt][nt][4 * g4 + 1], v2 = acc[mt][nt][4 * g4 + 2], v3 = acc[mt][nt][4 * g4 + 3];
            if (prod) {
              v0 = sq[i * 65 + d0] * eg - v0;
              v1 = sq[i * 65 + d0 + 1] * eg - v1;
              v2 = sq[i * 65 + d0 + 2] * eg - v2;
              v3 = sq[i * 65 + d0 + 3] * eg - v3;
            }
            uint2 o = {pk2(v0, v1), pk2(v2, v3)};
            if (prod) {
              *(uint2*)(dst + n * 64 + d0) = o;
            } else {
              const int mm = n >> 4, cnn = n & 15, ss = mt, hif = g4 >> 1, qq = 2 * (g4 & 1) + lh;
              *(uint2*)(dst + ((mm * 2 + ss) * 64 + qq * 16 + cnn) * 8 + 4 * hif) = o;
            }
          }
      }
    }
  }
  __syncthreads();
}

DI void s5_coeffs(const Params& p, int l, int dir, int g, int pp, float& a_re, float& a_im, float* b_re, float* b_im) {
  const int gi = (l * 2 + dir) * 16 + g;
  const int idx = gi * 64 + pp;
  const float lr = p.A_re[idx], lim = p.A_im[idx];
  const float dt = expf(p.log_dt[gi]);
  const float mag = expf(lr * dt);
  const float ang = lim * dt;
  float sn, cs;
  sincosf(ang, &sn, &cs);
  a_re = mag * cs;
  a_im = mag * sn;
  const float nr = a_re - 1.f, ni = a_im;
  const float den = 1.f / (lr * lr + lim * lim);
  const float c_re = (nr * lr + ni * lim) * den;
  const float c_im = (ni * lr - nr * lim) * den;
  const float* Br = p.B_re + (size_t)idx * 16;
  const float* Bi = p.B_im + (size_t)idx * 16;
#pragma unroll
  for (int c = 0; c < 16; ++c) {
    float br = Br[c], bi = Bi[c];
    b_re[c] = c_re * br - c_im * bi;
    b_im[c] = c_re * bi + c_im * br;
  }
}


constexpr int S5_WAVE_LDS = 12800;
DI void s5_wave_sync() { asm volatile("s_waitcnt lgkmcnt(0)" ::: "memory"); }
DI void s5_bfrags(u16* sbw, const float* b_re, const float* b_im, int lane, bf16x8* bfrag) {
  *(uint4*)(sbw + lane * 32) = make_uint4(pk2(b_re[0], b_re[1]), pk2(b_re[2], b_re[3]), pk2(b_re[4], b_re[5]), pk2(b_re[6], b_re[7]));
  *(uint4*)(sbw + lane * 32 + 8) = make_uint4(pk2(b_re[8], b_re[9]), pk2(b_re[10], b_re[11]), pk2(b_re[12], b_re[13]), pk2(b_re[14], b_re[15]));
  *(uint4*)(sbw + lane * 32 + 16) = make_uint4(pk2(b_im[0], b_im[1]), pk2(b_im[2], b_im[3]), pk2(b_im[4], b_im[5]), pk2(b_im[6], b_im[7]));
  *(uint4*)(sbw + lane * 32 + 24) = make_uint4(pk2(b_im[8], b_im[9]), pk2(b_im[10], b_im[11]), pk2(b_im[12], b_im[13]), pk2(b_im[14], b_im[15]));
  s5_wave_sync();
  const int n = lane & 15, q4 = lane >> 4;
  const unsigned keep = (q4 < 2) ? 0xffffffffu : 0u;
#pragma unroll
  for (int nt = 0; nt < 8; ++nt) {
    const int state = 16 * (nt & 3) + n, part = nt >> 2;
    uint4 v = *(const uint4*)(sbw + state * 32 + part * 16 + 8 * (q4 & 1));
    bfrag[nt] = mk8u(v.x & keep, v.y & keep, v.z & keep, v.w & keep);
  }
}
DI void s5_bu_slab(const float* su, int wave, int dir, int s, int lane, const bf16x8* bfrag, u16* busw) {
  const int n = lane & 15, q4 = lane >> 4;
  const int li = 16 * s + n;
  const int i = dir ? 63 - li : li;
  const float* ur = su + i * 64 + wave * 16 + 8 * (q4 & 1);
  const float4 u0 = *(const float4*)ur, u1 = *(const float4*)(ur + 4);
  const unsigned keep = (q4 < 2) ? 0xffffffffu : 0u;
  const bf16x8 a = mk8u(pk2(u0.x, u0.y) & keep, pk2(u0.z, u0.w) & keep, pk2(u1.x, u1.y) & keep, pk2(u1.z, u1.w) & keep);
#pragma unroll
  for (int nt = 0; nt < 8; ++nt) {
    f32x4 acc = {0.f, 0.f, 0.f, 0.f};
    acc = MFMA16(a, bfrag[nt], acc);
    const int col = (nt >> 2) * 64 + 16 * (nt & 3) + n;
#pragma unroll
    for (int j = 0; j < 4; ++j) busw[(4 * q4 + j) * 136 + col] = f2bf(acc[j]);
  }
  s5_wave_sync();
}

DI void s5_a_item(const Params& p, int l, int item, char* smem) {
  const int quarter = item & 3, dir = (item >> 2) & 1, cid = item >> 3;
  const int tid = otid(), lane = tid & 63, wave = tid >> 6;
  const int g = quarter * 4 + wave;
  float* su = (float*)smem;
  const float* uC = (const float*)(p.ws + OFF_UC);
  for (int e = tid; e < 64 * 16; e += 256) {
    int i = e >> 4, c4 = e & 15;
    *(float4*)(su + i * 64 + c4 * 4) = *(const float4*)(uC + (size_t)(cid * 64 + i) * 256 + quarter * 64 + c4 * 4);
  }
  float a_re, a_im, b_re[16], b_im[16];
  s5_coeffs(p, l, dir, g, lane, a_re, a_im, b_re, b_im);
  u16* wl = (u16*)(smem + 16384 + wave * S5_WAVE_LDS);
  u16* busw = wl + 2176;
  u16* sbw = wl + 4352;
  bf16x8 bfrag[8];
  s5_bfrags(sbw, b_re, b_im, lane, bfrag);
  __syncthreads();
  float h_re = 0.f, h_im = 0.f;
  for (int s4 = 0; s4 < 4; ++s4) {
    s5_bu_slab(su, wave, dir, s4, lane, bfrag, busw);
#pragma unroll
    for (int r = 0; r < 16; ++r) {
      const float bu_re = bf2f(busw[r * 136 + lane]), bu_im = bf2f(busw[r * 136 + 64 + lane]);
      float nr = a_re * h_re - a_im * h_im + bu_re;
      float ni = a_re * h_im + a_im * h_re + bu_im;
      h_re = nr; h_im = ni;
    }
    s5_wave_sync();
  }
  float2* E = (float2*)(p.ws + OFF_S5E);
  E[((size_t)(cid * 2 + dir) * 16 + g) * 64 + lane] = make_float2(h_re, h_im);
  __syncthreads();
}

DI int chain_cid(int dir, int pos) { return dir == 0 ? pos : (pos < 4 ? 3 - pos : 263 - pos); }

DI void s5_carry(const Params& p, int l, int sblk) {
  const int id = sblk * 256 + otid();
  const int dir = id >> 10, g = (id >> 6) & 15, pp = id & 63;
  const int gi = (l * 2 + dir) * 16 + g;
  const float lr = p.A_re[gi * 64 + pp], lim = p.A_im[gi * 64 + pp];
  const float dt = expf(p.log_dt[gi]);
  const float mag = expf(lr * dt);
  float sn, cs;
  sincosf(lim * dt, &sn, &cs);
  float ar = mag * cs, ai = mag * sn;
#pragma unroll
  for (int i = 0; i < 6; ++i) { float nr = ar * ar - ai * ai, ni = 2.f * ar * ai; ar = nr; ai = ni; }
  const float2* E = (const float2*)(p.ws + OFF_S5E);
  float2* H = (float2*)(p.ws + OFF_S5H);
  float hr = 0.f, hi = 0.f;
  asm volatile("" : "+v"(hr), "+v"(hi));
  for (int pos0 = 0; pos0 < NCH; pos0 += 20) {
    float2 e[20];
    size_t o[20];
#pragma unroll
    for (int u = 0; u < 20; ++u) {
      int cid = chain_cid(dir, pos0 + u);
      o[u] = ((size_t)(cid * 2 + dir) * 16 + g) * 64 + pp;
      e[u] = E[o[u]];
    }
#pragma unroll
    for (int u = 0; u < 20; ++u) {
      H[o[u]] = make_float2(hr, hi);
      float nr = ar * hr - ai * hi + e[u].x;
      float ni = ar * hi + ai * hr + e[u].y;
      hr = nr; hi = ni;
    }
  }
}

DI void s5_c_item(const Params& p, int l, int item, char* smem) {
  const int quarter = item & 3, cid = item >> 2;
  const int tid = otid(), lane = tid & 63, wave = tid >> 6;
  const int g = quarter * 4 + wave;
  float* su = (float*)smem;
  u16* hs = (u16*)(smem + 16384 + wave * S5_WAVE_LDS);
  u16* busw = hs + 2176;
  u16* sbw = hs + 4352;
  const float* uC = (const float*)(p.ws + OFF_UC);
  const float2* Hin = (const float2*)(p.ws + OFF_S5H);
  u16* zg = (u16*)(p.ws + OFF_QB);
  for (int e = tid; e < 64 * 16; e += 256) {
    int i = e >> 4, c4 = e & 15;
    *(float4*)(su + i * 64 + c4 * 4) = *(const float4*)(uC + (size_t)(cid * 64 + i) * 256 + quarter * 64 + c4 * 4);
  }
  __syncthreads();
  const int cc = lane & 15, q4 = lane >> 4;
  f32x4 yacc[4];
#pragma unroll
  for (int t = 0; t < 4; ++t) yacc[t] = (f32x4){0.f, 0.f, 0.f, 0.f};
#pragma unroll
  for (int dir = 0; dir < 2; ++dir) {
    float a_re, a_im, b_re[16], b_im[16];
    s5_coeffs(p, l, dir, g, lane, a_re, a_im, b_re, b_im);
    bf16x8 cf[4];
    {
      const size_t cb = ((size_t)((l * 2 + dir) * 16 + g) * 16 + cc) * 64;
#pragma unroll
      for (int s = 0; s < 4; ++s) {
        const float* src = (s < 2 ? p.C_re : p.C_im) + cb + 32 * (s & 1) + 8 * q4;
        const float sgn = (s < 2) ? 1.f : -1.f;
        float4 v0 = *(const float4*)src, v1 = *(const float4*)(src + 4);
        cf[s] = mk8u(pk2(sgn * v0.x, sgn * v0.y), pk2(sgn * v0.z, sgn * v0.w), pk2(sgn * v1.x, sgn * v1.y),
                     pk2(sgn * v1.z, sgn * v1.w));
      }
    }
    bf16x8 bfrag[8];
    s5_bfrags(sbw, b_re, b_im, lane, bfrag);
    float2 h0 = Hin[((size_t)(cid * 2 + dir) * 16 + g) * 64 + lane];
    float h_re = h0.x, h_im = h0.y;
#pragma unroll
    for (int s = 0; s < 4; ++s) {
      s5_bu_slab(su, wave, dir, s, lane, bfrag, busw);
#pragma unroll
      for (int r = 0; r < 16; ++r) {
        const float bu_re = bf2f(busw[r * 136 + lane]), bu_im = bf2f(busw[r * 136 + 64 + lane]);
        float nr = a_re * h_re - a_im * h_im + bu_re;
        float ni = a_re * h_im + a_im * h_re + bu_im;
        h_re = nr; h_im = ni;
        const int rr = dir ? 15 - r : r;
        hs[rr * 136 + lane] = f2bf(h_re);
        hs[rr * 136 + 64 + lane] = f2bf(h_im);
      }
      asm volatile("s_waitcnt lgkmcnt(0)" ::: "memory");
      const int tile = dir ? 3 - s : s;
#pragma unroll
      for (int ks = 0; ks < 4; ++ks) {
        bf16x8 a = *(const bf16x8*)(hs + cc * 136 + 32 * ks + 8 * q4);
        yacc[tile] = MFMA16(a, cf[ks], yacc[tile]);
      }
      asm volatile("s_waitcnt lgkmcnt(0)" ::: "memory");
    }
  }
  const int ch = g * 16 + cc;
  const float dsk = p.Dskip[l * 256 + ch];
#pragma unroll
  for (int tile = 0; tile < 4; ++tile)
#pragma unroll
    for (int j = 0; j < 4; ++j) {
      const int t = 16 * tile + 4 * q4 + j;
      float y = yacc[tile][j] + su[t * 64 + wave * 16 + cc] * dsk;
      zg[(size_t)(cid * 64 + t) * 256 + ch] = f2bf(gelu_tanh(y));
    }
  __syncthreads();
}

DI void dn_out_item(const Params& p, int l, int unit, char* smem) {
  const int cid = unit >> 2, head = unit & 3;
  const int tid = otid(), lane = tid & 63, wave = tid >> 6;
  const int lr = lane & 31, lh = lane >> 5;
  float* so = (float*)smem;
  const u16* gates = (const u16*)(p.ws + OFF_GATES);
  u16* mix = (u16*)(p.ws + OFF_H);
  const int dir = wave >> 1, mt = wave & 1;
  const u16* dnd = (const u16*)(p.ws + OFF_DN) + ((size_t)unit * 2 + dir) * 5 * 4096;
  const u16* Pm = dnd + 2 * 4096, *RT = dnd + 3 * 4096, *ST = dnd + 4 * 4096;
  f32x16 acc[2];
#pragma unroll
  for (int nt = 0; nt < 2; ++nt)
#pragma unroll
    for (int i = 0; i < 16; ++i) acc[nt][i] = 0.f;
#pragma unroll
  for (int ks = 0; ks < 4; ++ks) {
    bf16x8 a = *(const bf16x8*)(Pm + (mt * 32 + lr) * 64 + ks * 16 + lh * 8);
#pragma unroll
    for (int nt = 0; nt < 2; ++nt) {
      bf16x8 b = *(const bf16x8*)(ST + (nt * 32 + lr) * 64 + ks * 16 + lh * 8);
      acc[nt] = MFMA32(a, b, acc[nt]);
    }
  }
#pragma unroll
  for (int nt = 0; nt < 2; ++nt)
#pragma unroll
    for (int g4 = 0; g4 < 4; ++g4) {
      uint2 rr = *(const uint2*)(RT + (nt * 32 + lr) * 64 + mt * 32 + 8 * g4 + 4 * lh);
      acc[nt][4 * g4 + 0] += bf2f((u16)(rr.x & 0xffff));
      acc[nt][4 * g4 + 1] += bf2f((u16)(rr.x >> 16));
      acc[nt][4 * g4 + 2] += bf2f((u16)(rr.y & 0xffff));
      acc[nt][4 * g4 + 3] += bf2f((u16)(rr.y >> 16));
    }
  if (dir == 0) {
#pragma unroll
    for (int nt = 0; nt < 2; ++nt)
#pragma unroll
      for (int i = 0; i < 16; ++i) {
        const int li = mt * 32 + (i & 3) + 8 * (i >> 2) + 4 * lh;
        so[li * 65 + nt * 32 + lr] = acc[nt][i];
      }
  }
  __syncthreads();
  if (dir == 1) {
#pragma unroll
    for (int nt = 0; nt < 2; ++nt)
#pragma unroll
      for (int i = 0; i < 16; ++i) {
        const int li = mt * 32 + (i & 3) + 8 * (i >> 2) + 4 * lh;
        so[(63 - li) * 65 + nt * 32 + lr] += acc[nt][i];
      }
  }
  __syncthreads();
  const float gain = p.out_gain[l * 64 + lane];
#pragma unroll
  for (int i0 = 0; i0 < 16; ++i0) {
    const int i = wave + 4 * i0;
    const size_t tt = (size_t)cid * 64 + i;
    const int c = head * 64 + lane;
    float o = so[i * 65 + lane];
    float ms = wave_sum(o * o) * (1.f / 64.f);
    float v = o * rsqrtf(ms + EPS) * gain * bf2f(gates[tt * 1024 + 512 + c]);
    mix[tt * 1024 + 512 + c] = f2bf(v);
  }
  __syncthreads();
}

#define SCAN_LOAD(U, POS)                                                                      \
  {                                                                                            \
    const int cid_ = chain_cid(dir, (POS));                                                    \
    const u16* base_ = dnb + ((size_t)(cid_ * 4 + head) * 2 + dir) * 5 * 4096;                 \
    _Pragma("unroll") for (int m = 0; m < 4; ++m) {                                            \
      _Pragma("unroll") for (int s2 = 0; s2 < 2; ++s2) {                                       \
        const uint4 t_ = *(const uint4*)(base_ + ((m * 2 + s2) * 64 + lane) * 8);              \
        mlo##U[m][s2] = make_uint2(t_.x, t_.y);                                                \
        mhi##U[m][s2] = make_uint2(t_.z, t_.w);                                                \
      }                                                                                        \
    }                                                                                          \
    {                                                                                          \
      const uint4 t0_ = *(const uint4*)(base_ + 4096 + (cgp * 64 + lane) * 16);                \
      const uint4 t1_ = *(const uint4*)(base_ + 4096 + (cgp * 64 + lane) * 16 + 8);            \
      ntv##U[0] = make_uint2(t0_.x, t0_.y); ntv##U[1] = make_uint2(t0_.z, t0_.w);              \
      ntv##U[2] = make_uint2(t1_.x, t1_.y); ntv##U[3] = make_uint2(t1_.z, t1_.w);              \
    }                                                                                          \
    gl##U = glast[(cid_ * 4 + head) * 2 + dir];                                                \
  }
#define SCAN_COMPUTE(U, POS)                                                                   \
  {                                                                                            \
    const int cid_ = chain_cid(dir, (POS));                                                    \
    u16* STp_ = dnb + (((size_t)(cid_ * 4 + head) * 2 + dir) * 5 + 4) * 4096 + dv * 64 + 4 * q4; \
    unsigned pk_[4][2];                                                                        \
    _Pragma("unroll") for (int m = 0; m < 4; ++m) {                                            \
      pk_[m][0] = pk2(S[m][0], S[m][1]);                                                       \
      pk_[m][1] = pk2(S[m][2], S[m][3]);                                                       \
      *(uint2*)(STp_ + 16 * m) = make_uint2(pk_[m][0], pk_[m][1]);                             \
    }                                                                                          \
    bf16x8 sb0_ = mk8u(pk_[0][0], pk_[0][1], pk_[1][0], pk_[1][1]);                            \
    bf16x8 sb1_ = mk8u(pk_[2][0], pk_[2][1], pk_[3][0], pk_[3][1]);                            \
    _Pragma("unroll") for (int m = 0; m < 4; ++m) {                                            \
      f32x4 acc_ = {0.f, 0.f, 0.f, 0.f};                                                       \
      acc_ = MFMA16(mk8(mlo##U[m][0], mhi##U[m][0]), sb0_, acc_);                              \
      acc_ = MFMA16(mk8(mlo##U[m][1], mhi##U[m][1]), sb1_, acc_);                              \
      S[m][0] = gl##U * S[m][0] - acc_[0] + bf2f((u16)(ntv##U[m].x & 0xffff));                 \
      S[m][1] = gl##U * S[m][1] - acc_[1] + bf2f((u16)(ntv##U[m].x >> 16));                    \
      S[m][2] = gl##U * S[m][2] - acc_[2] + bf2f((u16)(ntv##U[m].y & 0xffff));                 \
      S[m][3] = gl##U * S[m][3] - acc_[3] + bf2f((u16)(ntv##U[m].y >> 16));                    \
    }                                                                                          \
  }
DI void dn_scan_wave(const Params& p, int task) {
  const int head = task & 3, dir = (task >> 2) & 1, cgp = task >> 3;
  const int lane = otid() & 63;
  const int cn = lane & 15, q4 = lane >> 4;
  const int dv = cgp * 16 + cn;
  u16* dnb = (u16*)(p.ws + OFF_DN);
  const float* glast = (const float*)(p.ws + OFF_GLAST);
  f32x4 S[4];
#pragma unroll
  for (int m = 0; m < 4; ++m) S[m] = (f32x4){0.f, 0.f, 0.f, 0.f};
  uint2 mlo0[4][2], mhi0[4][2], ntv0[4]; float gl0;
  uint2 mlo1[4][2], mhi1[4][2], ntv1[4]; float gl1;
  uint2 mlo2[4][2], mhi2[4][2], ntv2[4]; float gl2;
  uint2 mlo3[4][2], mhi3[4][2], ntv3[4]; float gl3;
  SCAN_LOAD(0, 0) SCAN_LOAD(1, 1) SCAN_LOAD(2, 2) SCAN_LOAD(3, 3)
  for (int pos0 = 0; pos0 < NCH; pos0 += 4) {
    const bool more = pos0 + 4 < NCH;
    SCAN_COMPUTE(0, pos0) if (more) SCAN_LOAD(0, pos0 + 4)
    SCAN_COMPUTE(1, pos0 + 1) if (more) SCAN_LOAD(1, pos0 + 5)
    SCAN_COMPUTE(2, pos0 + 2) if (more) SCAN_LOAD(2, pos0 + 6)
    SCAN_COMPUTE(3, pos0 + 3) if (more) SCAN_LOAD(3, pos0 + 7)
  }
}

constexpr int A_LD = 72;
constexpr int V_LD = 136;
DI void attn_item(const Params& p, int item, char* smem) {
  int head, q0, ntiles;
  if (item < 512) { head = item & 7; q0 = NCTX + (item >> 3) * 256; ntiles = NCH; }
  else { head = item - 512; q0 = 0; ntiles = 4; }
  const int kvh = head >> 2;
  const int tid = otid(), lane = tid & 63, wave = tid >> 6;
  const int lr = lane & 31, lh = lane >> 5;
  const u16* Qb = (const u16*)(p.ws + OFF_QB) + (size_t)head * T * 64;
  const u16* Kb = (const u16*)(p.ws + OFF_KB) + (size_t)kvh * T * 64;
  const u16* Vt = (const u16*)(p.ws + OFF_VT) + (size_t)kvh * 64 * T;
  u16* Ks = (u16*)smem;
  u16* Vs = Ks + 2 * 128 * A_LD;
  bf16x8 qf[2][4];
#pragma unroll
  for (int qt = 0; qt < 2; ++qt)
#pragma unroll
    for (int ks = 0; ks < 4; ++ks)
      qf[qt][ks] = *(const bf16x8*)(Qb + (size_t)(q0 + wave * 64 + qt * 32 + lr) * 64 + ks * 16 + lh * 8);

  f32x16 ot[2][2];
#pragma unroll
  for (int a = 0; a < 2; ++a)
#pragma unroll
    for (int b = 0; b < 2; ++b)
#pragma unroll
      for (int i = 0; i < 16; ++i) ot[a][b][i] = 0.f;
  float lrun[2] = {0.f, 0.f};

  uint4 rk0, rk1, rv0, rv1;
  const int srow = tid >> 3, sch = tid & 7;
  const u16* Kg = Kb + (size_t)srow * 64 + sch * 8;
  const u16* Vg = Vt + (size_t)srow * T + sch * 8;
#define A_LOAD(J_)                                                               \
  {                                                                              \
    const u16* kg_ = Kg + (size_t)(J_) * 4096;                                   \
    const u16* vg_ = Vg + (size_t)(J_) * 64;                                     \
    rk0 = *(const uint4*)(kg_);  rk1 = *(const uint4*)(kg_ + 32 * 64);           \
    rv0 = *(const uint4*)(vg_);  rv1 = *(const uint4*)(vg_ + (size_t)32 * T);    \
  }
#define A_STORE(BUF_, HALF_)                                                     \
  {                                                                              \
    u16* ks_ = Ks + ((BUF_) * 128 + (HALF_) * 64 + srow) * A_LD + sch * 8;       \
    u16* vs_ = Vs + ((BUF_) * 64 + srow) * V_LD + (HALF_) * 64 + sch * 8;        \
    *(uint4*)(ks_) = rk0;  *(uint4*)(ks_ + 32 * A_LD) = rk1;                     \
    *(uint4*)(vs_) = rv0;  *(uint4*)(vs_ + 32 * V_LD) = rv1;                     \
  }
  A_LOAD(0)
  A_STORE(0, 0)
  A_LOAD(1)
  A_STORE(0, 1)
  __syncthreads();
  const int npairs = ntiles >> 1;
  for (int jj = 0; jj < npairs; ++jj) {
    const int buf = jj & 1;
    const int jnext = (jj + 1 < npairs ? jj + 1 : jj) * 2;
#pragma unroll 1
    for (int half = 0; half < 2; ++half) {
    A_LOAD(jnext + half)
    __builtin_amdgcn_sched_barrier(0);
    const u16* Kt = Ks + (buf * 128 + half * 64) * A_LD;
    const u16* Vtile = Vs + buf * 64 * V_LD + half * 64;
    f32x16 st[2][2];
#pragma unroll
    for (int a = 0; a < 2; ++a)
#pragma unroll
      for (int b = 0; b < 2; ++b)
#pragma unroll
        for (int i = 0; i < 16; ++i) st[a][b][i] = 0.f;
    {
      bf16x8 kf[2][4];
#pragma unroll
      for (int kt = 0; kt < 2; ++kt)
#pragma unroll
        for (int ks = 0; ks < 4; ++ks) kf[kt][ks] = *(const bf16x8*)(Kt + (kt * 32 + lr) * A_LD + ks * 16 + lh * 8);
      __builtin_amdgcn_sched_barrier(0);
#pragma unroll
      for (int kt = 0; kt < 2; ++kt)
#pragma unroll
        for (int ks = 0; ks < 4; ++ks) {
          st[kt][0] = MFMA32(kf[kt][ks], qf[0][ks], st[kt][0]);
          st[kt][1] = MFMA32(kf[kt][ks], qf[1][ks], st[kt][1]);
        }
    }
#pragma unroll
    for (int kt = 0; kt < 2; ++kt) {
#pragma unroll
      for (int qt = 0; qt < 2; ++qt) {
        float ls0 = 0.f, ls1 = 0.f;
#pragma unroll
        for (int i = 0; i < 16; i += 2) {
          float p0 = __builtin_amdgcn_exp2f(st[kt][qt][i]);
          float p1 = __builtin_amdgcn_exp2f(st[kt][qt][i + 1]);
          st[kt][qt][i] = p0;
          st[kt][qt][i + 1] = p1;
          ls0 += p0;
          ls1 += p1;
        }
        lrun[qt] += ls0 + ls1;
      }
#pragma unroll
      for (int ss = 0; ss < 2; ++ss) {
        bf16x8 pb[2];
#pragma unroll
        for (int qt = 0; qt < 2; ++qt)
          pb[qt] = mk8u(pk2(st[kt][qt][8 * ss + 0], st[kt][qt][8 * ss + 1]), pk2(st[kt][qt][8 * ss + 2], st[kt][qt][8 * ss + 3]),
                        pk2(st[kt][qt][8 * ss + 4], st[kt][qt][8 * ss + 5]), pk2(st[kt][qt][8 * ss + 6], st[kt][qt][8 * ss + 7]));
#pragma unroll
        for (int dt = 0; dt < 2; ++dt) {
          const u16* pr = Vtile + (dt * 32 + lr) * V_LD + 32 * kt + 16 * ss + 4 * lh;
          uint2 lo = *(const uint2*)pr;
          uint2 hi = *(const uint2*)(pr + 8);
          bf16x8 a = mk8(lo, hi);
#pragma unroll
          for (int qt = 0; qt < 2; ++qt) ot[dt][qt] = MFMA32(a, pb[qt], ot[dt][qt]);
        }
      }
    }
    __builtin_amdgcn_sched_barrier(0);
    A_STORE(buf ^ 1, half)
    }
    __syncthreads();
  }
  const u16* gates = (const u16*)(p.ws + OFF_GATES);
  u16* mix = (u16*)(p.ws + OFF_H);
#pragma unroll
  for (int qt = 0; qt < 2; ++qt) {
    const float lt = lrun[qt] + __shfl_xor(lrun[qt], 32);
    const float inv = 1.f / lt;
    const size_t row = (size_t)(q0 + wave * 64 + qt * 32 + lr);
#pragma unroll
    for (int dt = 0; dt < 2; ++dt)
#pragma unroll
      for (int g4 = 0; g4 < 4; ++g4) {
        const int d0 = 32 * dt + 8 * g4 + 4 * lh;
        uint2 gg = *(const uint2*)(gates + row * 1024 + head * 64 + d0);
        float o0 = ot[dt][qt][4 * g4 + 0] * inv * bf2f((u16)(gg.x & 0xffff));
        float o1 = ot[dt][qt][4 * g4 + 1] * inv * bf2f((u16)(gg.x >> 16));
        float o2 = ot[dt][qt][4 * g4 + 2] * inv * bf2f((u16)(gg.y & 0xffff));
        float o3 = ot[dt][qt][4 * g4 + 3] * inv * bf2f((u16)(gg.y >> 16));
        uint2 o = {pk2(o0, o1), pk2(o2, o3)};
        *(uint2*)(mix + row * 1024 + head * 64 + d0) = o;
      }
  }
}

DI void final_ln_phase(const Params& p, int l, const float* ctx_src, const float* lat_src) {
  const int lane = otid() & 63, wave = otid() >> 6;
  const int nw = gridDim.x * 4;
  const float* y = (const float*)(p.ws + OFF_DN);
  const float* modv = (const float*)(p.ws + OFF_MODV);
  float* ctx1 = (float*)(p.ws + OFF_CTX1);
  u16* h = (u16*)(p.ws + OFF_H);
  const int rstart = (l == 1) ? NCTX : 0;
  for (int r = rstart + blockIdx.x * 4 + wave; r < T; r += nw) {
    const bool isc = r < NCTX;
    const float* src = isc ? ctx_src + (size_t)r * DM : lat_src + (size_t)(r - NCTX) * DM;
    float* dst = isc ? ctx1 + (size_t)r * DM : p.out + (size_t)(r - NCTX) * DM;
    const float* mod = modv + (l * 2 + (isc ? 1 : 0)) * 3072;
    float4 v[4];
    float s = 0.f;
#pragma unroll
    for (int i = 0; i < 4; ++i) {
      int c0 = (i * 64 + lane) * 4;
      float4 xv = nt_load4(src + c0);
      float4 yv = nt_load4(y + (size_t)r * DM + c0);
      float4 gv = *(const float4*)(mod + 2048 + c0);
      v[i].x = DN_ALPHA * xv.x + gv.x * yv.x;
      v[i].y = DN_ALPHA * xv.y + gv.y * yv.y;
      v[i].z = DN_ALPHA * xv.z + gv.z * yv.z;
      v[i].w = DN_ALPHA * xv.w + gv.w * yv.w;
      s += v[i].x + v[i].y + v[i].z + v[i].w;
    }
    float mu = wave_sum(s) * (1.f / DM);
    float q = 0.f;
#pragma unroll
    for (int i = 0; i < 4; ++i) {
      v[i].x -= mu; v[i].y -= mu; v[i].z -= mu; v[i].w -= mu;
      q += v[i].x * v[i].x + v[i].y * v[i].y + v[i].z * v[i].z + v[i].w * v[i].w;
    }
    float rstd = rsqrtf(wave_sum(q) * (1.f / DM) + EPS);
    float s2 = 0.f;
#pragma unroll
    for (int i = 0; i < 4; ++i) {
      int c0 = (i * 64 + lane) * 4;
      float4 g = *(const float4*)(p.ln_g + l * DM + c0);
      float4 b = *(const float4*)(p.ln_b + l * DM + c0);
      v[i].x = v[i].x * rstd * g.x + b.x;
      v[i].y = v[i].y * rstd * g.y + b.y;
      v[i].z = v[i].z * rstd * g.z + b.z;
      v[i].w = v[i].w * rstd * g.w + b.w;
      nt_store4(dst + c0, v[i]);
      s2 += v[i].x + v[i].y + v[i].z + v[i].w;
    }
    if (l == 0) {
      const float* mod1 = modv + (2 + (isc ? 1 : 0)) * 3072;
      float mu2 = wave_sum(s2) * (1.f / DM);
      float q2 = 0.f;
#pragma unroll
      for (int i = 0; i < 4; ++i) {
        v[i].x -= mu2; v[i].y -= mu2; v[i].z -= mu2; v[i].w -= mu2;
        q2 += v[i].x * v[i].x + v[i].y * v[i].y + v[i].z * v[i].z + v[i].w * v[i].w;
      }
      float rstd2 = rsqrtf(wave_sum(q2) * (1.f / DM) + EPS);
#pragma unroll
      for (int i = 0; i < 4; ++i) {
        int c0 = (i * 64 + lane) * 4;
        float4 sh = *(const float4*)(mod1 + c0);
        float4 sc = *(const float4*)(mod1 + 1024 + c0);
        float o0 = v[i].x * rstd2 * (1.f + sc.x) + sh.x;
        float o1 = v[i].y * rstd2 * (1.f + sc.y) + sh.y;
        float o2 = v[i].z * rstd2 * (1.f + sc.z) + sh.z;
        float o3 = v[i].w * rstd2 * (1.f + sc.w) + sh.w;
        uint2 pk = {pk2(o0, o1), pk2(o2, o3)};
        *(uint2*)(h + (size_t)r * DM + c0) = pk;
      }
    }
  }
}

#ifndef REP_ATTN
#define REP_ATTN 1
#endif
#ifndef REP_SCAN
#define REP_SCAN 1
#endif
#ifndef REP_GEMM
#define REP_GEMM 1
#endif
#ifndef REP_PREP
#define REP_PREP 1
#endif
#ifndef REP_P5
#define REP_P5 1
#endif
typedef const __attribute__((address_space(4))) Params* KParamsPtr;
DI const Params& kp() {
  KParamsPtr q = (KParamsPtr)__builtin_amdgcn_kernarg_segment_ptr();
  asm volatile("" : "+s"(q));
  return *(const Params*)q;
}
__global__ void __launch_bounds__(256, 2) fwd_megakernel(Params pin) {
  cg::grid_group grid = cg::this_grid();
  __shared__ __attribute__((aligned(16))) char smem[SMEM_BYTES];
  const int nb = gridDim.x;
  __shared__ uint4 xb_words;
  if (threadIdx.x == 0) xb_words = make_uint4(0u, 0u, 0u, 0u);
  __syncthreads();
  (void)xcd_barrier_post((unsigned*)(kp().ws + OFF_BAR), (volatile LAS unsigned*)&xb_words);
#define GRID_BARRIER() do { XcdBarrier xb_; xb_.bar = (unsigned*)(kp().ws + OFF_BAR); xb_.x = xb_xcc_id(); xb_.st = (volatile LAS unsigned*)&xb_words; xcd_barrier(xb_); } while (0)

  if (kp().ws == nullptr) grid.sync();
  setup_phase(kp(), smem);
  GRID_BARRIER();
  { const Params& p = kp(); ln_mod_phase(p, p.ctx, p.x, 0); }
  GRID_BARRIER();

  for (int l = 0; l < 2; ++l) {
    for (int rep = 0; rep < REP_GEMM; ++rep) gemm_in_phase(kp(), l, smem);
    GRID_BARRIER();
    {
      const int nx = (nb > 64 && nb < 1040) ? (1040 % nb) : 0;
      for (int item = blockIdx.x; item < 1040; item += nb) dn_prep_item(kp(), l, item, smem);
      if ((int)blockIdx.x >= nx)
        for (int item = (int)blockIdx.x - nx; item < 2080; item += nb - nx) s5_a_item(kp(), l, item, smem);
    }
    GRID_BARRIER();
    for (int rep = 0; rep < REP_SCAN; ++rep)
    for (int item = blockIdx.x; item < 40; item += nb) {
      if (item < 32) { if ((otid() >> 6) == 0) dn_scan_wave(kp(), item); }
      else s5_carry(kp(), l, item - 32);
    }
    GRID_BARRIER();
    {
      const int nattn = (l == 1) ? 512 : 520;
      for (int rep = 0; rep < REP_ATTN; ++rep)
        for (int item = blockIdx.x; item < nattn; item += nb) attn_item(kp(), item, smem);
    }
    GRID_BARRIER();
    {
      const int skip = (l == 1) ? 16 : 0;
      const int nper = 1040 - skip;
      for (int rep = 0; rep < REP_P5; ++rep)
      for (int item = blockIdx.x; item < 2 * nper; item += nb) {
        if (item < nper) s5_c_item(kp(), l, item + skip, smem);
        else dn_out_item(kp(), l, item - nper + skip, smem);
      }
    }
    GRID_BARRIER();
    gemm_glu_phase(kp(), l, smem);
    GRID_BARRIER();
    gemm_out_phase(kp(), l, smem);
    GRID_BARRIER();
    {
      const Params& p = kp();
      if (l == 0) final_ln_phase(p, 0, p.ctx, p.x);
      else final_ln_phase(p, 1, (const float*)(p.ws + OFF_CTX1), p.out);
    }
    if (l == 0) GRID_BARRIER();
  }
}

extern "C" void kernel_launch(void* const* d_in, const int* in_sizes, int n_in, void* d_out, int out_size, void* d_ws,
                              size_t ws_size, hipStream_t stream) {
  static int grid_blocks = 0;
  if (!grid_blocks) {
    int dev = 0, cus = 0, per_cu = 0;
    hipGetDevice(&dev);
    hipDeviceGetAttribute(&cus, hipDeviceAttributeMultiprocessorCount, dev);
    hipOccupancyMaxActiveBlocksPerMultiprocessor(&per_cu, fwd_megakernel, 256, 0);
    if (per_cu > 2) per_cu = 2;
    if (per_cu < 1) per_cu = 1;
    grid_blocks = cus * per_cu;
  }
  Params p{};
  const float** pp = (const float**)&p;
  for (int i = 0; i < 26; ++i) pp[i] = (const float*)d_in[i];
  p.out = (float*)d_out;
  p.ws = (char*)d_ws;
  void* args[] = {&p};
  (void)hipMemsetAsync((char*)d_ws + OFF_BAR, 0, XCD_BAR_WORDS * 4, stream);
  hipError_t e = hipLaunchCooperativeKernel((void*)fwd_megakernel, dim3(grid_blocks), dim3(256), args, 0, stream);
  if (e != hipSuccess) fprintf(stderr, "cooperative launch failed: %s (grid %d)\n", hipGetErrorString(e), grid_blocks);
}
```
